# Optimizing an MI355X kernel written in HIP

```python
import math
import jax, jax.numpy as jnp
from jax import lax
import numpy as np

D_MODEL = 1024
BATCH = 8
SEQ = 4096
DEPTH = 2

HEAD_DIM = 64
N_HEADS = D_MODEL // HEAD_DIM
BRANCH_WIDTH = N_HEADS * HEAD_DIM
N_MIXERS = 2
DILATED_PAIRS = ((128, 1), (512, 4), (2048, 16))
N_DIL_GROUPS = len(DILATED_PAIRS)
T5_BUCKETS = 32
T5_MAX_DISTANCE = 1024
GRID_W = 64
NA_ROWS = 8
NA_COLS = 16
NA_COL_BLOCK = 16
NA_SLAB = NA_COL_BLOCK + NA_COLS
RMS_EPS = 1e-6
NEG_INF = -1e30
N_A_LAYERS = (DEPTH + N_MIXERS - 1) // N_MIXERS
N_B_LAYERS = DEPTH // N_MIXERS
A_IN_COLS = N_DIL_GROUPS * 3 * BRANCH_WIDTH + BRANCH_WIDTH
B_IN_COLS = 4 * BRANCH_WIDTH

kernel_name = "hybrid_dilated_neighbourhood_encoder"


def rms_norm(x, g):
    xf = x.astype(jnp.float32)
    y = xf * lax.rsqrt(jnp.mean(xf * xf, axis=-1, keepdims=True) + RMS_EPS)
    return (y * g.astype(jnp.float32)).astype(x.dtype)


def t5_bucket(rel):
    half = T5_BUCKETS // 2
    max_exact = half // 2
    ret = jnp.where(rel > 0, half, 0)
    n = jnp.abs(rel)
    nf = jnp.maximum(n, 1).astype(jnp.float32)
    large = max_exact + (jnp.log(nf / max_exact) / math.log(T5_MAX_DISTANCE / max_exact)
                         * (half - max_exact)).astype(jnp.int32)
    large = jnp.minimum(large, half - 1)
    return ret + jnp.where(n < max_exact, n, large)


def _to_sub(t, dilation):
    b, s, h, dh = t.shape
    return t.reshape(b, s // dilation, dilation, h, dh).transpose(0, 2, 3, 1, 4)


def dilated_group_attention(q, k, v, bias_table, dilation, reach):
    b, s, h, dh = q.shape
    length = s // dilation
    nb = -(-length // reach)
    lp = nb * reach
    qs = jnp.pad(_to_sub(q, dilation), ((0, 0), (0, 0), (0, 0), (0, lp - length), (0, 0)))
    kv_pad = ((0, 0), (0, 0), (0, 0), (reach, lp - length + reach), (0, 0))
    ks = jnp.pad(_to_sub(k, dilation), kv_pad)
    vs = jnp.pad(_to_sub(v, dilation), kv_pad)
    rel = np.arange(3 * reach)[None, :] - reach - np.arange(reach)[:, None]
    near = jnp.asarray(np.abs(rel) <= reach)
    bias = bias_table[:, t5_bucket(jnp.asarray(rel * dilation, dtype=jnp.int32))].astype(jnp.float32)
    scale = dh ** -0.5

    def block(i):
        start = i * reach
        qb = lax.dynamic_slice_in_dim(qs, start, reach, axis=3)
        kb = lax.dynamic_slice_in_dim(ks, start, 3 * reach, axis=3)
        vb = lax.dynamic_slice_in_dim(vs, start, 3 * reach, axis=3)
        key_pos = start - reach + jnp.arange(3 * reach)
        valid = near & ((key_pos >= 0) & (key_pos < length))[None, :]
        logits = jnp.einsum('brhqd,brhkd->brhqk', qb, kb).astype(jnp.float32) * scale + bias
        logits = jnp.where(valid, logits, NEG_INF)
        mx = jnp.max(logits, axis=-1, keepdims=True)
        p = jnp.exp(logits - mx)
        denom = jnp.sum(p, axis=-1)
        out = jnp.einsum('brhqk,brhkd->brhqd', p.astype(vb.dtype), vb).astype(jnp.float32) / denom[..., None]
        return out, mx[..., 0] + jnp.log(denom)

    out, lse = lax.map(block, jnp.arange(nb))
    out = out.transpose(1, 2, 3, 0, 4, 5).reshape(b, dilation, h, lp, dh)[:, :, :, :length]
    out = out.transpose(0, 3, 1, 2, 4).reshape(b, s, h, dh)
    lse = lse.transpose(1, 2, 3, 0, 4).reshape(b, dilation, h, lp)[:, :, :, :length]
    lse = lse.transpose(0, 3, 1, 2).reshape(b, s, h)
    return out, lse


def mixer_a(hn, w_in, w_out, q_gain, k_gain, t5_bias):
    b, s, _ = hn.shape
    proj = hn @ w_in
    n_qkv = N_DIL_GROUPS * 3 * BRANCH_WIDTH
    qkv = proj[..., :n_qkv].reshape(b, s, N_DIL_GROUPS, 3, N_HEADS, HEAD_DIM)
    gate = proj[..., n_qkv:]
    outs, lses = [], []
    for g, (window, dilation) in enumerate(DILATED_PAIRS):
        q = rms_norm(qkv[:, :, g, 0], q_gain[g])
        k = rms_norm(qkv[:, :, g, 1], k_gain[g])
        v = qkv[:, :, g, 2]
        reach = (window // 2) // dilation
        o, lse = dilated_group_attention(q, k, v, t5_bias[g * N_HEADS:(g + 1) * N_HEADS],
                                         dilation, reach)
        outs.append(o)
        lses.append(lse)
    alpha = jax.nn.softmax(jnp.stack(lses), axis=0)
    y = jnp.sum(alpha[..., None] * jnp.stack(outs), axis=0)
    y = y.reshape(b, s, BRANCH_WIDTH).astype(hn.dtype) * jax.nn.silu(gate)
    return y @ w_out


def mixer_b(hn, w_in, w_out, q_gain, k_gain, rpb):
    b, s, _ = hn.shape
    rows = s // GRID_W
    wr = min(NA_ROWS, rows)
    proj = hn @ w_in
    q, k, v, gate = jnp.split(proj, 4, axis=-1)
    q = rms_norm(q.reshape(b, s, N_HEADS, HEAD_DIM), q_gain) * (HEAD_DIM ** -0.5)
    k = rms_norm(k.reshape(b, s, N_HEADS, HEAD_DIM), k_gain)
    v = v.reshape(b, s, N_HEADS, HEAD_DIM)

    def to_grid(t):
        return t.reshape(b, rows, GRID_W, N_HEADS, HEAD_DIM).transpose(0, 3, 1, 2, 4)

    qg, kg, vg = to_grid(q), to_grid(k), to_grid(v)
    n_cb = GRID_W // NA_COL_BLOCK
    qcol = np.arange(GRID_W).reshape(n_cb, NA_COL_BLOCK)
    cstart = np.clip(qcol - NA_COLS // 2, 0, GRID_W - NA_COLS)
    slab0 = np.clip(np.arange(n_cb) * NA_COL_BLOCK - NA_COLS // 2, 0, GRID_W - NA_SLAB)
    slab_cols = slab0[:, None] + np.arange(NA_SLAB)
    kc = slab_cols[:, None, :]
    col_valid = jnp.asarray((kc >= cstart[..., None]) & (kc < cstart[..., None] + NA_COLS))
    col_idx = np.clip(kc - qcol[..., None], -(NA_COLS - 1), NA_COLS - 1) + NA_COLS - 1
    col_bias = rpb[:, :, col_idx].astype(jnp.float32)
    slab_cols_j = jnp.asarray(slab_cols)

    def row(r):
        rs = jnp.clip(r - wr // 2, 0, rows - wr)
        qr = lax.dynamic_index_in_dim(qg, r, axis=2, keepdims=False)
        qr = qr.reshape(b, N_HEADS, n_cb, NA_COL_BLOCK, HEAD_DIM)
        kr = lax.dynamic_slice_in_dim(kg, rs, wr, axis=2)[:, :, :, slab_cols_j, :]
        vr = lax.dynamic_slice_in_dim(vg, rs, wr, axis=2)[:, :, :, slab_cols_j, :]
        row_idx = rs + jnp.arange(wr) - r + NA_ROWS - 1
        bias = col_bias[:, row_idx].transpose(0, 2, 3, 1, 4)
        logits = jnp.einsum('bhcqd,bhrcjd->bhcqrj', qr, kr).astype(jnp.float32) + bias
        logits = jnp.where(col_valid[:, :, None, :], logits, NEG_INF)
        p = jax.nn.softmax(logits.reshape(b, N_HEADS, n_cb, NA_COL_BLOCK, wr * NA_SLAB), axis=-1)
        p = p.reshape(b, N_HEADS, n_cb, NA_COL_BLOCK, wr, NA_SLAB).astype(vr.dtype)
        out = jnp.einsum('bhcqrj,bhrcjd->bhcqd', p, vr)
        return out.reshape(b, N_HEADS, GRID_W, HEAD_DIM)

    out = lax.map(row, jnp.arange(rows))
    y = out.transpose(1, 0, 3, 2, 4).reshape(b, s, BRANCH_WIDTH).astype(hn.dtype)
    y = y * jax.nn.silu(gate)
    return y @ w_out


def setup_inputs(seed: int = 0) -> dict:
    key = jax.random.key(seed)
    ks = jax.random.split(key, 13)
    f32 = jnp.float32
    x = jax.random.normal(ks[0], (BATCH, SEQ, D_MODEL), f32)
    norm_gain = 1.0 + 0.02 * jax.random.normal(ks[1], (DEPTH, D_MODEL), f32)
    a_w_in = jax.random.normal(ks[2], (N_A_LAYERS, D_MODEL, A_IN_COLS), f32) * D_MODEL ** -0.5
    a_w_out = jax.random.normal(ks[3], (N_A_LAYERS, BRANCH_WIDTH, D_MODEL), f32) * BRANCH_WIDTH ** -0.5
    a_q_gain = 1.0 + 0.02 * jax.random.normal(ks[4], (N_A_LAYERS, N_DIL_GROUPS, HEAD_DIM), f32)
    a_k_gain = 1.0 + 0.02 * jax.random.normal(ks[5], (N_A_LAYERS, N_DIL_GROUPS, HEAD_DIM), f32)
    t5_bias = 0.1 * jax.random.normal(ks[6], (N_DIL_GROUPS * N_HEADS, T5_BUCKETS), f32)
    b_w_in = jax.random.normal(ks[7], (N_B_LAYERS, D_MODEL, B_IN_COLS), f32) * D_MODEL ** -0.5
    b_w_out = jax.random.normal(ks[8], (N_B_LAYERS, BRANCH_WIDTH, D_MODEL), f32) * BRANCH_WIDTH ** -0.5
    b_q_gain = 1.0 + 0.02 * jax.random.normal(ks[9], (N_B_LAYERS, HEAD_DIM), f32)
    b_k_gain = 1.0 + 0.02 * jax.random.normal(ks[10], (N_B_LAYERS, HEAD_DIM), f32)
    b_rpb = 0.1 * jax.random.normal(ks[11], (N_B_LAYERS, N_HEADS, 2 * NA_ROWS - 1, 2 * NA_COLS - 1), f32)
    return {"x": x, "norm_gain": norm_gain, "a_w_in": a_w_in, "a_w_out": a_w_out,
            "a_q_gain": a_q_gain, "a_k_gain": a_k_gain, "t5_bias": t5_bias,
            "b_w_in": b_w_in, "b_w_out": b_w_out, "b_q_gain": b_q_gain,
            "b_k_gain": b_k_gain, "b_rpb": b_rpb}


def reference(x, norm_gain, a_w_in, a_w_out, a_q_gain, a_k_gain, t5_bias,
              b_w_in, b_w_out, b_q_gain, b_k_gain, b_rpb):
    for i in range(DEPTH):
        hn = rms_norm(x, norm_gain[i])
        j = i // N_MIXERS
        if i % N_MIXERS == 0:
            y = mixer_a(hn, a_w_in[j], a_w_out[j], a_q_gain[j], a_k_gain[j], t5_bias)
        else:
            y = mixer_b(hn, b_w_in[j], b_w_out[j], b_q_gain[j], b_k_gain[j], b_rpb[j])
        x = x + y.astype(x.dtype)
    return x
```

```cpp
#include <hip/hip_runtime.h>
#include <cstdio>
#include <cstdint>
namespace pg8 {
#define PG8_LAS __attribute__((address_space(3)))
typedef unsigned short bf16_t;
typedef short bf16x8 __attribute__((ext_vector_type(8)));
typedef float f32x4 __attribute__((ext_vector_type(4)));
typedef unsigned u32x4 __attribute__((ext_vector_type(4)));
typedef unsigned u32x2 __attribute__((ext_vector_type(2)));
constexpr int BM = 256, BK = 64, HALF = 128, HTB = HALF * BK * 2  , STAGE_BYTES = 8 * HTB, NXCD = 8, WGM = 8;

__host__ __device__ __forceinline__ int lds_byte(int r, int c) { const int st = (r >> 4) * 2 + (c >> 5), rr = r & 15, cc = c & 31, ob = rr * 64 + cc * 2; return st * 1024 + (ob ^ (((ob >> 9) & 1) << 5)); }
__host__ __device__ __forceinline__ void stage_rc(int b, int& R, int& C) { const int st = b / 1024, sb = b % 1024, swz = sb ^ (((sb >> 9) & 1) << 5); R = (st >> 1) * 16 + swz / 64; C = (st & 1) * 32 + (swz % 64) / 2; }
__host__ __device__ __forceinline__ int perm32(int rho) { const int n = rho >> 4, i = rho & 15; return 8 * (i >> 2) + 4 * n + (i & 3); }

struct Unit { int pm, pn; };
struct Gemm { const bf16_t* A; const bf16_t* Bt; int M, N, K; };

struct StaticOrder {
    int nM, nN, nwg, G, c;
    __host__ __device__ void init(int M, int N, int G_, int c_) { nM = M / BM; nN = N / BM; nwg = nM * nN; G = G_; c = c_; }
    __host__ __device__ bool next(int i, Unit& u) const {
        const long L = (long)i * G + c; if (L >= nwg) return false;
        int wgid = (int)L; { const int q = nwg / NXCD, r = nwg % NXCD, xcd = wgid % NXCD, off = wgid / NXCD; wgid = (xcd < r ? xcd * (q + 1) : r * (q + 1) + (xcd - r) * q) + off; }
        const int nig = WGM * nN, gid = wgid / nig, fm = gid * WGM, gsz = (nM - fm) < WGM ? (nM - fm) : WGM;
        u.pm = fm + ((wgid % nig) % gsz); u.pn = (wgid % nig) / gsz; return true;
    }
};

__device__ __forceinline__ unsigned cvt_pk_bf16(float lo, float hi) { unsigned r; asm volatile("v_cvt_pk_bf16_f32 %0, %1, %2" : "=v"(r) : "v"(lo), "v"(hi)); return r; }


constexpr float RMS_EPS = 1e-6f;
template <int MODE> struct EpiIn {
    static constexpr bool HEADMAP = true;
    bf16_t* qkv; size_t sec_stride; bf16_t* gate; const float* rs; const float* qg; const float* kg; int row_base; float qscale;
    __device__ __forceinline__ void operator()(const f32x4 (&acc)[2][2][4][2], const Unit& u, int wr, int wc, int fr, int fq) const {
        const int sec = u.pn >> 2, hq = u.pn & 3, h = hq * 4 + wc;
        int type, g = 0;
        if (MODE == 0) { if (sec == 9) type = 3; else { g = sec / 3; type = sec - 3 * g; } } else type = sec;
        const int shift = (MODE == 0) ? 2 * g : 0;
        f32x4 gv[2][2];
#pragma unroll
        for (int bj = 0; bj < 2; ++bj)
#pragma unroll
            for (int n = 0; n < 2; ++n) gv[bj][n] = (f32x4){1.f, 1.f, 1.f, 1.f};
        if (type < 2) {
            const float* gp = (type == 0 ? qg : kg) + (MODE == 0 ? g * 64 : 0) + 8 * fq;
            const float sc = (type == 0) ? qscale : 1.f;
#pragma unroll
            for (int bj = 0; bj < 2; ++bj)
#pragma unroll
                for (int n = 0; n < 2; ++n) gv[bj][n] = *(const f32x4*)(gp + 32 * bj + 4 * n) * sc;
        }
#pragma unroll
        for (int ai = 0; ai < 2; ++ai)
#pragma unroll
            for (int m = 0; m < 4; ++m) {
                const int r = u.pm * BM + ai * HALF + wr * 64 + m * 16 + fr;
                float rsv;
                if (MODE == 0) rsv = rs[row_base + r];
                else { const f32x4 pp = *(const f32x4*)(rs + (size_t)(row_base + r) * 16 + 4 * fq); float s = (pp[0] + pp[1]) + (pp[2] + pp[3]); s += __shfl_xor(s, 16); s += __shfl_xor(s, 32); rsv = __builtin_amdgcn_rsqf(s * (1.0f / 1024.0f) + RMS_EPS); }
                f32x4 v[2][2];
#pragma unroll
                for (int bj = 0; bj < 2; ++bj)
#pragma unroll
                    for (int n = 0; n < 2; ++n) v[bj][n] = acc[ai][bj][m][n] * rsv;
                if (type < 2) {
                    float ss = 0.f;
#pragma unroll
                    for (int bj = 0; bj < 2; ++bj)
#pragma unroll
                        for (int n = 0; n < 2; ++n) { const f32x4 x = v[bj][n]; ss += (x[0] * x[0] + x[1] * x[1]) + (x[2] * x[2] + x[3] * x[3]); }
                    ss += __shfl_xor(ss, 16); ss += __shfl_xor(ss, 32);
                    const float inv = __builtin_amdgcn_rsqf(ss * (1.0f / 64.0f) + RMS_EPS);
#pragma unroll
                    for (int bj = 0; bj < 2; ++bj)
#pragma unroll
                        for (int n = 0; n < 2; ++n) v[bj][n] = v[bj][n] * gv[bj][n] * inv;
                } else if (type == 3) {
#pragma unroll
                    for (int bj = 0; bj < 2; ++bj)
#pragma unroll
                        for (int n = 0; n < 2; ++n)
#pragma unroll
                            for (int i = 0; i < 4; ++i) { const float x = v[bj][n][i]; v[bj][n][i] = x * __builtin_amdgcn_rcpf(1.0f + __expf(-x)); }
                }
                bf16_t* p;
                if (type < 3) { const int t = r & 4095, bl = r >> 12; const int pos = ((t & ((1 << shift) - 1)) << (12 - shift)) | (t >> shift);
                    p = qkv + (size_t)sec * sec_stride + ((size_t)(bl * 16 + h) * 4096 + pos) * 64 + 8 * fq; }
                else p = gate + (size_t)r * 1024 + hq * 256 + wc * 64 + 8 * fq;
#pragma unroll
                for (int bj = 0; bj < 2; ++bj) { u32x4 w; w.x = cvt_pk_bf16(v[bj][0][0], v[bj][0][1]); w.y = cvt_pk_bf16(v[bj][0][2], v[bj][0][3]); w.z = cvt_pk_bf16(v[bj][1][0], v[bj][1][1]); w.w = cvt_pk_bf16(v[bj][1][2], v[bj][1][3]);
                    *(u32x4*)(p + 32 * bj) = w; }
            }
    }
};

struct EpiOut {
    static constexpr bool HEADMAP = false;
    const float* base; float* out; bf16_t* xb; float* part;
    __device__ __forceinline__ void operator()(const f32x4 (&acc)[2][2][4][2], const Unit& u, int wr, int wc, int fr, int fq) const {
#pragma unroll
        for (int ai = 0; ai < 2; ++ai)
#pragma unroll
            for (int m = 0; m < 4; ++m) {
                const int r = u.pm * BM + ai * HALF + wr * 64 + m * 16 + fr;
                const size_t off = (size_t)r * 1024 + u.pn * BM + wc * 32 + 4 * fq;
                float ss = 0.f;
#pragma unroll
                for (int bj = 0; bj < 2; ++bj)
#pragma unroll
                    for (int n = 0; n < 2; ++n) {
                        const f32x4 bs = *(const f32x4*)(base + off + bj * HALF + n * 16);
                        const f32x4 o = bs + acc[ai][bj][m][n];
                        *(f32x4*)(out + off + bj * HALF + n * 16) = o;
                        if (xb) { u32x2 w; w.x = cvt_pk_bf16(o[0], o[1]); w.y = cvt_pk_bf16(o[2], o[3]); *(u32x2*)(xb + off + bj * HALF + n * 16) = w; }
                        ss += (o[0] * o[0] + o[1] * o[1]) + (o[2] * o[2] + o[3] * o[3]);
                    }
                if (part) { ss += __shfl_xor(ss, 16); ss += __shfl_xor(ss, 32); if (fq == 0) part[(size_t)r * 16 + u.pn * 4 + wc] = ss; }
            }
    }
};

template <class Epi, class Sched, bool ALIGN_EPI>
__device__ __forceinline__ void gemm_phase(PG8_LAS unsigned char* lds, const Gemm g, const Sched& S, const Epi& E) {
    const int tid = threadIdx.x, wid = __builtin_amdgcn_readfirstlane(tid >> 6), lane = tid & 63, wr = wid >> 2, wc = wid & 3, fr = lane & 15, fq = lane >> 4;
    const int K = g.K, nt = K / BK;
    unsigned voffA[2], voffB[2];
#pragma unroll
    for (int i = 0; i < 2; ++i) { int R, C; stage_rc(tid * 16 + i * 8192, R, C);
        const int Rb = Epi::HEADMAP ? (64 * (R >> 5) + perm32(R & 31)) : R;
        voffA[i] = (unsigned)(R * K + C) * 2u; voffB[i] = (unsigned)(Rb * K + C) * 2u; }
    const size_t kstep = (size_t)(BK * 2);
    const size_t hstep = (size_t)HALF * K * 2;
    const size_t hstepB = Epi::HEADMAP ? (size_t)32 * K * 2 : hstep;
    const size_t tstep = 2 * hstep;
    const unsigned ldsw = (unsigned)wid * 1024u;
    const int aoff = lds_byte(wr * 64 + fr, fq * 8), boff = lds_byte(wc * 32 + fr, fq * 8);
#define PG8_SA(b, h) (((b) * 2 + (h)) * HTB)
#define PG8_SB(b, h) ((4 + (b) * 2 + (h)) * HTB)
#define PG8_STAGE(bufoff, gbase, voff) do { _Pragma("unroll") for (int _i = 0; _i < 2; ++_i) \
        __builtin_amdgcn_global_load_lds((const unsigned*)((const char*)(gbase) + (voff)[_i]), (PG8_LAS unsigned*)(lds + (bufoff) + ldsw + _i * 8192), 16, 0, 0); } while (0)
#define PG8_LDA(dst, b, h) do { _Pragma("unroll") for (int m = 0; m < 4; ++m) _Pragma("unroll") for (int k = 0; k < 2; ++k) dst[m][k] = *(const PG8_LAS bf16x8*)(lds + PG8_SA(b, h) + aoff + m * 2048 + k * 1024); } while (0)
#define PG8_LDB(dst, b, h) do { _Pragma("unroll") for (int n = 0; n < 2; ++n) _Pragma("unroll") for (int k = 0; k < 2; ++k) dst[n][k] = *(const PG8_LAS bf16x8*)(lds + PG8_SB(b, h) + boff + n * 2048 + k * 1024); } while (0)
#define PG8_MMA(ai, bj, At, Bt) do { __builtin_amdgcn_s_setprio(1); _Pragma("unroll") for (int m = 0; m < 4; ++m) _Pragma("unroll") for (int n = 0; n < 2; ++n) _Pragma("unroll") for (int k = 0; k < 2; ++k) \
        acc[ai][bj][m][n] = __builtin_amdgcn_mfma_f32_16x16x32_bf16(Bt[n][k], At[m][k], acc[ai][bj][m][n], 0, 0, 0); __builtin_amdgcn_s_setprio(0); } while (0)
#define PG8_WAIT_V(n) asm volatile("s_waitcnt vmcnt(" #n ")" ::: "memory")
#define PG8_WAIT_L(n) asm volatile("s_waitcnt lgkmcnt(" #n ")" ::: "memory")
#define PG8_BAR __builtin_amdgcn_s_barrier()
#define PG8_SCHED __builtin_amdgcn_sched_barrier(0)
    Unit cur, nxt; int ui = 0;
    if (!S.next(0, cur)) return;
    f32x4 acc[2][2][4][2];
#pragma unroll
    for (int a = 0; a < 2; ++a)
#pragma unroll
        for (int b = 0; b < 2; ++b)
#pragma unroll
            for (int m = 0; m < 4; ++m)
#pragma unroll
                for (int n = 0; n < 2; ++n) acc[a][b][m][n] = (f32x4){0.f, 0.f, 0.f, 0.f};
    bf16x8 At[4][2], B0[2][2], B1[2][2];
    const char* cA = (const char*)g.A + (size_t)cur.pm * tstep; const char* cB = (const char*)g.Bt + (size_t)cur.pn * tstep;
    PG8_STAGE(PG8_SB(0, 0), cB, voffB); PG8_STAGE(PG8_SB(0, 1), cB + hstepB, voffB); PG8_STAGE(PG8_SA(0, 0), cA, voffA); PG8_STAGE(PG8_SA(0, 1), cA + hstep, voffA);
    if (wr == 1) PG8_BAR;
    PG8_WAIT_V(2); PG8_BAR;
    PG8_STAGE(PG8_SB(1, 0), cB + kstep, voffB); PG8_STAGE(PG8_SA(1, 0), cA + kstep, voffA); PG8_STAGE(PG8_SB(1, 1), cB + hstepB + kstep, voffB);
    PG8_WAIT_V(6); PG8_BAR;
    for (;;) {
        const bool has_next = S.next(ui + 1, nxt);
        const char* nA = has_next ? (const char*)g.A + (size_t)nxt.pm * tstep : cA; const char* nB = has_next ? (const char*)g.Bt + (size_t)nxt.pn * tstep : cB;
        for (int t = 0; t < nt; t += 2) {
            const bool last = (t == nt - 2);
            const char* a1 = cA + (size_t)(t + 1) * kstep;
            const char* a2 = last ? nA : cA + (size_t)(t + 2) * kstep; const char* b2 = last ? nB : cB + (size_t)(t + 2) * kstep;
            const char* a3 = a2 + kstep; const char* b3 = b2 + kstep;
            PG8_LDB(B0, 0, 0); PG8_LDB(B1, 0, 1); PG8_SCHED; PG8_LDA(At, 0, 0); PG8_STAGE(PG8_SA(1, 1), a1 + hstep, voffA);
            PG8_WAIT_V(8); PG8_WAIT_L(0); PG8_BAR; PG8_MMA(0, 0, At, B0); PG8_MMA(0, 1, At, B1); PG8_BAR; PG8_SCHED;
            PG8_LDA(At, 0, 1); PG8_STAGE(PG8_SB(0, 0), b2, voffB); PG8_STAGE(PG8_SB(0, 1), b2 + hstepB, voffB); PG8_STAGE(PG8_SA(0, 0), a2, voffA);
            PG8_WAIT_V(8); PG8_WAIT_L(0); PG8_BAR; PG8_MMA(1, 0, At, B0); PG8_MMA(1, 1, At, B1); PG8_BAR; PG8_SCHED;
            PG8_LDB(B0, 1, 0); PG8_LDB(B1, 1, 1); PG8_SCHED; PG8_LDA(At, 1, 0); PG8_STAGE(PG8_SA(0, 1), a2 + hstep, voffA);
            PG8_WAIT_V(8); PG8_WAIT_L(0); PG8_BAR; PG8_MMA(0, 0, At, B0); PG8_MMA(0, 1, At, B1); PG8_BAR; PG8_SCHED;
            PG8_LDA(At, 1, 1); PG8_STAGE(PG8_SB(1, 0), b3, voffB); PG8_STAGE(PG8_SB(1, 1), b3 + hstepB, voffB); PG8_STAGE(PG8_SA(1, 0), a3, voffA);
            PG8_WAIT_V(8); PG8_WAIT_L(0); PG8_BAR; PG8_MMA(1, 0, At, B0); PG8_MMA(1, 1, At, B1); PG8_BAR; PG8_SCHED;
        }
        if constexpr (ALIGN_EPI) { if (wr == 0) PG8_BAR; }
        E(acc, cur, wr, wc, fr, fq);
        if (!has_next) break;
#pragma unroll
        for (int a = 0; a < 2; ++a)
#pragma unroll
            for (int b = 0; b < 2; ++b)
#pragma unroll
                for (int m = 0; m < 4; ++m)
#pragma unroll
                    for (int n = 0; n < 2; ++n) acc[a][b][m][n] = (f32x4){0.f, 0.f, 0.f, 0.f};
        cur = nxt; cA = nA; cB = nB; ++ui;
        if constexpr (ALIGN_EPI) { if (wr == 1) PG8_BAR; }
    }
    PG8_WAIT_V(0);
    if constexpr (!ALIGN_EPI) { if (wr == 0) PG8_BAR; }
    PG8_BAR;
#undef PG8_SA
#undef PG8_SB
#undef PG8_STAGE
#undef PG8_LDA
#undef PG8_LDB
#undef PG8_MMA
#undef PG8_WAIT_V
#undef PG8_WAIT_L
#undef PG8_BAR
#undef PG8_SCHED
}
}
constexpr int NWAVES = 8;
constexpr int BATCH = 8, SEQ = 4096, DM = 1024, NH = 16, HD = 64;
constexpr int MTOK = BATCH * SEQ;
constexpr int MHALF = MTOK / 2;
constexpr int NA_IN = 10240, NB_IN = 4096;
constexpr float LOG2E = 1.4426950408889634f;
constexpr float QSCALE = 0.125f * LOG2E;

constexpr size_t MiB = 1u << 20;
constexpr size_t WS_CTL = 0, CTL_ZERO_BYTES = 1 * MiB;
constexpr size_t WS_RSTD1 = 1 * MiB;
constexpr size_t WS_PART2 = 2 * MiB;
constexpr size_t WS_WAIN = 4 * MiB, WS_WAOUT = 24 * MiB, WS_WBIN = 26 * MiB, WS_WBOUT = 34 * MiB;
constexpr size_t WS_XB = 36 * MiB;
constexpr size_t WS_QKVA = 100 * MiB;
constexpr size_t SECA = (size_t)4 * NH * SEQ * HD;
constexpr size_t WS_GATEA = WS_QKVA + 9 * 32 * MiB;
constexpr size_t WS_X1B = 100 * MiB;
constexpr size_t WS_QKVB = 164 * MiB;
constexpr size_t SECB = (size_t)8 * NH * SEQ * HD;
constexpr size_t WS_GATEB = WS_QKVB + 3 * 64 * MiB;
constexpr size_t WS_END = 420 * MiB;
static_assert(WS_GATEA + 32 * MiB <= WS_END && WS_GATEB + 64 * MiB <= WS_END && WS_X1B + 64 * MiB <= WS_QKVB, "ws map");
constexpr int CW_BAR = 4096;

constexpr int RING_OFF = 0, RING_BYTES = 131072;
constexpr int LDSCTL_OFF = RING_BYTES, MISC_OFF = LDSCTL_OFF + 320;
constexpr int LDS_BYTES = 147456;

#define GAS __attribute__((address_space(1)))
#define LAS __attribute__((address_space(3)))
typedef unsigned short bf16;
typedef unsigned v4u __attribute__((ext_vector_type(4)));
typedef unsigned v2u __attribute__((ext_vector_type(2)));
typedef float f32x4 __attribute__((ext_vector_type(4)));
typedef short bf16x8 __attribute__((ext_vector_type(8)));
typedef GAS unsigned gu32;
#define RLX_AGENT __ATOMIC_RELAXED, __HIP_MEMORY_SCOPE_AGENT
#define LDS_WAIT() asm volatile("s_waitcnt lgkmcnt(0)" ::: "memory")
#define VM_WAIT() asm volatile("s_waitcnt vmcnt(0)" ::: "memory")
__device__ __forceinline__ unsigned f2bf(float f) { unsigned u = __builtin_bit_cast(unsigned, f); return (u + 0x7fffu + ((u >> 16) & 1u)) >> 16; }
__device__ __forceinline__ unsigned pk2(float lo, float hi) { return f2bf(lo) | (f2bf(hi) << 16); }
__device__ __forceinline__ float bf2f(unsigned short h) { return __builtin_bit_cast(float, (unsigned)h << 16); }

#define XB_TMO      128
#define XB_XCNT(j)  (256  + 64 * (j))
#define XB_XSUB(j)  (1280 + 64 * (j))
#define XB_XGEN(j)  (2304 + 64 * (j))
#define XB_TOP      3328
#define XB_TOPGEN   3392
#define XCD_BAR_WORDS 3456
#define XB_SPIN_CAP (1u << 18)
__device__ __forceinline__ unsigned xb_ld(unsigned* p)              { return __hip_atomic_load(p, __ATOMIC_RELAXED, __HIP_MEMORY_SCOPE_AGENT); }
__device__ __forceinline__ unsigned xb_add(unsigned* p, unsigned v) { return __hip_atomic_fetch_add(p, v, __ATOMIC_RELAXED, __HIP_MEMORY_SCOPE_AGENT); }
__device__ __forceinline__ unsigned xb_xcc_id() { return (unsigned)__builtin_amdgcn_s_getreg((3 << 11) | 20) & 0xFu; }
#define XB_SPIN(cond, bar) do { unsigned _sp = 0; while (cond) { __builtin_amdgcn_s_sleep(1); \
    if ((++_sp & 255u) == 0u) { if (xb_ld(&(bar)[XB_TMO])) break; if (_sp > XB_SPIN_CAP) { atomicAdd(&(bar)[XB_TMO], 1u); break; } } } } while (0)
struct XcdBarrier { unsigned* bar; unsigned x; volatile LAS unsigned* st; };
__device__ __forceinline__ XcdBarrier xcd_barrier_post(unsigned* bar, volatile LAS unsigned* st) {
    XcdBarrier b; b.bar = bar; b.x = xb_xcc_id(); b.st = st;
    if (threadIdx.x == 0) (void)xb_add(&bar[XB_XCNT(b.x)], 1u);
    return b;
}
__device__ __forceinline__ void xcd_barrier_complete(unsigned* bar, unsigned x, unsigned& nloc, unsigned& nx) {
    const unsigned G = gridDim.x * gridDim.y * gridDim.z;
    unsigned sum, cnt, mine, sp = 0u;
    for (;;) {
        sum = 0u; cnt = 0u; mine = 0u;
#pragma unroll
        for (unsigned j = 0; j < 16; ++j) { const unsigned c = xb_ld(&bar[XB_XCNT(j)]); sum += c; cnt += (c > 0u) ? 1u : 0u; mine = (j == x) ? c : mine; }
        if (sum == G) break;
        __builtin_amdgcn_s_sleep(1);
        if ((++sp & 255u) == 0u) { if (xb_ld(&bar[XB_TMO])) break; if (sp > XB_SPIN_CAP) { atomicAdd(&bar[XB_TMO], 1u); break; } }
    }
    nloc = mine > 0u ? mine : 1u; nx = cnt > 0u ? cnt : 1u;
}
__device__ __forceinline__ void xcd_barrier(const XcdBarrier& b) {
    asm volatile("s_waitcnt vmcnt(0)" ::: "memory");
    __syncthreads();
    if (threadIdx.x == 0) {
        unsigned* bar = b.bar;
        __builtin_amdgcn_s_waitcnt(0);
        unsigned nloc = b.st[0], nx = b.st[1];
        if (nloc == 0u) { xcd_barrier_complete(bar, b.x, nloc, nx); b.st[0] = nloc; b.st[1] = nx; }
        const unsigned old = xb_add(&bar[XB_XSUB(b.x)], 1u);
        const unsigned gen = old / nloc;
        if (old + 1u == (gen + 1u) * nloc) {
            __builtin_amdgcn_fence(__ATOMIC_RELEASE, "agent");
            asm volatile("s_waitcnt vmcnt(0)" ::: "memory");
            const unsigned og = xb_add(&bar[XB_TOP], 1u);
            const unsigned tg = og / nx;
            if (og + 1u == (tg + 1u) * nx) xb_add(&bar[XB_TOPGEN], 1u);
            else XB_SPIN(xb_ld(&bar[XB_TOPGEN]) == tg, bar);
            __builtin_amdgcn_fence(__ATOMIC_ACQUIRE, "agent");
            xb_add(&bar[XB_XGEN(b.x)], 1u);
            asm volatile("s_waitcnt vmcnt(0)" ::: "memory");
        } else {
            XB_SPIN(xb_ld(&bar[XB_XGEN(b.x)]) == gen, bar);
            __builtin_amdgcn_fence(__ATOMIC_ACQUIRE, "agent");
            asm volatile("s_waitcnt vmcnt(0)" ::: "memory");
        }
    }
    __syncthreads();
}

struct Frame {
    LAS unsigned char* lds;
    volatile LAS unsigned* MISC;
    gu32* ctl;
    int tid, lane, wave, vcu, G;
};

__device__ __forceinline__ float wave_sum(float v) {
#pragma unroll
    for (int o = 1; o < 64; o <<= 1) v += __shfl_xor(v, o);
    return v;
}
__device__ __forceinline__ void p0_transpose_item(const float* W, int K, int N, bf16* WT, const float* gk, LAS float* scr, int item, int lane) {
    const int nblk = N / 32, kb = item / nblk, nb = item % nblk, k0 = 64 * kb, n0 = 32 * nb;
#pragma unroll 8
    for (int i = 0; i < 32; ++i) { const int kk = 2 * i + (lane >> 5); const float gsc = gk ? gk[k0 + kk] : 1.0f; scr[kk * 33 + (lane & 31)] = W[(size_t)(k0 + kk) * N + n0 + (lane & 31)] * gsc; }
    LDS_WAIT(); asm volatile("" ::: "memory");
    const int c = lane & 7;
#pragma unroll
    for (int j = 0; j < 4; ++j) { const int n = (lane >> 3) + 8 * j; const LAS float* s = scr + (8 * c) * 33 + n;
        v4u o; o.x = pk2(s[0 * 33], s[1 * 33]); o.y = pk2(s[2 * 33], s[3 * 33]); o.z = pk2(s[4 * 33], s[5 * 33]); o.w = pk2(s[6 * 33], s[7 * 33]);
        *(GAS v4u*)(WT + (size_t)(n0 + n) * K + k0 + 8 * c) = o; }
    LDS_WAIT(); asm volatile("" ::: "memory");
}
__device__ __forceinline__ int t5_bucket_dev(int rel) {
    const int n = rel < 0 ? -rel : rel;
    const int b = n < 8 ? n : 8 + (n >= 15) + (n >= 27) + (n >= 50) + (n >= 91) + (n >= 167) + (n >= 305) + (n >= 559);
    return b + (rel > 0 ? 16 : 0);
}
__device__ __forceinline__ void ld_row64(const bf16* p, float (&f)[64]) {
#pragma unroll
    for (int i = 0; i < 8; ++i) { const v4u w = *(const v4u*)(p + 8 * i);
        f[8 * i + 0] = __builtin_bit_cast(float, w.x << 16); f[8 * i + 1] = __builtin_bit_cast(float, w.x & 0xffff0000u);
        f[8 * i + 2] = __builtin_bit_cast(float, w.y << 16); f[8 * i + 3] = __builtin_bit_cast(float, w.y & 0xffff0000u);
        f[8 * i + 4] = __builtin_bit_cast(float, w.z << 16); f[8 * i + 5] = __builtin_bit_cast(float, w.z & 0xffff0000u);
        f[8 * i + 6] = __builtin_bit_cast(float, w.w << 16); f[8 * i + 7] = __builtin_bit_cast(float, w.w & 0xffff0000u); }
}
__global__ void __launch_bounds__(256) naive_attn_a(const bf16* qkv, const bf16* gate, bf16* y, const float* t5) {
    const int idx = blockIdx.x * 256 + threadIdx.x; const int t = idx & 4095, h = (idx >> 12) & 15, bl = idx >> 16;
    float m = -1e30f, l = 0.f; float o[64];
#pragma unroll
    for (int d = 0; d < 64; ++d) o[d] = 0.f;
    for (int g = 0; g < 3; ++g) {
        const int sh = 2 * g, dil = 1 << sh, L = 4096 >> sh, res = t & (dil - 1), mq = t >> sh;
        const bf16* Q = qkv + (size_t)(3 * g) * SECA + ((size_t)(bl * 16 + h) * 4096) * 64;
        const bf16* K = Q + SECA; const bf16* V = K + SECA;
        float q[64]; ld_row64(Q + (size_t)(res * L + mq) * 64, q);
        for (int dm = -64; dm <= 64; ++dm) {
            const int mk = mq + dm; if (mk < 0 || mk >= L) continue;
            float kf[64]; ld_row64(K + (size_t)(res * L + mk) * 64, kf);
            float s = 0.f;
#pragma unroll
            for (int d = 0; d < 64; ++d) s += q[d] * kf[d];
            s += LOG2E * t5[(g * 16 + h) * 32 + t5_bucket_dev(dm * dil)];
            const float mn = fmaxf(m, s), a = exp2f(m - mn), p = exp2f(s - mn);
            l = l * a + p; m = mn;
            ld_row64(V + (size_t)(res * L + mk) * 64, kf);
#pragma unroll
            for (int d = 0; d < 64; ++d) o[d] = o[d] * a + p * kf[d];
        }
    }
    const float inv = 1.0f / l;
    const size_t row = (size_t)(bl * 4096 + t) * 1024 + h * 64;
#pragma unroll
    for (int i = 0; i < 8; ++i) { const v4u gw = *(const v4u*)(gate + row + 8 * i); v4u w;
        w.x = pk2(o[8 * i + 0] * inv * __builtin_bit_cast(float, gw.x << 16), o[8 * i + 1] * inv * __builtin_bit_cast(float, gw.x & 0xffff0000u));
        w.y = pk2(o[8 * i + 2] * inv * __builtin_bit_cast(float, gw.y << 16), o[8 * i + 3] * inv * __builtin_bit_cast(float, gw.y & 0xffff0000u));
        w.z = pk2(o[8 * i + 4] * inv * __builtin_bit_cast(float, gw.z << 16), o[8 * i + 5] * inv * __builtin_bit_cast(float, gw.z & 0xffff0000u));
        w.w = pk2(o[8 * i + 6] * inv * __builtin_bit_cast(float, gw.w << 16), o[8 * i + 7] * inv * __builtin_bit_cast(float, gw.w & 0xffff0000u));
        *(v4u*)(y + row + 8 * i) = w; }
}
__global__ void __launch_bounds__(256) naive_attn_b(const bf16* qkv, const bf16* gate, bf16* y, const float* rpb) {
    const int idx = blockIdx.x * 256 + threadIdx.x; const int t = idx & 4095, h = (idx >> 12) & 15, b = idx >> 16;
    const int r = t >> 6, c = t & 63; const int rs = min(max(r - 4, 0), 56), cs = min(max(c - 8, 0), 48);
    float m = -1e30f, l = 0.f; float o[64];
#pragma unroll
    for (int d = 0; d < 64; ++d) o[d] = 0.f;
    const bf16* Q = qkv + ((size_t)(b * 16 + h) * 4096) * 64; const bf16* K = Q + SECB; const bf16* V = K + SECB;
    float q[64]; ld_row64(Q + (size_t)t * 64, q);
    for (int kr = rs; kr < rs + 8; ++kr)
        for (int kc = cs; kc < cs + 16; ++kc) {
            const int kt = kr * 64 + kc;
            float kf[64]; ld_row64(K + (size_t)kt * 64, kf);
            float s = 0.f;
#pragma unroll
            for (int d = 0; d < 64; ++d) s += q[d] * kf[d];
            s += LOG2E * rpb[(h * 15 + (kr - r + 7)) * 31 + (kc - c + 15)];
            const float mn = fmaxf(m, s), a = exp2f(m - mn), p = exp2f(s - mn);
            l = l * a + p; m = mn;
            ld_row64(V + (size_t)kt * 64, kf);
#pragma unroll
            for (int d = 0; d < 64; ++d) o[d] = o[d] * a + p * kf[d];
        }
    const float inv = 1.0f / l;
    const size_t row = (size_t)(b * 4096 + t) * 1024 + h * 64;
#pragma unroll
    for (int i = 0; i < 8; ++i) { const v4u gw = *(const v4u*)(gate + row + 8 * i); v4u w;
        w.x = pk2(o[8 * i + 0] * inv * __builtin_bit_cast(float, gw.x << 16), o[8 * i + 1] * inv * __builtin_bit_cast(float, gw.x & 0xffff0000u));
        w.y = pk2(o[8 * i + 2] * inv * __builtin_bit_cast(float, gw.y << 16), o[8 * i + 3] * inv * __builtin_bit_cast(float, gw.y & 0xffff0000u));
        w.z = pk2(o[8 * i + 4] * inv * __builtin_bit_cast(float, gw.z << 16), o[8 * i + 5] * inv * __builtin_bit_cast(float, gw.z & 0xffff0000u));
        w.w = pk2(o[8 * i + 6] * inv * __builtin_bit_cast(float, gw.w << 16), o[8 * i + 7] * inv * __builtin_bit_cast(float, gw.w & 0xffff0000u));
        *(v4u*)(y + row + 8 * i) = w; }
}
struct Args { const float* in[12]; float* out; unsigned char* ws; int ph_lo, ph_hi; };
__global__ void __launch_bounds__(NWAVES * 64, 2) fwd_kernel(Args args) {
    extern __shared__ __attribute__((aligned(16))) unsigned char lds[];
    Frame F;
    F.lds = (LAS unsigned char*)lds;
    F.MISC = (volatile LAS unsigned*)(F.lds + MISC_OFF);
    F.tid = threadIdx.x; F.lane = F.tid & 63; F.wave = __builtin_amdgcn_readfirstlane(F.tid >> 6);
    F.G = gridDim.x; { const int bx = blockIdx.x; F.vcu = (F.G % 8 == 0) ? (bx % 8) * (F.G / 8) + bx / 8 : bx; }
    unsigned char* ws = args.ws;
    F.ctl = (gu32*)(ws + WS_CTL);
    for (int u = F.tid; u < (LDS_BYTES - LDSCTL_OFF) / 4; u += NWAVES * 64) ((LAS unsigned*)(F.lds + LDSCTL_OFF))[u] = 0u;
    __syncthreads();
    XcdBarrier bar = xcd_barrier_post((unsigned*)(F.ctl + CW_BAR), F.MISC + 8);
    const int lo = args.ph_lo, hi = args.ph_hi;
#define IN(k) (lo <= (k) && (k) < hi)
#define BOTH(k) (IN(k) && IN((k) + 1))
    const float* x = args.in[0]; const float* norm_gain = args.in[1];
    bf16* XB = (bf16*)(ws + WS_XB);
    float* rstd1 = (float*)(ws + WS_RSTD1); float* part2 = (float*)(ws + WS_PART2);

    if (IN(0)) {
        LAS float* scr = (LAS float*)(F.lds + RING_OFF + F.wave * 16384);
        const int gw = F.vcu * NWAVES + F.wave, NGW = F.G * NWAVES;
        constexpr int I_AIN = (DM / 64) * (NA_IN / 32), I_O = (DM / 64) * (DM / 32), I_BIN = (DM / 64) * (NB_IN / 32);
        constexpr int NITEMS = I_AIN + I_O + I_BIN + I_O;
        for (int it = gw; it < NITEMS; it += NGW) {
            int r = it;
            if (r < I_AIN) { p0_transpose_item(args.in[2], DM, NA_IN, (bf16*)(ws + WS_WAIN), norm_gain, scr, r, F.lane); continue; } r -= I_AIN;
            if (r < I_O) { p0_transpose_item(args.in[3], DM, DM, (bf16*)(ws + WS_WAOUT), nullptr, scr, r, F.lane); continue; } r -= I_O;
            if (r < I_BIN) { p0_transpose_item(args.in[7], DM, NB_IN, (bf16*)(ws + WS_WBIN), norm_gain + DM, scr, r, F.lane); continue; } r -= I_BIN;
            p0_transpose_item(args.in[8], DM, DM, (bf16*)(ws + WS_WBOUT), nullptr, scr, r, F.lane);
        }
        for (int m = gw; m < MTOK; m += NGW) {
            const GAS f32x4* xr = (const GAS f32x4*)(x + (size_t)m * DM) + F.lane;
            f32x4 v[4]; float s = 0.f;
#pragma unroll
            for (int j = 0; j < 4; ++j) { v[j] = xr[64 * j]; s += (v[j].x * v[j].x + v[j].y * v[j].y) + (v[j].z * v[j].z + v[j].w * v[j].w); }
            s = wave_sum(s);
            if (F.lane == 0) rstd1[m] = __builtin_amdgcn_rsqf(s * (1.0f / DM) + pg8::RMS_EPS);
            GAS v2u* o8 = (GAS v2u*)(XB + (size_t)m * DM) + F.lane;
#pragma unroll
            for (int j = 0; j < 4; ++j) { v2u w; w.x = pk2(v[j].x, v[j].y); w.y = pk2(v[j].z, v[j].w); o8[64 * j] = w; }
        }
        if (BOTH(0)) xcd_barrier(bar);
    }
    for (int hf = 0; hf < 2; ++hf) {
        if (IN(1 + 2 * hf)) {
            pg8::Gemm g{XB + (size_t)hf * MHALF * DM, (const bf16*)(ws + WS_WAIN), MHALF, NA_IN, DM};
            pg8::StaticOrder S; S.init(MHALF, NA_IN, F.G, (int)blockIdx.x);
            pg8::EpiIn<0> E{(bf16*)(ws + WS_QKVA), SECA, (bf16*)(ws + WS_GATEA), rstd1, args.in[4], args.in[5], hf * MHALF, QSCALE};
            pg8::gemm_phase<pg8::EpiIn<0>, pg8::StaticOrder, true>(F.lds + RING_OFF, g, S, E);
            if (BOTH(1 + 2 * hf)) xcd_barrier(bar);
        }
        if (IN(2 + 2 * hf)) {
            if (BOTH(2 + 2 * hf)) xcd_barrier(bar);
        }
    }
    if (IN(5)) {
        pg8::Gemm g{XB, (const bf16*)(ws + WS_WAOUT), MTOK, DM, DM};
        pg8::StaticOrder S; S.init(MTOK, DM, F.G, (int)blockIdx.x);
        pg8::EpiOut E{x, args.out, (bf16*)(ws + WS_X1B), part2};
        pg8::gemm_phase<pg8::EpiOut, pg8::StaticOrder, true>(F.lds + RING_OFF, g, S, E);
        if (BOTH(5)) xcd_barrier(bar);
    }
    if (IN(6)) {
        pg8::Gemm g{(const bf16*)(ws + WS_X1B), (const bf16*)(ws + WS_WBIN), MTOK, NB_IN, DM};
        pg8::StaticOrder S; S.init(MTOK, NB_IN, F.G, (int)blockIdx.x);
        pg8::EpiIn<1> E{(bf16*)(ws + WS_QKVB), SECB, (bf16*)(ws + WS_GATEB), part2, args.in[9], args.in[10], 0, QSCALE};
        pg8::gemm_phase<pg8::EpiIn<1>, pg8::StaticOrder, true>(F.lds + RING_OFF, g, S, E);
        if (BOTH(6)) xcd_barrier(bar);
    }
    if (IN(7)) {
        if (BOTH(7)) xcd_barrier(bar);
    }
    if (IN(8)) {
        pg8::Gemm g{XB, (const bf16*)(ws + WS_WBOUT), MTOK, DM, DM};
        pg8::StaticOrder S; S.init(MTOK, DM, F.G, (int)blockIdx.x);
        pg8::EpiOut E{args.out, args.out, nullptr, nullptr};
        pg8::gemm_phase<pg8::EpiOut, pg8::StaticOrder, true>(F.lds + RING_OFF, g, S, E);
    }
#undef IN
#undef BOTH
}

extern "C" void kernel_launch(void* const* d_in, const int* in_sizes, int n_in, void* d_out, int out_size, void* d_ws, size_t ws_size, hipStream_t stream) {
    static int grid = 0;
    if (grid == 0) {
        if (n_in != 12 || in_sizes[0] != MTOK * DM || out_size != MTOK * DM || ws_size < WS_END) { fprintf(stderr, "kernel_launch: unexpected shapes / workspace (%d inputs, ws %zu)\n", n_in, ws_size); grid = -1; return; }
        int dev = 0, cus = 0, per_cu = 0;
        if (hipGetDevice(&dev) != hipSuccess || hipDeviceGetAttribute(&cus, hipDeviceAttributeMultiprocessorCount, dev) != hipSuccess) { grid = -1; return; }
        if (hipFuncSetAttribute((const void*)fwd_kernel, hipFuncAttributeMaxDynamicSharedMemorySize, LDS_BYTES) != hipSuccess) { fprintf(stderr, "kernel_launch: hipFuncSetAttribute failed\n"); grid = -1; return; }
        if (hipOccupancyMaxActiveBlocksPerMultiprocessor(&per_cu, (const void*)fwd_kernel, NWAVES * 64, LDS_BYTES) != hipSuccess || per_cu < 1) { fprintf(stderr, "kernel_launch: occupancy query says %d blocks per CU\n", per_cu); per_cu = 1; }
        (void)hipGetLastError();
        grid = cus;
    }
    if (grid < 0) return;
    (void)hipMemsetAsync((char*)d_ws + WS_CTL, 0, CTL_ZERO_BYTES, stream);
    Args a{};
    for (int i = 0; i < 12; ++i) a.in[i] = (const float*)d_in[i];
    a.out = (float*)d_out; a.ws = (unsigned char*)d_ws;
    unsigned char* ws = (unsigned char*)d_ws;
    auto run = [&](int lo, int hi) { a.ph_lo = lo; a.ph_hi = hi; hipLaunchKernelGGL(fwd_kernel, dim3(grid), dim3(NWAVES * 64), LDS_BYTES, stream, a); };
    run(0, 1);
    for (int hf = 0; hf < 2; ++hf) {
        run(1 + 2 * hf, 2 + 2 * hf);
        naive_attn_a<<<(4 * NH * SEQ) / 256, 256, 0, stream>>>((const bf16*)(ws + WS_QKVA), (const bf16*)(ws + WS_GATEA), (bf16*)(ws + WS_XB) + (size_t)hf * MHALF * DM, (const float*)d_in[6]);
    }
    run(5, 6);
    run(6, 7);
    naive_attn_b<<<(BATCH * NH * SEQ) / 256, 256, 0, stream>>>((const bf16*)(ws + WS_QKVB), (const bf16*)(ws + WS_GATEB), (bf16*)(ws + WS_XB), (const float*)d_in[11]);
    run(8, 9);
}
```

```cpp
#include <hip/hip_runtime.h>
#include <cstdio>
#include <cstdint>
namespace pg8 {
#define PG8_LAS __attribute__((address_space(3)))
typedef unsigned short bf16_t;
typedef short bf16x8 __attribute__((ext_vector_type(8)));
typedef float f32x4 __attribute__((ext_vector_type(4)));
typedef unsigned u32x4 __attribute__((ext_vector_type(4)));
typedef unsigned u32x2 __attribute__((ext_vector_type(2)));
constexpr int BM = 256, BK = 64, HALF = 128, HTB = HALF * BK * 2  , STAGE_BYTES = 8 * HTB, NXCD = 8, WGM = 8;

__host__ __device__ __forceinline__ int lds_byte(int r, int c) { const int st = (r >> 4) * 2 + (c >> 5), rr = r & 15, cc = c & 31, ob = rr * 64 + cc * 2; return st * 1024 + (ob ^ (((ob >> 9) & 1) << 5)); }
__host__ __device__ __forceinline__ void stage_rc(int b, int& R, int& C) { const int st = b / 1024, sb = b % 1024, swz = sb ^ (((sb >> 9) & 1) << 5); R = (st >> 1) * 16 + swz / 64; C = (st & 1) * 32 + (swz % 64) / 2; }
__host__ __device__ __forceinline__ int perm32(int rho) { const int n = rho >> 4, i = rho & 15; return 8 * (i >> 2) + 4 * n + (i & 3); }

struct Unit { int pm, pn; };
struct Gemm { const bf16_t* A; const bf16_t* Bt; int M, N, K; };

struct StaticOrder {
    int nM, nN, nwg, G, c;
    __host__ __device__ void init(int M, int N, int G_, int c_) { nM = M / BM; nN = N / BM; nwg = nM * nN; G = G_; c = c_; }
    __host__ __device__ bool next(int i, Unit& u) const {
        const long L = (long)i * G + c; if (L >= nwg) return false;
        int wgid = (int)L; { const int q = nwg / NXCD, r = nwg % NXCD, xcd = wgid % NXCD, off = wgid / NXCD; wgid = (xcd < r ? xcd * (q + 1) : r * (q + 1) + (xcd - r) * q) + off; }
        const int nig = WGM * nN, gid = wgid / nig, fm = gid * WGM, gsz = (nM - fm) < WGM ? (nM - fm) : WGM;
        u.pm = fm + ((wgid % nig) % gsz); u.pn = (wgid % nig) / gsz; return true;
    }
};

__device__ __forceinline__ unsigned cvt_pk_bf16(float lo, float hi) { unsigned r; asm volatile("v_cvt_pk_bf16_f32 %0, %1, %2" : "=v"(r) : "v"(lo), "v"(hi)); return r; }


constexpr float RMS_EPS = 1e-6f;
template <int MODE> struct EpiIn {
    static constexpr bool HEADMAP = true;
    bf16_t* qkv; size_t sec_stride; bf16_t* gate; const float* rs; const float* qg; const float* kg; int row_base; float qscale;
    __device__ __forceinline__ void operator()(const f32x4 (&acc)[2][2][4][2], const Unit& u, int wr, int wc, int fr, int fq) const {
        const int sec = u.pn >> 2, hq = u.pn & 3, h = hq * 4 + wc;
        int type, g = 0;
        if (MODE == 0) { if (sec == 9) type = 3; else { g = sec / 3; type = sec - 3 * g; } } else type = sec;
        const int shift = (MODE == 0) ? 2 * g : 0;
        f32x4 gv[2][2];
#pragma unroll
        for (int bj = 0; bj < 2; ++bj)
#pragma unroll
            for (int n = 0; n < 2; ++n) gv[bj][n] = (f32x4){1.f, 1.f, 1.f, 1.f};
        if (type < 2) {
            const float* gp = (type == 0 ? qg : kg) + (MODE == 0 ? g * 64 : 0) + 8 * fq;
            const float sc = (type == 0) ? qscale : 1.f;
#pragma unroll
            for (int bj = 0; bj < 2; ++bj)
#pragma unroll
                for (int n = 0; n < 2; ++n) gv[bj][n] = *(const f32x4*)(gp + 32 * bj + 4 * n) * sc;
        }
#pragma unroll
        for (int ai = 0; ai < 2; ++ai)
#pragma unroll
            for (int m = 0; m < 4; ++m) {
                const int r = u.pm * BM + ai * HALF + wr * 64 + m * 16 + fr;
                float rsv;
                if (MODE == 0) rsv = rs[row_base + r];
                else { const f32x4 pp = *(const f32x4*)(rs + (size_t)(row_base + r) * 16 + 4 * fq); float s = (pp[0] + pp[1]) + (pp[2] + pp[3]); s += __shfl_xor(s, 16); s += __shfl_xor(s, 32); rsv = __builtin_amdgcn_rsqf(s * (1.0f / 1024.0f) + RMS_EPS); }
                f32x4 v[2][2];
#pragma unroll
                for (int bj = 0; bj < 2; ++bj)
#pragma unroll
                    for (int n = 0; n < 2; ++n) v[bj][n] = acc[ai][bj][m][n] * rsv;
                if (type < 2) {
                    float ss = 0.f;
#pragma unroll
                    for (int bj = 0; bj < 2; ++bj)
#pragma unroll
                        for (int n = 0; n < 2; ++n) { const f32x4 x = v[bj][n]; ss += (x[0] * x[0] + x[1] * x[1]) + (x[2] * x[2] + x[3] * x[3]); }
                    ss += __shfl_xor(ss, 16); ss += __shfl_xor(ss, 32);
                    const float inv = __builtin_amdgcn_rsqf(ss * (1.0f / 64.0f) + RMS_EPS);
#pragma unroll
                    for (int bj = 0; bj < 2; ++bj)
#pragma unroll
                        for (int n = 0; n < 2; ++n) v[bj][n] = v[bj][n] * gv[bj][n] * inv;
                } else if (type == 3) {
#pragma unroll
                    for (int bj = 0; bj < 2; ++bj)
#pragma unroll
                        for (int n = 0; n < 2; ++n)
#pragma unroll
                            for (int i = 0; i < 4; ++i) { const float x = v[bj][n][i]; v[bj][n][i] = x * __builtin_amdgcn_rcpf(1.0f + __expf(-x)); }
                }
                bf16_t* p;
                if (type < 3) { const int t = r & 4095, bl = r >> 12; const int pos = ((t & ((1 << shift) - 1)) << (12 - shift)) | (t >> shift);
                    p = qkv + (size_t)sec * sec_stride + ((size_t)(bl * 16 + h) * 4096 + pos) * 64 + 8 * fq; }
                else p = gate + (size_t)r * 1024 + hq * 256 + wc * 64 + 8 * fq;
#pragma unroll
                for (int bj = 0; bj < 2; ++bj) { u32x4 w; w.x = cvt_pk_bf16(v[bj][0][0], v[bj][0][1]); w.y = cvt_pk_bf16(v[bj][0][2], v[bj][0][3]); w.z = cvt_pk_bf16(v[bj][1][0], v[bj][1][1]); w.w = cvt_pk_bf16(v[bj][1][2], v[bj][1][3]);
                    *(u32x4*)(p + 32 * bj) = w; }
            }
    }
};

struct EpiOut {
    static constexpr bool HEADMAP = false;
    const float* base; float* out; bf16_t* xb; float* part;
    __device__ __forceinline__ void operator()(const f32x4 (&acc)[2][2][4][2], const Unit& u, int wr, int wc, int fr, int fq) const {
#pragma unroll
        for (int ai = 0; ai < 2; ++ai)
#pragma unroll
            for (int m = 0; m < 4; ++m) {
                const int r = u.pm * BM + ai * HALF + wr * 64 + m * 16 + fr;
                const size_t off = (size_t)r * 1024 + u.pn * BM + wc * 32 + 4 * fq;
                float ss = 0.f;
#pragma unroll
                for (int bj = 0; bj < 2; ++bj)
#pragma unroll
                    for (int n = 0; n < 2; ++n) {
                        const f32x4 bs = *(const f32x4*)(base + off + bj * HALF + n * 16);
                        const f32x4 o = bs + acc[ai][bj][m][n];
                        *(f32x4*)(out + off + bj * HALF + n * 16) = o;
                        if (xb) { u32x2 w; w.x = cvt_pk_bf16(o[0], o[1]); w.y = cvt_pk_bf16(o[2], o[3]); *(u32x2*)(xb + off + bj * HALF + n * 16) = w; }
                        ss += (o[0] * o[0] + o[1] * o[1]) + (o[2] * o[2] + o[3] * o[3]);
                    }
                if (part) { ss += __shfl_xor(ss, 16); ss += __shfl_xor(ss, 32); if (fq == 0) part[(size_t)r * 16 + u.pn * 4 + wc] = ss; }
            }
    }
};

template <class Epi, class Sched, bool ALIGN_EPI>
__device__ __forceinline__ void gemm_phase(PG8_LAS unsigned char* lds, const Gemm g, const Sched& S, const Epi& E) {
    const int tid = threadIdx.x, wid = __builtin_amdgcn_readfirstlane(tid >> 6), lane = tid & 63, wr = wid >> 2, wc = wid & 3, fr = lane & 15, fq = lane >> 4;
    const int K = g.K, nt = K / BK;
    unsigned voffA[2], voffB[2];
#pragma unroll
    for (int i = 0; i < 2; ++i) { int R, C; stage_rc(tid * 16 + i * 8192, R, C);
        const int Rb = Epi::HEADMAP ? (64 * (R >> 5) + perm32(R & 31)) : R;
        voffA[i] = (unsigned)(R * K + C) * 2u; voffB[i] = (unsigned)(Rb * K + C) * 2u; }
    const size_t kstep = (size_t)(BK * 2);
    const size_t hstep = (size_t)HALF * K * 2;
    const size_t hstepB = Epi::HEADMAP ? (size_t)32 * K * 2 : hstep;
    const size_t tstep = 2 * hstep;
    const unsigned ldsw = (unsigned)wid * 1024u;
    const int aoff = lds_byte(wr * 64 + fr, fq * 8), boff = lds_byte(wc * 32 + fr, fq * 8);
#define PG8_SA(b, h) (((b) * 2 + (h)) * HTB)
#define PG8_SB(b, h) ((4 + (b) * 2 + (h)) * HTB)
#define PG8_STAGE(bufoff, gbase, voff) do { _Pragma("unroll") for (int _i = 0; _i < 2; ++_i) \
        __builtin_amdgcn_global_load_lds((const unsigned*)((const char*)(gbase) + (voff)[_i]), (PG8_LAS unsigned*)(lds + (bufoff) + ldsw + _i * 8192), 16, 0, 0); } while (0)
#define PG8_LDA(dst, b, h) do { _Pragma("unroll") for (int m = 0; m < 4; ++m) _Pragma("unroll") for (int k = 0; k < 2; ++k) dst[m][k] = *(const PG8_LAS bf16x8*)(lds + PG8_SA(b, h) + aoff + m * 2048 + k * 1024); } while (0)
#define PG8_LDB(dst, b, h) do { _Pragma("unroll") for (int n = 0; n < 2; ++n) _Pragma("unroll") for (int k = 0; k < 2; ++k) dst[n][k] = *(const PG8_LAS bf16x8*)(lds + PG8_SB(b, h) + boff + n * 2048 + k * 1024); } while (0)
#define PG8_MMA(ai, bj, At, Bt) do { __builtin_amdgcn_s_setprio(1); _Pragma("unroll") for (int m = 0; m < 4; ++m) _Pragma("unroll") for (int n = 0; n < 2; ++n) _Pragma("unroll") for (int k = 0; k < 2; ++k) \
        acc[ai][bj][m][n] = __builtin_amdgcn_mfma_f32_16x16x32_bf16(Bt[n][k], At[m][k], acc[ai][bj][m][n], 0, 0, 0); __builtin_amdgcn_s_setprio(0); } while (0)
#define PG8_WAIT_V(n) asm volatile("s_waitcnt vmcnt(" #n ")" ::: "memory")
#define PG8_WAIT_L(n) asm volatile("s_waitcnt lgkmcnt(" #n ")" ::: "memory")
#define PG8_BAR __builtin_amdgcn_s_barrier()
#define PG8_SCHED __builtin_amdgcn_sched_barrier(0)
    Unit cur, nxt; int ui = 0;
    if (!S.next(0, cur)) return;
    f32x4 acc[2][2][4][2];
#pragma unroll
    for (int a = 0; a < 2; ++a)
#pragma unroll
        for (int b = 0; b < 2; ++b)
#pragma unroll
            for (int m = 0; m < 4; ++m)
#pragma unroll
                for (int n = 0; n < 2; ++n) acc[a][b][m][n] = (f32x4){0.f, 0.f, 0.f, 0.f};
    bf16x8 At[4][2], B0[2][2], B1[2][2];
    const char* cA = (const char*)g.A + (size_t)cur.pm * tstep; const char* cB = (const char*)g.Bt + (size_t)cur.pn * tstep;
    PG8_STAGE(PG8_SB(0, 0), cB, voffB); PG8_STAGE(PG8_SB(0, 1), cB + hstepB, voffB); PG8_STAGE(PG8_SA(0, 0), cA, voffA); PG8_STAGE(PG8_SA(0, 1), cA + hstep, voffA);
    if (wr == 1) PG8_BAR;
    PG8_WAIT_V(2); PG8_BAR;
    PG8_STAGE(PG8_SB(1, 0), cB + kstep, voffB); PG8_STAGE(PG8_SA(1, 0), cA + kstep, voffA); PG8_STAGE(PG8_SB(1, 1), cB + hstepB + kstep, voffB);
    PG8_WAIT_V(6); PG8_BAR;
    for (;;) {
        const bool has_next = S.next(ui + 1, nxt);
        const char* nA = has_next ? (const char*)g.A + (size_t)nxt.pm * tstep : cA; const char* nB = has_next ? (const char*)g.Bt + (size_t)nxt.pn * tstep : cB;
        for (int t = 0; t < nt; t += 2) {
            const bool last = (t == nt - 2);
            const char* a1 = cA + (size_t)(t + 1) * kstep;
            const char* a2 = last ? nA : cA + (size_t)(t + 2) * kstep; const char* b2 = last ? nB : cB + (size_t)(t + 2) * kstep;
            const char* a3 = a2 + kstep; const char* b3 = b2 + kstep;
            PG8_LDB(B0, 0, 0); PG8_LDB(B1, 0, 1); PG8_SCHED; PG8_LDA(At, 0, 0); PG8_STAGE(PG8_SA(1, 1), a1 + hstep, voffA);
            PG8_WAIT_V(8); PG8_WAIT_L(0); PG8_BAR; PG8_MMA(0, 0, At, B0); PG8_MMA(0, 1, At, B1); PG8_BAR; PG8_SCHED;
            PG8_LDA(At, 0, 1); PG8_STAGE(PG8_SB(0, 0), b2, voffB); PG8_STAGE(PG8_SB(0, 1), b2 + hstepB, voffB); PG8_STAGE(PG8_SA(0, 0), a2, voffA);
            PG8_WAIT_V(8); PG8_WAIT_L(0); PG8_BAR; PG8_MMA(1, 0, At, B0); PG8_MMA(1, 1, At, B1); PG8_BAR; PG8_SCHED;
            PG8_LDB(B0, 1, 0); PG8_LDB(B1, 1, 1); PG8_SCHED; PG8_LDA(At, 1, 0); PG8_STAGE(PG8_SA(0, 1), a2 + hstep, voffA);
            PG8_WAIT_V(8); PG8_WAIT_L(0); PG8_BAR; PG8_MMA(0, 0, At, B0); PG8_MMA(0, 1, At, B1); PG8_BAR; PG8_SCHED;
            PG8_LDA(At, 1, 1); PG8_STAGE(PG8_SB(1, 0), b3, voffB); PG8_STAGE(PG8_SB(1, 1), b3 + hstepB, voffB); PG8_STAGE(PG8_SA(1, 0), a3, voffA);
            PG8_WAIT_V(8); PG8_WAIT_L(0); PG8_BAR; PG8_MMA(1, 0, At, B0); PG8_MMA(1, 1, At, B1); PG8_BAR; PG8_SCHED;
        }
        if constexpr (ALIGN_EPI) { if (wr == 0) PG8_BAR; }
        E(acc, cur, wr, wc, fr, fq);
        if (!has_next) break;
#pragma unroll
        for (int a = 0; a < 2; ++a)
#pragma unroll
            for (int b = 0; b < 2; ++b)
#pragma unroll
                for (int m = 0; m < 4; ++m)
#pragma unroll
                    for (int n = 0; n < 2; ++n) acc[a][b][m][n] = (f32x4){0.f, 0.f, 0.f, 0.f};
        cur = nxt; cA = nA; cB = nB; ++ui;
        if constexpr (ALIGN_EPI) { if (wr == 1) PG8_BAR; }
    }
    PG8_WAIT_V(0);
    if constexpr (!ALIGN_EPI) { if (wr == 0) PG8_BAR; }
    PG8_BAR;
#undef PG8_SA
#undef PG8_SB
#undef PG8_STAGE
#undef PG8_LDA
#undef PG8_LDB
#undef PG8_MMA
#undef PG8_WAIT_V
#undef PG8_WAIT_L
#undef PG8_BAR
#undef PG8_SCHED
}
}
constexpr int NWAVES = 8;
constexpr int BATCH = 8, SEQ = 4096, DM = 1024, NH = 16, HD = 64;
constexpr int MTOK = BATCH * SEQ;
constexpr int MHALF = MTOK / 2;
constexpr int NA_IN = 10240, NB_IN = 4096;
constexpr float LOG2E = 1.4426950408889634f;
constexpr float QSCALE = 0.125f * LOG2E;

constexpr size_t MiB = 1u << 20;
constexpr size_t WS_CTL = 0, CTL_ZERO_BYTES = 1 * MiB;
constexpr size_t WS_RSTD1 = 1 * MiB;
constexpr size_t WS_PART2 = 2 * MiB;
constexpr size_t WS_WAIN = 4 * MiB, WS_WAOUT = 24 * MiB, WS_WBIN = 26 * MiB, WS_WBOUT = 34 * MiB;
constexpr size_t WS_XB = 36 * MiB;
constexpr size_t WS_QKVA = 100 * MiB;
constexpr size_t SECA = (size_t)4 * NH * SEQ * HD;
constexpr size_t WS_GATEA = WS_QKVA + 9 * 32 * MiB;
constexpr size_t WS_X1B = 100 * MiB;
constexpr size_t WS_QKVB = 164 * MiB;
constexpr size_t SECB = (size_t)8 * NH * SEQ * HD;
constexpr size_t WS_GATEB = WS_QKVB + 3 * 64 * MiB;
constexpr size_t WS_END = 420 * MiB;
static_assert(WS_GATEA + 32 * MiB <= WS_END && WS_GATEB + 64 * MiB <= WS_END && WS_X1B + 64 * MiB <= WS_QKVB, "ws map");
constexpr int CW_BAR = 4096;

constexpr int RING_OFF = 0, RING_BYTES = 131072;
constexpr int LDSCTL_OFF = RING_BYTES, MISC_OFF = LDSCTL_OFF + 320;
constexpr int LDS_BYTES = 147456;

#define GAS __attribute__((address_space(1)))
#define LAS __attribute__((address_space(3)))
typedef unsigned short bf16;
typedef unsigned v4u __attribute__((ext_vector_type(4)));
typedef unsigned v2u __attribute__((ext_vector_type(2)));
typedef float f32x4 __attribute__((ext_vector_type(4)));
typedef short bf16x8 __attribute__((ext_vector_type(8)));
typedef GAS unsigned gu32;
#define RLX_AGENT __ATOMIC_RELAXED, __HIP_MEMORY_SCOPE_AGENT
#define LDS_WAIT() asm volatile("s_waitcnt lgkmcnt(0)" ::: "memory")
#define VM_WAIT() asm volatile("s_waitcnt vmcnt(0)" ::: "memory")
__device__ __forceinline__ unsigned f2bf(float f) { unsigned u = __builtin_bit_cast(unsigned, f); return (u + 0x7fffu + ((u >> 16) & 1u)) >> 16; }
__device__ __forceinline__ unsigned pk2(float lo, float hi) { return f2bf(lo) | (f2bf(hi) << 16); }
__device__ __forceinline__ float bf2f(unsigned short h) { return __builtin_bit_cast(float, (unsigned)h << 16); }

#define XB_TMO      128
#define XB_XCNT(j)  (256  + 64 * (j))
#define XB_XSUB(j)  (1280 + 64 * (j))
#define XB_XGEN(j)  (2304 + 64 * (j))
#define XB_TOP      3328
#define XB_TOPGEN   3392
#define XCD_BAR_WORDS 3456
#define XB_SPIN_CAP (1u << 18)
__device__ __forceinline__ unsigned xb_ld(unsigned* p)              { return __hip_atomic_load(p, __ATOMIC_RELAXED, __HIP_MEMORY_SCOPE_AGENT); }
__device__ __forceinline__ unsigned xb_add(unsigned* p, unsigned v) { return __hip_atomic_fetch_add(p, v, __ATOMIC_RELAXED, __HIP_MEMORY_SCOPE_AGENT); }
__device__ __forceinline__ unsigned xb_xcc_id() { return (unsigned)__builtin_amdgcn_s_getreg((3 << 11) | 20) & 0xFu; }
#define XB_SPIN(cond, bar) do { unsigned _sp = 0; while (cond) { __builtin_amdgcn_s_sleep(1); \
    if ((++_sp & 255u) == 0u) { if (xb_ld(&(bar)[XB_TMO])) break; if (_sp > XB_SPIN_CAP) { atomicAdd(&(bar)[XB_TMO], 1u); break; } } } } while (0)
struct XcdBarrier { unsigned* bar; unsigned x; volatile LAS unsigned* st; };
__device__ __forceinline__ XcdBarrier xcd_barrier_post(unsigned* bar, volatile LAS unsigned* st) {
    XcdBarrier b; b.bar = bar; b.x = xb_xcc_id(); b.st = st;
    if (threadIdx.x == 0) (void)xb_add(&bar[XB_XCNT(b.x)], 1u);
    return b;
}
__device__ __forceinline__ void xcd_barrier_complete(unsigned* bar, unsigned x, unsigned& nloc, unsigned& nx) {
    const unsigned G = gridDim.x * gridDim.y * gridDim.z;
    unsigned sum, cnt, mine, sp = 0u;
    for (;;) {
        sum = 0u; cnt = 0u; mine = 0u;
#pragma unroll
        for (unsigned j = 0; j < 16; ++j) { const unsigned c = xb_ld(&bar[XB_XCNT(j)]); sum += c; cnt += (c > 0u) ? 1u : 0u; mine = (j == x) ? c : mine; }
        if (sum == G) break;
        __builtin_amdgcn_s_sleep(1);
        if ((++sp & 255u) == 0u) { if (xb_ld(&bar[XB_TMO])) break; if (sp > XB_SPIN_CAP) { atomicAdd(&bar[XB_TMO], 1u); break; } }
    }
    nloc = mine > 0u ? mine : 1u; nx = cnt > 0u ? cnt : 1u;
}
__device__ __forceinline__ void xcd_barrier(const XcdBarrier& b) {
    asm volatile("s_waitcnt vmcnt(0)" ::: "memory");
    __syncthreads();
    if (threadIdx.x == 0) {
        unsigned* bar = b.bar;
        __builtin_amdgcn_s_waitcnt(0);
        unsigned nloc = b.st[0], nx = b.st[1];
        if (nloc == 0u) { xcd_barrier_complete(bar, b.x, nloc, nx); b.st[0] = nloc; b.st[1] = nx; }
        const unsigned old = xb_add(&bar[XB_XSUB(b.x)], 1u);
        const unsigned gen = old / nloc;
        if (old + 1u == (gen + 1u) * nloc) {
            __builtin_amdgcn_fence(__ATOMIC_RELEASE, "agent");
            asm volatile("s_waitcnt vmcnt(0)" ::: "memory");
            const unsigned og = xb_add(&bar[XB_TOP], 1u);
            const unsigned tg = og / nx;
            if (og + 1u == (tg + 1u) * nx) xb_add(&bar[XB_TOPGEN], 1u);
            else XB_SPIN(xb_ld(&bar[XB_TOPGEN]) == tg, bar);
            __builtin_amdgcn_fence(__ATOMIC_ACQUIRE, "agent");
            xb_add(&bar[XB_XGEN(b.x)], 1u);
            asm volatile("s_waitcnt vmcnt(0)" ::: "memory");
        } else {
            XB_SPIN(xb_ld(&bar[XB_XGEN(b.x)]) == gen, bar);
            __builtin_amdgcn_fence(__ATOMIC_ACQUIRE, "agent");
            asm volatile("s_waitcnt vmcnt(0)" ::: "memory");
        }
    }
    __syncthreads();
}

struct Frame {
    LAS unsigned char* lds;
    volatile LAS unsigned* MISC;
    gu32* ctl;
    int tid, lane, wave, vcu, G;
};

__device__ __forceinline__ float wave_sum(float v) {
#pragma unroll
    for (int o = 1; o < 64; o <<= 1) v += __shfl_xor(v, o);
    return v;
}
__device__ __forceinline__ void p0_transpose_item(const float* W, int K, int N, bf16* WT, const float* gk, LAS float* scr, int item, int lane) {
    const int nblk = N / 32, kb = item / nblk, nb = item % nblk, k0 = 64 * kb, n0 = 32 * nb;
#pragma unroll 8
    for (int i = 0; i < 32; ++i) { const int kk = 2 * i + (lane >> 5); const float gsc = gk ? gk[k0 + kk] : 1.0f; scr[kk * 33 + (lane & 31)] = W[(size_t)(k0 + kk) * N + n0 + (lane & 31)] * gsc; }
    LDS_WAIT(); asm volatile("" ::: "memory");
    const int c = lane & 7;
#pragma unroll
    for (int j = 0; j < 4; ++j) { const int n = (lane >> 3) + 8 * j; const LAS float* s = scr + (8 * c) * 33 + n;
        v4u o; o.x = pk2(s[0 * 33], s[1 * 33]); o.y = pk2(s[2 * 33], s[3 * 33]); o.z = pk2(s[4 * 33], s[5 * 33]); o.w = pk2(s[6 * 33], s[7 * 33]);
        *(GAS v4u*)(WT + (size_t)(n0 + n) * K + k0 + 8 * c) = o; }
    LDS_WAIT(); asm volatile("" ::: "memory");
}
__device__ __forceinline__ int t5_bucket_dev(int rel) {
    const int n = rel < 0 ? -rel : rel;
    const int b = n < 8 ? n : 8 + (n >= 15) + (n >= 27) + (n >= 50) + (n >= 91) + (n >= 167) + (n >= 305) + (n >= 559);
    return b + (rel > 0 ? 16 : 0);
}
__device__ __forceinline__ void ld_row64p(const bf16* p, unsigned (&w)[32]) {
#pragma unroll
    for (int i = 0; i < 8; ++i) { const v4u x = *(const v4u*)(p + 8 * i); w[4 * i] = x.x; w[4 * i + 1] = x.y; w[4 * i + 2] = x.z; w[4 * i + 3] = x.w; }
}
__device__ __forceinline__ float dot_row64p(const bf16* p, const unsigned (&q)[32]) {
    float s = 0.f;
#pragma unroll
    for (int i = 0; i < 8; ++i) { const v4u x = *(const v4u*)(p + 8 * i); const unsigned kw[4] = {x.x, x.y, x.z, x.w};
#pragma unroll
        for (int j = 0; j < 4; ++j) { s += __builtin_bit_cast(float, q[4 * i + j] << 16) * __builtin_bit_cast(float, kw[j] << 16); s += __builtin_bit_cast(float, q[4 * i + j] & 0xffff0000u) * __builtin_bit_cast(float, kw[j] & 0xffff0000u); } }
    return s;
}
__device__ __forceinline__ void ld_row64(const bf16* p, float (&f)[64]) {
#pragma unroll
    for (int i = 0; i < 8; ++i) { const v4u w = *(const v4u*)(p + 8 * i);
        f[8 * i + 0] = __builtin_bit_cast(float, w.x << 16); f[8 * i + 1] = __builtin_bit_cast(float, w.x & 0xffff0000u);
        f[8 * i + 2] = __builtin_bit_cast(float, w.y << 16); f[8 * i + 3] = __builtin_bit_cast(float, w.y & 0xffff0000u);
        f[8 * i + 4] = __builtin_bit_cast(float, w.z << 16); f[8 * i + 5] = __builtin_bit_cast(float, w.z & 0xffff0000u);
        f[8 * i + 6] = __builtin_bit_cast(float, w.w << 16); f[8 * i + 7] = __builtin_bit_cast(float, w.w & 0xffff0000u); }
}

__device__ __forceinline__ void ld_row32(const bf16* p, float (&f)[32]) {
#pragma unroll
    for (int i = 0; i < 4; ++i) { const v4u w = *(const v4u*)(p + 8 * i);
        f[8 * i + 0] = __builtin_bit_cast(float, w.x << 16); f[8 * i + 1] = __builtin_bit_cast(float, w.x & 0xffff0000u);
        f[8 * i + 2] = __builtin_bit_cast(float, w.y << 16); f[8 * i + 3] = __builtin_bit_cast(float, w.y & 0xffff0000u);
        f[8 * i + 4] = __builtin_bit_cast(float, w.z << 16); f[8 * i + 5] = __builtin_bit_cast(float, w.z & 0xffff0000u);
        f[8 * i + 6] = __builtin_bit_cast(float, w.w << 16); f[8 * i + 7] = __builtin_bit_cast(float, w.w & 0xffff0000u); }
}
__device__ __forceinline__ void st_row32(bf16* yp, const bf16* gp, const float (&o)[32], float inv) {
#pragma unroll
    for (int i = 0; i < 4; ++i) { const v4u gw = *(const v4u*)(gp + 8 * i); v4u w;
        w.x = pk2(o[8 * i + 0] * inv * __builtin_bit_cast(float, gw.x << 16), o[8 * i + 1] * inv * __builtin_bit_cast(float, gw.x & 0xffff0000u));
        w.y = pk2(o[8 * i + 2] * inv * __builtin_bit_cast(float, gw.y << 16), o[8 * i + 3] * inv * __builtin_bit_cast(float, gw.y & 0xffff0000u));
        w.z = pk2(o[8 * i + 4] * inv * __builtin_bit_cast(float, gw.z << 16), o[8 * i + 5] * inv * __builtin_bit_cast(float, gw.z & 0xffff0000u));
        w.w = pk2(o[8 * i + 6] * inv * __builtin_bit_cast(float, gw.w << 16), o[8 * i + 7] * inv * __builtin_bit_cast(float, gw.w & 0xffff0000u));
        *(v4u*)(yp + 8 * i) = w; }
}
__device__ __forceinline__ void naive_attn_a(const int idx, const bf16* qkv, const bf16* gate, bf16* y, const float* t5) {
    const int t = idx & 4095, h = (idx >> 12) & 15, bl = idx >> 16;
#pragma unroll 1
    for (int dh = 0; dh < 2; ++dh) {
        float m = -1e30f, l = 0.f; float o[32];
#pragma unroll
        for (int d = 0; d < 32; ++d) o[d] = 0.f;
#pragma unroll 1
        for (int g = 0; g < 3; ++g) {
            const int sh = 2 * g, dil = 1 << sh, L = 4096 >> sh, res = t & (dil - 1), mq = t >> sh;
            const bf16* Q = qkv + (size_t)(3 * g) * SECA + ((size_t)(bl * 16 + h) * 4096) * 64;
            const bf16* K = Q + SECA; const bf16* V = K + SECA;
            unsigned q[32]; ld_row64p(Q + (size_t)(res * L + mq) * 64, q);
#pragma unroll 1
            for (int dm = -64; dm <= 64; ++dm) {
                const int mk = mq + dm; if (mk < 0 || mk >= L) continue;
                float s = dot_row64p(K + (size_t)(res * L + mk) * 64, q);
                s += LOG2E * t5[(g * 16 + h) * 32 + t5_bucket_dev(dm * dil)];
                const float mn = fmaxf(m, s), a = exp2f(m - mn), p = exp2f(s - mn);
                l = l * a + p; m = mn;
                float vf[32]; ld_row32(V + (size_t)(res * L + mk) * 64 + 32 * dh, vf);
#pragma unroll
                for (int d = 0; d < 32; ++d) o[d] = o[d] * a + p * vf[d];
            }
        }
        const size_t row = (size_t)(bl * 4096 + t) * 1024 + h * 64 + 32 * dh;
        st_row32(y + row, gate + row, o, 1.0f / l);
    }
}
__device__ __forceinline__ void naive_attn_b(const int idx, const bf16* qkv, const bf16* gate, bf16* y, const float* rpb) {
    const int t = idx & 4095, h = (idx >> 12) & 15, b = idx >> 16;
    const int r = t >> 6, c = t & 63; const int rs = min(max(r - 4, 0), 56), cs = min(max(c - 8, 0), 48);
    const bf16* Q = qkv + ((size_t)(b * 16 + h) * 4096) * 64; const bf16* K = Q + SECB; const bf16* V = K + SECB;
#pragma unroll 1
    for (int dh = 0; dh < 2; ++dh) {
        float m = -1e30f, l = 0.f; float o[32];
#pragma unroll
        for (int d = 0; d < 32; ++d) o[d] = 0.f;
        unsigned q[32]; ld_row64p(Q + (size_t)t * 64, q);
#pragma unroll 1
        for (int kk = 0; kk < 128; ++kk) {
            const int kr = rs + (kk >> 4), kc = cs + (kk & 15);
            const int kt = kr * 64 + kc;
            float s = dot_row64p(K + (size_t)kt * 64, q);
            s += LOG2E * rpb[(h * 15 + (kr - r + 7)) * 31 + (kc - c + 15)];
            const float mn = fmaxf(m, s), a = exp2f(m - mn), p = exp2f(s - mn);
            l = l * a + p; m = mn;
            float vf[32]; ld_row32(V + (size_t)kt * 64 + 32 * dh, vf);
#pragma unroll
            for (int d = 0; d < 32; ++d) o[d] = o[d] * a + p * vf[d];
        }
        const size_t row = (size_t)(b * 4096 + t) * 1024 + h * 64 + 32 * dh;
        st_row32(y + row, gate + row, o, 1.0f / l);
    }
}
struct Args { const float* in[12]; float* out; unsigned char* ws; int ph_lo, ph_hi; };
__global__ void __launch_bounds__(NWAVES * 64, 2) fwd_kernel(Args args) {
    extern __shared__ __attribute__((aligned(16))) unsigned char lds[];
    Frame F;
    F.lds = (LAS unsigned char*)lds;
    F.MISC = (volatile LAS unsigned*)(F.lds + MISC_OFF);
    F.tid = threadIdx.x; F.lane = F.tid & 63; F.wave = __builtin_amdgcn_readfirstlane(F.tid >> 6);
    F.G = gridDim.x; { const int bx = blockIdx.x; F.vcu = (F.G % 8 == 0) ? (bx % 8) * (F.G / 8) + bx / 8 : bx; }
    unsigned char* ws = args.ws;
    F.ctl = (gu32*)(ws + WS_CTL);
    for (int u = F.tid; u < (LDS_BYTES - LDSCTL_OFF) / 4; u += NWAVES * 64) ((LAS unsigned*)(F.lds + LDSCTL_OFF))[u] = 0u;
    __syncthreads();
    XcdBarrier bar = xcd_barrier_post((unsigned*)(F.ctl + CW_BAR), F.MISC + 8);
    const int lo = args.ph_lo, hi = args.ph_hi;
#define IN(k) (lo <= (k) && (k) < hi)
#define BOTH(k) (IN(k) && IN((k) + 1))
    const float* x = args.in[0]; const float* norm_gain = args.in[1];
    bf16* XB = (bf16*)(ws + WS_XB);
    float* rstd1 = (float*)(ws + WS_RSTD1); float* part2 = (float*)(ws + WS_PART2);

    if (IN(0)) {
        LAS float* scr = (LAS float*)(F.lds + RING_OFF + F.wave * 16384);
        const int gw = F.vcu * NWAVES + F.wave, NGW = F.G * NWAVES;
        constexpr int I_AIN = (DM / 64) * (NA_IN / 32), I_O = (DM / 64) * (DM / 32), I_BIN = (DM / 64) * (NB_IN / 32);
        constexpr int NITEMS = I_AIN + I_O + I_BIN + I_O;
        for (int it = gw; it < NITEMS; it += NGW) {
            int r = it;
            if (r < I_AIN) { p0_transpose_item(args.in[2], DM, NA_IN, (bf16*)(ws + WS_WAIN), norm_gain, scr, r, F.lane); continue; } r -= I_AIN;
            if (r < I_O) { p0_transpose_item(args.in[3], DM, DM, (bf16*)(ws + WS_WAOUT), nullptr, scr, r, F.lane); continue; } r -= I_O;
            if (r < I_BIN) { p0_transpose_item(args.in[7], DM, NB_IN, (bf16*)(ws + WS_WBIN), norm_gain + DM, scr, r, F.lane); continue; } r -= I_BIN;
            p0_transpose_item(args.in[8], DM, DM, (bf16*)(ws + WS_WBOUT), nullptr, scr, r, F.lane);
        }
        for (int m = gw; m < MTOK; m += NGW) {
            const GAS f32x4* xr = (const GAS f32x4*)(x + (size_t)m * DM) + F.lane;
            f32x4 v[4]; float s = 0.f;
#pragma unroll
            for (int j = 0; j < 4; ++j) { v[j] = xr[64 * j]; s += (v[j].x * v[j].x + v[j].y * v[j].y) + (v[j].z * v[j].z + v[j].w * v[j].w); }
            s = wave_sum(s);
            if (F.lane == 0) rstd1[m] = __builtin_amdgcn_rsqf(s * (1.0f / DM) + pg8::RMS_EPS);
            GAS v2u* o8 = (GAS v2u*)(XB + (size_t)m * DM) + F.lane;
#pragma unroll
            for (int j = 0; j < 4; ++j) { v2u w; w.x = pk2(v[j].x, v[j].y); w.y = pk2(v[j].z, v[j].w); o8[64 * j] = w; }
        }
        if (BOTH(0)) xcd_barrier(bar);
    }
    for (int hf = 0; hf < 2; ++hf) {
        if (IN(1 + 2 * hf)) {
            pg8::Gemm g{XB + (size_t)hf * MHALF * DM, (const bf16*)(ws + WS_WAIN), MHALF, NA_IN, DM};
            pg8::StaticOrder S; S.init(MHALF, NA_IN, F.G, (int)blockIdx.x);
            pg8::EpiIn<0> E{(bf16*)(ws + WS_QKVA), SECA, (bf16*)(ws + WS_GATEA), rstd1, args.in[4], args.in[5], hf * MHALF, QSCALE};
            pg8::gemm_phase<pg8::EpiIn<0>, pg8::StaticOrder, true>(F.lds + RING_OFF, g, S, E);
            if (BOTH(1 + 2 * hf)) xcd_barrier(bar);
        }
        if (IN(2 + 2 * hf)) {
            for (int idx = blockIdx.x * (NWAVES * 64) + F.tid; idx < 4 * NH * SEQ; idx += F.G * NWAVES * 64)
                naive_attn_a(idx, (const bf16*)(ws + WS_QKVA), (const bf16*)(ws + WS_GATEA), XB + (size_t)hf * MHALF * DM, args.in[6]);
            if (BOTH(2 + 2 * hf)) xcd_barrier(bar);
        }
    }
    if (IN(5)) {
        pg8::Gemm g{XB, (const bf16*)(ws + WS_WAOUT), MTOK, DM, DM};
        pg8::StaticOrder S; S.init(MTOK, DM, F.G, (int)blockIdx.x);
        pg8::EpiOut E{x, args.out, (bf16*)(ws + WS_X1B), part2};
        pg8::gemm_phase<pg8::EpiOut, pg8::StaticOrder, true>(F.lds + RING_OFF, g, S, E);
        if (BOTH(5)) xcd_barrier(bar);
    }
    if (IN(6)) {
        pg8::Gemm g{(const bf16*)(ws + WS_X1B), (const bf16*)(ws + WS_WBIN), MTOK, NB_IN, DM};
        pg8::StaticOrder S; S.init(MTOK, NB_IN, F.G, (int)blockIdx.x);
        pg8::EpiIn<1> E{(bf16*)(ws + WS_QKVB), SECB, (bf16*)(ws + WS_GATEB), part2, args.in[9], args.in[10], 0, QSCALE};
        pg8::gemm_phase<pg8::EpiIn<1>, pg8::StaticOrder, true>(F.lds + RING_OFF, g, S, E);
        if (BOTH(6)) xcd_barrier(bar);
    }
    if (IN(7)) {
        for (int idx = blockIdx.x * (NWAVES * 64) + F.tid; idx < BATCH * NH * SEQ; idx += F.G * NWAVES * 64)
            naive_attn_b(idx, (const bf16*)(ws + WS_QKVB), (const bf16*)(ws + WS_GATEB), XB, args.in[11]);
        if (BOTH(7)) xcd_barrier(bar);
    }
    if (IN(8)) {
        pg8::Gemm g{XB, (const bf16*)(ws + WS_WBOUT), MTOK, DM, DM};
        pg8::StaticOrder S; S.init(MTOK, DM, F.G, (int)blockIdx.x);
        pg8::EpiOut E{args.out, args.out, nullptr, nullptr};
        pg8::gemm_phase<pg8::EpiOut, pg8::StaticOrder, true>(F.lds + RING_OFF, g, S, E);
    }
#undef IN
#undef BOTH
}

extern "C" void kernel_launch(void* const* d_in, const int* in_sizes, int n_in, void* d_out, int out_size, void* d_ws, size_t ws_size, hipStream_t stream) {
    static int grid = 0;
    if (grid == 0) {
        if (n_in != 12 || in_sizes[0] != MTOK * DM || out_size != MTOK * DM || ws_size < WS_END) { fprintf(stderr, "kernel_launch: unexpected shapes / workspace (%d inputs, ws %zu)\n", n_in, ws_size); grid = -1; return; }
        int dev = 0, cus = 0, per_cu = 0;
        if (hipGetDevice(&dev) != hipSuccess || hipDeviceGetAttribute(&cus, hipDeviceAttributeMultiprocessorCount, dev) != hipSuccess) { grid = -1; return; }
        if (hipFuncSetAttribute((const void*)fwd_kernel, hipFuncAttributeMaxDynamicSharedMemorySize, LDS_BYTES) != hipSuccess) { fprintf(stderr, "kernel_launch: hipFuncSetAttribute failed\n"); grid = -1; return; }
        if (hipOccupancyMaxActiveBlocksPerMultiprocessor(&per_cu, (const void*)fwd_kernel, NWAVES * 64, LDS_BYTES) != hipSuccess || per_cu < 1) { fprintf(stderr, "kernel_launch: occupancy query says %d blocks per CU\n", per_cu); per_cu = 1; }
        (void)hipGetLastError();
        grid = cus;
    }
    if (grid < 0) return;
    (void)hipMemsetAsync((char*)d_ws + WS_CTL, 0, CTL_ZERO_BYTES, stream);
    Args a{};
    for (int i = 0; i < 12; ++i) a.in[i] = (const float*)d_in[i];
    a.out = (float*)d_out; a.ws = (unsigned char*)d_ws;
    a.ph_lo = 0; a.ph_hi = 9;
    void* kargs[] = {&a};
    hipError_t e = hipLaunchCooperativeKernel((const void*)fwd_kernel, dim3(grid), dim3(NWAVES * 64), kargs, LDS_BYTES, stream);
    if (e != hipSuccess) fprintf(stderr, "kernel_launch: cooperative launch failed: %s (grid %d)\n", hipGetErrorString(e), grid);
}
```

```cpp
#include <hip/hip_runtime.h>
#include <cstdio>
#include <cstdint>
namespace pg8 {
#define PG8_LAS __attribute__((address_space(3)))
typedef unsigned short bf16_t;
typedef short bf16x8 __attribute__((ext_vector_type(8)));
typedef float f32x4 __attribute__((ext_vector_type(4)));
typedef unsigned u32x4 __attribute__((ext_vector_type(4)));
typedef unsigned u32x2 __attribute__((ext_vector_type(2)));
constexpr int BM = 256, BK = 64, HALF = 128, HTB = HALF * BK * 2  , STAGE_BYTES = 8 * HTB, NXCD = 8, WGM = 8;

__host__ __device__ __forceinline__ int lds_byte(int r, int c) { const int st = (r >> 4) * 2 + (c >> 5), rr = r & 15, cc = c & 31, ob = rr * 64 + cc * 2; return st * 1024 + (ob ^ (((ob >> 9) & 1) << 5)); }
__host__ __device__ __forceinline__ void stage_rc(int b, int& R, int& C) { const int st = b / 1024, sb = b % 1024, swz = sb ^ (((sb >> 9) & 1) << 5); R = (st >> 1) * 16 + swz / 64; C = (st & 1) * 32 + (swz % 64) / 2; }
__host__ __device__ __forceinline__ int perm32(int rho) { const int n = rho >> 4, i = rho & 15; return 8 * (i >> 2) + 4 * n + (i & 3); }

struct Unit { int pm, pn; };
struct Gemm { const bf16_t* A; const bf16_t* Bt; int M, N, K; };

struct StaticOrder {
    int nM, nN, nwg, G, c;
    __host__ __device__ void init(int M, int N, int G_, int c_) { nM = M / BM; nN = N / BM; nwg = nM * nN; G = G_; c = c_; }
    __host__ __device__ bool next(int i, Unit& u) const {
        const long L = (long)i * G + c; if (L >= nwg) return false;
        int wgid = (int)L; { const int q = nwg / NXCD, r = nwg % NXCD, xcd = wgid % NXCD, off = wgid / NXCD; wgid = (xcd < r ? xcd * (q + 1) : r * (q + 1) + (xcd - r) * q) + off; }
        const int nig = WGM * nN, gid = wgid / nig, fm = gid * WGM, gsz = (nM - fm) < WGM ? (nM - fm) : WGM;
        u.pm = fm + ((wgid % nig) % gsz); u.pn = (wgid % nig) / gsz; return true;
    }
};

__device__ __forceinline__ unsigned cvt_pk_bf16(float lo, float hi) { unsigned r; asm volatile("v_cvt_pk_bf16_f32 %0, %1, %2" : "=v"(r) : "v"(lo), "v"(hi)); return r; }


constexpr float RMS_EPS = 1e-6f;
template <int MODE> struct EpiIn {
    static constexpr bool HEADMAP = true;
    bf16_t* qkv; size_t sec_stride; bf16_t* gate; const float* rs; const float* qg; const float* kg; int row_base; float qscale;
    __device__ __forceinline__ void operator()(const f32x4 (&acc)[2][2][4][2], const Unit& u, int wr, int wc, int fr, int fq) const {
        const int sec = u.pn >> 2, hq = u.pn & 3, h = hq * 4 + wc;
        int type, g = 0;
        if (MODE == 0) { if (sec == 9) type = 3; else { g = sec / 3; type = sec - 3 * g; } } else type = sec;
        const int shift = (MODE == 0) ? 2 * g : 0;
        f32x4 gv[2][2];
#pragma unroll
        for (int bj = 0; bj < 2; ++bj)
#pragma unroll
            for (int n = 0; n < 2; ++n) gv[bj][n] = (f32x4){1.f, 1.f, 1.f, 1.f};
        if (type < 2) {
            const float* gp = (type == 0 ? qg : kg) + (MODE == 0 ? g * 64 : 0) + 8 * fq;
            const float sc = (type == 0) ? qscale : 1.f;
#pragma unroll
            for (int bj = 0; bj < 2; ++bj)
#pragma unroll
                for (int n = 0; n < 2; ++n) gv[bj][n] = *(const f32x4*)(gp + 32 * bj + 4 * n) * sc;
        }
#pragma unroll
        for (int ai = 0; ai < 2; ++ai)
#pragma unroll
            for (int m = 0; m < 4; ++m) {
                const int r = u.pm * BM + ai * HALF + wr * 64 + m * 16 + fr;
                float rsv;
                if (MODE == 0) rsv = rs[row_base + r];
                else { const f32x4 pp = *(const f32x4*)(rs + (size_t)(row_base + r) * 16 + 4 * fq); float s = (pp[0] + pp[1]) + (pp[2] + pp[3]); s += __shfl_xor(s, 16); s += __shfl_xor(s, 32); rsv = __builtin_amdgcn_rsqf(s * (1.0f / 1024.0f) + RMS_EPS); }
                f32x4 v[2][2];
#pragma unroll
                for (int bj = 0; bj < 2; ++bj)
#pragma unroll
                    for (int n = 0; n < 2; ++n) v[bj][n] = acc[ai][bj][m][n] * rsv;
                if (type < 2) {
                    float ss = 0.f;
#pragma unroll
                    for (int bj = 0; bj < 2; ++bj)
#pragma unroll
                        for (int n = 0; n < 2; ++n) { const f32x4 x = v[bj][n]; ss += (x[0] * x[0] + x[1] * x[1]) + (x[2] * x[2] + x[3] * x[3]); }
                    ss += __shfl_xor(ss, 16); ss += __shfl_xor(ss, 32);
                    const float inv = __builtin_amdgcn_rsqf(ss * (1.0f / 64.0f) + RMS_EPS);
#pragma unroll
                    for (int bj = 0; bj < 2; ++bj)
#pragma unroll
                        for (int n = 0; n < 2; ++n) v[bj][n] = v[bj][n] * gv[bj][n] * inv;
                } else if (type == 3) {
#pragma unroll
                    for (int bj = 0; bj < 2; ++bj)
#pragma unroll
                        for (int n = 0; n < 2; ++n)
#pragma unroll
                            for (int i = 0; i < 4; ++i) { const float x = v[bj][n][i]; v[bj][n][i] = x * __builtin_amdgcn_rcpf(1.0f + __expf(-x)); }
                }
                bf16_t* p;
                if (type < 3) { const int t = r & 4095, bl = r >> 12; const int pos = ((t & ((1 << shift) - 1)) << (12 - shift)) | (t >> shift);
                    p = qkv + (size_t)sec * sec_stride + ((size_t)(bl * 16 + h) * 4096 + pos) * 64 + 8 * fq; }
                else p = gate + (size_t)r * 1024 + hq * 256 + wc * 64 + 8 * fq;
#pragma unroll
                for (int bj = 0; bj < 2; ++bj) { u32x4 w; w.x = cvt_pk_bf16(v[bj][0][0], v[bj][0][1]); w.y = cvt_pk_bf16(v[bj][0][2], v[bj][0][3]); w.z = cvt_pk_bf16(v[bj][1][0], v[bj][1][1]); w.w = cvt_pk_bf16(v[bj][1][2], v[bj][1][3]);
                    *(u32x4*)(p + 32 * bj) = w; }
            }
    }
};

struct EpiOut {
    static constexpr bool HEADMAP = false;
    const float* base; float* out; bf16_t* xb; float* part;
    __device__ __forceinline__ void operator()(const f32x4 (&acc)[2][2][4][2], const Unit& u, int wr, int wc, int fr, int fq) const {
#pragma unroll
        for (int ai = 0; ai < 2; ++ai)
#pragma unroll
            for (int m = 0; m < 4; ++m) {
                const int r = u.pm * BM + ai * HALF + wr * 64 + m * 16 + fr;
                const size_t off = (size_t)r * 1024 + u.pn * BM + wc * 32 + 4 * fq;
                float ss = 0.f;
#pragma unroll
                for (int bj = 0; bj < 2; ++bj)
#pragma unroll
                    for (int n = 0; n < 2; ++n) {
                        const f32x4 bs = *(const f32x4*)(base + off + bj * HALF + n * 16);
                        const f32x4 o = bs + acc[ai][bj][m][n];
                        *(f32x4*)(out + off + bj * HALF + n * 16) = o;
                        if (xb) { u32x2 w; w.x = cvt_pk_bf16(o[0], o[1]); w.y = cvt_pk_bf16(o[2], o[3]); *(u32x2*)(xb + off + bj * HALF + n * 16) = w; }
                        ss += (o[0] * o[0] + o[1] * o[1]) + (o[2] * o[2] + o[3] * o[3]);
                    }
                if (part) { ss += __shfl_xor(ss, 16); ss += __shfl_xor(ss, 32); if (fq == 0) part[(size_t)r * 16 + u.pn * 4 + wc] = ss; }
            }
    }
};

template <class Epi, class Sched, bool ALIGN_EPI>
__device__ __forceinline__ void gemm_phase(PG8_LAS unsigned char* lds, const Gemm g, const Sched& S, const Epi& E) {
    const int tid = threadIdx.x, wid = __builtin_amdgcn_readfirstlane(tid >> 6), lane = tid & 63, wr = wid >> 2, wc = wid & 3, fr = lane & 15, fq = lane >> 4;
    const int K = g.K, nt = K / BK;
    unsigned voffA[2], voffB[2];
#pragma unroll
    for (int i = 0; i < 2; ++i) { int R, C; stage_rc(tid * 16 + i * 8192, R, C);
        const int Rb = Epi::HEADMAP ? (64 * (R >> 5) + perm32(R & 31)) : R;
        voffA[i] = (unsigned)(R * K + C) * 2u; voffB[i] = (unsigned)(Rb * K + C) * 2u; }
    const size_t kstep = (size_t)(BK * 2);
    const size_t hstep = (size_t)HALF * K * 2;
    const size_t hstepB = Epi::HEADMAP ? (size_t)32 * K * 2 : hstep;
    const size_t tstep = 2 * hstep;
    const unsigned ldsw = (unsigned)wid * 1024u;
    const int aoff = lds_byte(wr * 64 + fr, fq * 8), boff = lds_byte(wc * 32 + fr, fq * 8);
#define PG8_SA(b, h) (((b) * 2 + (h)) * HTB)
#define PG8_SB(b, h) ((4 + (b) * 2 + (h)) * HTB)
#define PG8_STAGE(bufoff, gbase, voff) do { _Pragma("unroll") for (int _i = 0; _i < 2; ++_i) \
        __builtin_amdgcn_global_load_lds((const unsigned*)((const char*)(gbase) + (voff)[_i]), (PG8_LAS unsigned*)(lds + (bufoff) + ldsw + _i * 8192), 16, 0, 0); } while (0)
#define PG8_LDA(dst, b, h) do { _Pragma("unroll") for (int m = 0; m < 4; ++m) _Pragma("unroll") for (int k = 0; k < 2; ++k) dst[m][k] = *(const PG8_LAS bf16x8*)(lds + PG8_SA(b, h) + aoff + m * 2048 + k * 1024); } while (0)
#define PG8_LDB(dst, b, h) do { _Pragma("unroll") for (int n = 0; n < 2; ++n) _Pragma("unroll") for (int k = 0; k < 2; ++k) dst[n][k] = *(const PG8_LAS bf16x8*)(lds + PG8_SB(b, h) + boff + n * 2048 + k * 1024); } while (0)
#define PG8_MMA(ai, bj, At, Bt) do { __builtin_amdgcn_s_setprio(1); _Pragma("unroll") for (int m = 0; m < 4; ++m) _Pragma("unroll") for (int n = 0; n < 2; ++n) _Pragma("unroll") for (int k = 0; k < 2; ++k) \
        acc[ai][bj][m][n] = __builtin_amdgcn_mfma_f32_16x16x32_bf16(Bt[n][k], At[m][k], acc[ai][bj][m][n], 0, 0, 0); __builtin_amdgcn_s_setprio(0); } while (0)
#define PG8_WAIT_V(n) asm volatile("s_waitcnt vmcnt(" #n ")" ::: "memory")
#define PG8_WAIT_L(n) asm volatile("s_waitcnt lgkmcnt(" #n ")" ::: "memory")
#define PG8_BAR __builtin_amdgcn_s_barrier()
#define PG8_SCHED __builtin_amdgcn_sched_barrier(0)
    Unit cur, nxt; int ui = 0;
    if (!S.next(0, cur)) return;
    f32x4 acc[2][2][4][2];
#pragma unroll
    for (int a = 0; a < 2; ++a)
#pragma unroll
        for (int b = 0; b < 2; ++b)
#pragma unroll
            for (int m = 0; m < 4; ++m)
#pragma unroll
                for (int n = 0; n < 2; ++n) acc[a][b][m][n] = (f32x4){0.f, 0.f, 0.f, 0.f};
    bf16x8 At[4][2], B0[2][2], B1[2][2];
    const char* cA = (const char*)g.A + (size_t)cur.pm * tstep; const char* cB = (const char*)g.Bt + (size_t)cur.pn * tstep;
    PG8_STAGE(PG8_SB(0, 0), cB, voffB); PG8_STAGE(PG8_SB(0, 1), cB + hstepB, voffB); PG8_STAGE(PG8_SA(0, 0), cA, voffA); PG8_STAGE(PG8_SA(0, 1), cA + hstep, voffA);
    if (wr == 1) PG8_BAR;
    PG8_WAIT_V(2); PG8_BAR;
    PG8_STAGE(PG8_SB(1, 0), cB + kstep, voffB); PG8_STAGE(PG8_SA(1, 0), cA + kstep, voffA); PG8_STAGE(PG8_SB(1, 1), cB + hstepB + kstep, voffB);
    PG8_WAIT_V(6); PG8_BAR;
    for (;;) {
        const bool has_next = S.next(ui + 1, nxt);
        const char* nA = has_next ? (const char*)g.A + (size_t)nxt.pm * tstep : cA; const char* nB = has_next ? (const char*)g.Bt + (size_t)nxt.pn * tstep : cB;
        for (int t = 0; t < nt; t += 2) {
            const bool last = (t == nt - 2);
            const char* a1 = cA + (size_t)(t + 1) * kstep;
            const char* a2 = last ? nA : cA + (size_t)(t + 2) * kstep; const char* b2 = last ? nB : cB + (size_t)(t + 2) * kstep;
            const char* a3 = a2 + kstep; const char* b3 = b2 + kstep;
            PG8_LDB(B0, 0, 0); PG8_LDB(B1, 0, 1); PG8_SCHED; PG8_LDA(At, 0, 0); PG8_STAGE(PG8_SA(1, 1), a1 + hstep, voffA);
            PG8_WAIT_V(8); PG8_WAIT_L(0); PG8_BAR; PG8_MMA(0, 0, At, B0); PG8_MMA(0, 1, At, B1); PG8_BAR; PG8_SCHED;
            PG8_LDA(At, 0, 1); PG8_STAGE(PG8_SB(0, 0), b2, voffB); PG8_STAGE(PG8_SB(0, 1), b2 + hstepB, voffB); PG8_STAGE(PG8_SA(0, 0), a2, voffA);
            PG8_WAIT_V(8); PG8_WAIT_L(0); PG8_BAR; PG8_MMA(1, 0, At, B0); PG8_MMA(1, 1, At, B1); PG8_BAR; PG8_SCHED;
            PG8_LDB(B0, 1, 0); PG8_LDB(B1, 1, 1); PG8_SCHED; PG8_LDA(At, 1, 0); PG8_STAGE(PG8_SA(0, 1), a2 + hstep, voffA);
            PG8_WAIT_V(8); PG8_WAIT_L(0); PG8_BAR; PG8_MMA(0, 0, At, B0); PG8_MMA(0, 1, At, B1); PG8_BAR; PG8_SCHED;
            PG8_LDA(At, 1, 1); PG8_STAGE(PG8_SB(1, 0), b3, voffB); PG8_STAGE(PG8_SB(1, 1), b3 + hstepB, voffB); PG8_STAGE(PG8_SA(1, 0), a3, voffA);
            PG8_WAIT_V(8); PG8_WAIT_L(0); PG8_BAR; PG8_MMA(1, 0, At, B0); PG8_MMA(1, 1, At, B1); PG8_BAR; PG8_SCHED;
        }
        if constexpr (ALIGN_EPI) { if (wr == 0) PG8_BAR; }
        E(acc, cur, wr, wc, fr, fq);
        if (!has_next) break;
#pragma unroll
        for (int a = 0; a < 2; ++a)
#pragma unroll
            for (int b = 0; b < 2; ++b)
#pragma unroll
                for (int m = 0; m < 4; ++m)
#pragma unroll
                    for (int n = 0; n < 2; ++n) acc[a][b][m][n] = (f32x4){0.f, 0.f, 0.f, 0.f};
        cur = nxt; cA = nA; cB = nB; ++ui;
        if constexpr (ALIGN_EPI) { if (wr == 1) PG8_BAR; }
    }
    PG8_WAIT_V(0);
    if constexpr (!ALIGN_EPI) { if (wr == 0) PG8_BAR; }
    PG8_BAR;
#undef PG8_SA
#undef PG8_SB
#undef PG8_STAGE
#undef PG8_LDA
#undef PG8_LDB
#undef PG8_MMA
#undef PG8_WAIT_V
#undef PG8_WAIT_L
#undef PG8_BAR
#undef PG8_SCHED
}
}
constexpr int NWAVES = 8;
constexpr int BATCH = 8, SEQ = 4096, DM = 1024, NH = 16, HD = 64;
constexpr int MTOK = BATCH * SEQ;
constexpr int MHALF = MTOK / 2;
constexpr int NA_IN = 10240, NB_IN = 4096;
constexpr float LOG2E = 1.4426950408889634f;
constexpr float QSCALE = 0.125f * LOG2E;

constexpr size_t MiB = 1u << 20;
constexpr size_t WS_CTL = 0, CTL_ZERO_BYTES = 1 * MiB;
constexpr size_t WS_RSTD1 = 1 * MiB;
constexpr size_t WS_PART2 = 2 * MiB;
constexpr size_t WS_WAIN = 4 * MiB, WS_WAOUT = 24 * MiB, WS_WBIN = 26 * MiB, WS_WBOUT = 34 * MiB;
constexpr size_t WS_XB = 36 * MiB;
constexpr size_t WS_QKVA = 100 * MiB;
constexpr size_t SECA = (size_t)4 * NH * SEQ * HD;
constexpr size_t WS_GATEA = WS_QKVA + 9 * 32 * MiB;
constexpr size_t WS_X1B = 100 * MiB;
constexpr size_t WS_QKVB = 164 * MiB;
constexpr size_t SECB = (size_t)8 * NH * SEQ * HD;
constexpr size_t WS_GATEB = WS_QKVB + 3 * 64 * MiB;
constexpr size_t WS_END = 420 * MiB;
static_assert(WS_GATEA + 32 * MiB <= WS_END && WS_GATEB + 64 * MiB <= WS_END && WS_X1B + 64 * MiB <= WS_QKVB, "ws map");
constexpr int CW_BAR = 4096;

constexpr int RING_OFF = 0, RING_BYTES = 131072;
constexpr int LDSCTL_OFF = RING_BYTES, MISC_OFF = LDSCTL_OFF + 320;
constexpr int LDS_BYTES = 147456;

#define GAS __attribute__((address_space(1)))
#define LAS __attribute__((address_space(3)))
typedef unsigned short bf16;
typedef unsigned v4u __attribute__((ext_vector_type(4)));
typedef unsigned v2u __attribute__((ext_vector_type(2)));
typedef float f32x4 __attribute__((ext_vector_type(4)));
typedef short bf16x8 __attribute__((ext_vector_type(8)));
typedef GAS unsigned gu32;
#define RLX_AGENT __ATOMIC_RELAXED, __HIP_MEMORY_SCOPE_AGENT
#define LDS_WAIT() asm volatile("s_waitcnt lgkmcnt(0)" ::: "memory")
#define VM_WAIT() asm volatile("s_waitcnt vmcnt(0)" ::: "memory")
__device__ __forceinline__ unsigned f2bf(float f) { unsigned u = __builtin_bit_cast(unsigned, f); return (u + 0x7fffu + ((u >> 16) & 1u)) >> 16; }
__device__ __forceinline__ unsigned pk2(float lo, float hi) { return f2bf(lo) | (f2bf(hi) << 16); }
__device__ __forceinline__ float bf2f(unsigned short h) { return __builtin_bit_cast(float, (unsigned)h << 16); }

#define XB_TMO      128
#define XB_XCNT(j)  (256  + 64 * (j))
#define XB_XSUB(j)  (1280 + 64 * (j))
#define XB_XGEN(j)  (2304 + 64 * (j))
#define XB_TOP      3328
#define XB_TOPGEN   3392
#define XCD_BAR_WORDS 3456
#define XB_SPIN_CAP (1u << 18)
__device__ __forceinline__ unsigned xb_ld(unsigned* p)              { return __hip_atomic_load(p, __ATOMIC_RELAXED, __HIP_MEMORY_SCOPE_AGENT); }
__device__ __forceinline__ unsigned xb_add(unsigned* p, unsigned v) { return __hip_atomic_fetch_add(p, v, __ATOMIC_RELAXED, __HIP_MEMORY_SCOPE_AGENT); }
__device__ __forceinline__ unsigned xb_xcc_id() { return (unsigned)__builtin_amdgcn_s_getreg((3 << 11) | 20) & 0xFu; }
#define XB_SPIN(cond, bar) do { unsigned _sp = 0; while (cond) { __builtin_amdgcn_s_sleep(1); \
    if ((++_sp & 255u) == 0u) { if (xb_ld(&(bar)[XB_TMO])) break; if (_sp > XB_SPIN_CAP) { atomicAdd(&(bar)[XB_TMO], 1u); break; } } } } while (0)
struct XcdBarrier { unsigned* bar; unsigned x; volatile LAS unsigned* st; };
__device__ __forceinline__ XcdBarrier xcd_barrier_post(unsigned* bar, volatile LAS unsigned* st) {
    XcdBarrier b; b.bar = bar; b.x = xb_xcc_id(); b.st = st;
    if (threadIdx.x == 0) (void)xb_add(&bar[XB_XCNT(b.x)], 1u);
    return b;
}
__device__ __forceinline__ void xcd_barrier_complete(unsigned* bar, unsigned x, unsigned& nloc, unsigned& nx) {
    const unsigned G = gridDim.x * gridDim.y * gridDim.z;
    unsigned sum, cnt, mine, sp = 0u;
    for (;;) {
        sum = 0u; cnt = 0u; mine = 0u;
#pragma unroll
        for (unsigned j = 0; j < 16; ++j) { const unsigned c = xb_ld(&bar[XB_XCNT(j)]); sum += c; cnt += (c > 0u) ? 1u : 0u; mine = (j == x) ? c : mine; }
        if (sum == G) break;
        __builtin_amdgcn_s_sleep(1);
        if ((++sp & 255u) == 0u) { if (xb_ld(&bar[XB_TMO])) break; if (sp > XB_SPIN_CAP) { atomicAdd(&bar[XB_TMO], 1u); break; } }
    }
    nloc = mine > 0u ? mine : 1u; nx = cnt > 0u ? cnt : 1u;
}
__device__ __forceinline__ void xcd_barrier(const XcdBarrier& b) {
    asm volatile("s_waitcnt vmcnt(0)" ::: "memory");
    __syncthreads();
    if (threadIdx.x == 0) {
        unsigned* bar = b.bar;
        __builtin_amdgcn_s_waitcnt(0);
        unsigned nloc = b.st[0], nx = b.st[1];
        if (nloc == 0u) { xcd_barrier_complete(bar, b.x, nloc, nx); b.st[0] = nloc; b.st[1] = nx; }
        const unsigned old = xb_add(&bar[XB_XSUB(b.x)], 1u);
        const unsigned gen = old / nloc;
        if (old + 1u == (gen + 1u) * nloc) {
            __builtin_amdgcn_fence(__ATOMIC_RELEASE, "agent");
            asm volatile("s_waitcnt vmcnt(0)" ::: "memory");
            const unsigned og = xb_add(&bar[XB_TOP], 1u);
            const unsigned tg = og / nx;
            if (og + 1u == (tg + 1u) * nx) xb_add(&bar[XB_TOPGEN], 1u);
            else XB_SPIN(xb_ld(&bar[XB_TOPGEN]) == tg, bar);
            __builtin_amdgcn_fence(__ATOMIC_ACQUIRE, "agent");
            xb_add(&bar[XB_XGEN(b.x)], 1u);
            asm volatile("s_waitcnt vmcnt(0)" ::: "memory");
        } else {
            XB_SPIN(xb_ld(&bar[XB_XGEN(b.x)]) == gen, bar);
            __builtin_amdgcn_fence(__ATOMIC_ACQUIRE, "agent");
            asm volatile("s_waitcnt vmcnt(0)" ::: "memory");
        }
    }
    __syncthreads();
}

struct Frame {
    LAS unsigned char* lds;
    volatile LAS unsigned* MISC;
    gu32* ctl;
    int tid, lane, wave, vcu, G;
};

__device__ __forceinline__ float wave_sum(float v) {
#pragma unroll
    for (int o = 1; o < 64; o <<= 1) v += __shfl_xor(v, o);
    return v;
}
__device__ __forceinline__ void p0_transpose_item(const float* W, int K, int N, bf16* WT, const float* gk, LAS float* scr, int item, int lane) {
    const int nblk = N / 32, kb = item / nblk, nb = item % nblk, k0 = 64 * kb, n0 = 32 * nb;
#pragma unroll 8
    for (int i = 0; i < 32; ++i) { const int kk = 2 * i + (lane >> 5); const float gsc = gk ? gk[k0 + kk] : 1.0f; scr[kk * 33 + (lane & 31)] = W[(size_t)(k0 + kk) * N + n0 + (lane & 31)] * gsc; }
    LDS_WAIT(); asm volatile("" ::: "memory");
    const int c = lane & 7;
#pragma unroll
    for (int j = 0; j < 4; ++j) { const int n = (lane >> 3) + 8 * j; const LAS float* s = scr + (8 * c) * 33 + n;
        v4u o; o.x = pk2(s[0 * 33], s[1 * 33]); o.y = pk2(s[2 * 33], s[3 * 33]); o.z = pk2(s[4 * 33], s[5 * 33]); o.w = pk2(s[6 * 33], s[7 * 33]);
        *(GAS v4u*)(WT + (size_t)(n0 + n) * K + k0 + 8 * c) = o; }
    LDS_WAIT(); asm volatile("" ::: "memory");
}
__device__ __forceinline__ int t5_bucket_dev(int rel) {
    const int n = rel < 0 ? -rel : rel;
    const int b = n < 8 ? n : 8 + (n >= 15) + (n >= 27) + (n >= 50) + (n >= 91) + (n >= 167) + (n >= 305) + (n >= 559);
    return b + (rel > 0 ? 16 : 0);
}
namespace att {
typedef float f32x16 __attribute__((ext_vector_type(16)));
typedef short s16x4 __attribute__((ext_vector_type(4)));
typedef short v4i16_t __attribute__((ext_vector_type(4)));
typedef float f32x2_t __attribute__((ext_vector_type(2)));
typedef __bf16 bf16x2_t __attribute__((ext_vector_type(2)));
constexpr float NEG = -1e30f;
constexpr int ACC_PITCH = 136;
constexpr int ACC_OFF = 0, LACC_OFF = 512 * ACC_PITCH, TBL_OFF = LACC_OFF + 2048, TBL_BYTES = 4096, SCR_OFF = TBL_OFF + TBL_BYTES, VST_OFF = SCR_OFF + 256, LDS_END = VST_OFF + 8 * 4096;
static_assert(VST_OFF % 16 == 0 && LDS_END <= RING_BYTES, "attention LDS map");
__device__ __forceinline__ int rho(int t) { return t ^ ((t >> 5) & 15); }
__device__ __forceinline__ unsigned cvtpk(float lo, float hi) { f32x2_t v = {lo, hi}; bf16x2_t b = __builtin_convertvector(v, bf16x2_t); return __builtin_bit_cast(unsigned, b); }
__device__ __forceinline__ s16x4 vtr(const LAS char* p) { return __builtin_bit_cast(s16x4, __builtin_amdgcn_ds_read_tr16_b64_v4i16((LAS v4i16_t*)p)); }

template <bool CM>
__device__ __forceinline__ void attn_block(const bf16* qrow, const bf16* kt, const bf16* vt, int tstride, int nt, const LAS char* tb, const LAS char* tneg, int rlo, int rhi,
                                           const float (&cm)[16], LAS char* vst, int lane, f32x16& o0, f32x16& o1, float& lsum) {
    const int r32 = lane & 31, hi = lane >> 5;
    bf16x8 qr[4];
#pragma unroll
    for (int d0 = 0; d0 < 4; ++d0) qr[d0] = *(const bf16x8*)(qrow + d0 * 16 + hi * 8);
    o0 = f32x16{}; o1 = f32x16{}; lsum = 0.f;
    const LAS char* vrd = vst + ((lane >> 4) & 1) * 32 + (lane & 3) * 8 + (4 * hi + ((lane & 15) >> 2)) * 64;
    for (int t = 0; t < nt; ++t) {
        const bf16* kb = kt + (size_t)t * tstride + r32 * 64 + hi * 8;
        const bf16* vb = vt + (size_t)t * tstride + (lane >> 2) * 64 + (lane & 3) * 8;
        bf16x8 kf[4]; v4u vv[4];
#pragma unroll
        for (int d0 = 0; d0 < 4; ++d0) kf[d0] = *(const bf16x8*)(kb + d0 * 16);
#pragma unroll
        for (int pc = 0; pc < 4; ++pc) vv[pc] = *(const v4u*)(vb + (pc & 1) * 16 * 64 + (pc >> 1) * 32);
        const LAS char* ta = tb + 128 * t;
        if (CM) ta = (t >= rlo && t <= rhi) ? ta : tneg;
        f32x16 p;
#pragma unroll
        for (int r = 0; r < 16; ++r) { p[r] = *(const LAS float*)(ta + 4 * ((r & 3) + 8 * (r >> 2))); if (CM) p[r] += cm[r]; }
#pragma unroll
        for (int d0 = 0; d0 < 4; ++d0) p = __builtin_amdgcn_mfma_f32_32x32x16_bf16(kf[d0], qr[d0], p, 0, 0, 0);
#pragma unroll
        for (int r = 0; r < 16; ++r) { p[r] = __builtin_amdgcn_exp2f(p[r]); lsum += p[r]; }
        v4u pk0, pk1;
        pk0.x = cvtpk(p[0], p[1]); pk0.y = cvtpk(p[2], p[3]); pk0.z = cvtpk(p[4], p[5]); pk0.w = cvtpk(p[6], p[7]);
        pk1.x = cvtpk(p[8], p[9]); pk1.y = cvtpk(p[10], p[11]); pk1.z = cvtpk(p[12], p[13]); pk1.w = cvtpk(p[14], p[15]);
#pragma unroll
        for (int pc = 0; pc < 4; ++pc) *(LAS v4u*)(vst + pc * 1024 + lane * 16) = vv[pc];
#pragma unroll
        for (int dh = 0; dh < 2; ++dh)
#pragma unroll
            for (int s = 0; s < 2; ++s) {
                const s16x4 lo = vtr(vrd + dh * 2048 + s * 1024), hh = vtr(vrd + dh * 2048 + s * 1024 + 512);
                const bf16x8 vf = (bf16x8){lo[0], lo[1], lo[2], lo[3], hh[0], hh[1], hh[2], hh[3]};
                const bf16x8 pf = __builtin_bit_cast(bf16x8, s ? pk1 : pk0);
                if (dh == 0) o0 = __builtin_amdgcn_mfma_f32_32x32x16_bf16(vf, pf, o0, 0, 0, 0);
                else o1 = __builtin_amdgcn_mfma_f32_32x32x16_bf16(vf, pf, o1, 0, 0, 0);
            }
    }
}
template <bool FIRST>
__device__ __forceinline__ void acc_block(const f32x16& o0, const f32x16& o1, float lsum, LAS char* lds, int tloc, int lane) {
    const int hi = lane >> 5;
    LAS char* row = lds + ACC_OFF + rho(tloc) * ACC_PITCH + 8 * hi;
#pragma unroll
    for (int dh = 0; dh < 2; ++dh)
#pragma unroll
        for (int c4 = 0; c4 < 4; ++c4) {
            float v0 = dh ? o1[4 * c4] : o0[4 * c4], v1 = dh ? o1[4 * c4 + 1] : o0[4 * c4 + 1], v2 = dh ? o1[4 * c4 + 2] : o0[4 * c4 + 2], v3 = dh ? o1[4 * c4 + 3] : o0[4 * c4 + 3];
            LAS v2u* a = (LAS v2u*)(row + 64 * dh + 16 * c4);
            if (!FIRST) { const v2u old = *a; v0 += __builtin_bit_cast(float, old.x << 16); v1 += __builtin_bit_cast(float, old.x & 0xffff0000u); v2 += __builtin_bit_cast(float, old.y << 16); v3 += __builtin_bit_cast(float, old.y & 0xffff0000u); }
            v2u w; w.x = cvtpk(v0, v1); w.y = cvtpk(v2, v3); *a = w;
        }
    float l = lsum + __shfl_xor(lsum, 32);
    if (hi == 0) { LAS float* la = (LAS float*)(lds + LACC_OFF) + tloc; if (!FIRST) l += *la; *la = l; }
}
__device__ __forceinline__ void final_pass(LAS char* lds, const bf16* grow, bf16* yrow, int tid) {
#pragma unroll 2
    for (int it = 0; it < 8; ++it) {
        const int tloc = (tid >> 3) + 64 * it, c = tid & 7;
        const LAS char* row = lds + ACC_OFF + rho(tloc) * ACC_PITCH + 16 * c;
        const v2u a0 = *(const LAS v2u*)row, a1 = *(const LAS v2u*)(row + 8);
        const float inv = 1.0f / *((const LAS float*)(lds + LACC_OFF) + tloc);
        const v4u gw = *(const v4u*)(grow + (size_t)tloc * 1024 + 8 * c);
        v4u w;
        w.x = cvtpk(__builtin_bit_cast(float, a0.x << 16) * inv * __builtin_bit_cast(float, gw.x << 16), __builtin_bit_cast(float, a0.x & 0xffff0000u) * inv * __builtin_bit_cast(float, gw.x & 0xffff0000u));
        w.y = cvtpk(__builtin_bit_cast(float, a0.y << 16) * inv * __builtin_bit_cast(float, gw.y << 16), __builtin_bit_cast(float, a0.y & 0xffff0000u) * inv * __builtin_bit_cast(float, gw.y & 0xffff0000u));
        w.z = cvtpk(__builtin_bit_cast(float, a1.x << 16) * inv * __builtin_bit_cast(float, gw.z << 16), __builtin_bit_cast(float, a1.x & 0xffff0000u) * inv * __builtin_bit_cast(float, gw.z & 0xffff0000u));
        w.w = cvtpk(__builtin_bit_cast(float, a1.y << 16) * inv * __builtin_bit_cast(float, gw.w << 16), __builtin_bit_cast(float, a1.y & 0xffff0000u) * inv * __builtin_bit_cast(float, gw.w & 0xffff0000u));
        *(v4u*)(yrow + (size_t)tloc * 1024 + 8 * c) = w;
    }
}
__device__ __forceinline__ float wg_absmax(const float* p, int n, LAS float* scr, int tid) {
    float m = 0.f;
    for (int i = tid; i < n; i += NWAVES * 64) m = fmaxf(m, fabsf(p[i]));
#pragma unroll
    for (int o = 1; o < 64; o <<= 1) m = fmaxf(m, __shfl_xor(m, o));
    __syncthreads();
    if ((tid & 63) == 0) scr[tid >> 6] = m;
    __syncthreads();
    float r = scr[0];
#pragma unroll
    for (int i = 1; i < NWAVES; ++i) r = fmaxf(r, scr[i]);
    return r;
}

__device__ __forceinline__ void attn_a_phase(Frame& F, const bf16* qkv, const bf16* gate, bf16* y, const float* t5, const float* qg, const float* kg) {
    LAS char* lds = (LAS char*)F.lds;
    LAS float* scr = (LAS float*)(lds + SCR_OFF);
    int tid_ = threadIdx.x; asm volatile("" : "+v"(tid_));
    const int tid = tid_, lane = tid & 63, wave = __builtin_amdgcn_readfirstlane(tid >> 6);
    const float cshift = 64.0f * QSCALE * wg_absmax(qg, 192, scr, tid) * wg_absmax(kg, 192, scr, tid) + LOG2E * wg_absmax(t5, 48 * 32, scr, tid);
    const int NU = 4 * NH * 8, per = (NU + F.G - 1) / F.G;
    const float zero16[16] = {0.f, 0.f, 0.f, 0.f, 0.f, 0.f, 0.f, 0.f, 0.f, 0.f, 0.f, 0.f, 0.f, 0.f, 0.f, 0.f};
    for (int ui = 0; ui < per; ++ui) {
        const int u = F.vcu * per + ui; if (u >= NU) break;
        const int s = u & 7, h = (u >> 3) & 15, bl = u >> 7;
        for (int idx = tid; idx < 3 * 192; idx += NWAVES * 64) {
            const int g = idx / 192, rel = idx % 192 - 95; const int ar = rel < 0 ? -rel : rel;
            float v = NEG; if (ar <= 64) v = LOG2E * t5[(g * 16 + h) * 32 + t5_bucket_dev(rel << (2 * g))] - cshift;
            ((LAS float*)(lds + TBL_OFF))[idx] = v;
        }
        __syncthreads();
#pragma unroll 1
        for (int g = 2; g >= 0; --g) {
            const int sh = 2 * g, L = SEQ >> sh;
            const bf16* Qg = qkv + (size_t)(3 * g) * SECA + ((size_t)(bl * 16 + h) * 4096) * 64; const bf16* Kg = Qg + SECA; const bf16* Vg = Kg + SECA;
#pragma unroll 1
            for (int bb = 0; bb < 2; ++bb) {
                const int bi = 2 * wave + bb, res = bi >> (4 - sh), i = bi & ((16 >> sh) - 1);
                const int pos0 = ((512 * s) >> sh) + 32 * i;
                const int jlo = max(0, 2 - (pos0 >> 5)), jhi = min(4, 2 + ((L - 32 - pos0) >> 5)), nt = jhi - jlo + 1;
                const int q = lane & 31, hi = lane >> 5;
                const bf16* qrow = Qg + (size_t)(res * L + pos0 + q) * 64;
                const size_t krow0 = (size_t)(res * L + pos0 + 32 * (jlo - 2)) * 64;
                const LAS char* tb = lds + TBL_OFF + 4 * (g * 192 + 32 * jlo + 31 + 4 * hi - q);
                f32x16 o0, o1; float lsum;
                attn_block<false>(qrow, Kg + krow0, Vg + krow0, 2048, nt, tb, tb, 0, 0, zero16, lds + VST_OFF + wave * 4096, lane, o0, o1, lsum);
                const int tloc = ((32 * i + q) << sh) + res;
                if (g == 2) acc_block<true>(o0, o1, lsum, lds, tloc, lane); else acc_block<false>(o0, o1, lsum, lds, tloc, lane);
            }
            __syncthreads();
        }
        const size_t tok0 = (size_t)bl * 4096 + 512 * s;
        final_pass(lds, gate + tok0 * 1024 + h * 64, y + tok0 * 1024 + h * 64, tid);
        __syncthreads();
    }
}
__device__ __forceinline__ void attn_b_phase(Frame& F, const bf16* qkv, const bf16* gate, bf16* y, const float* rpb, const float* qg, const float* kg) {
    LAS char* lds = (LAS char*)F.lds;
    LAS float* scr = (LAS float*)(lds + SCR_OFF);
    int tid_ = threadIdx.x; asm volatile("" : "+v"(tid_));
    const int tid = tid_, lane = tid & 63, wave = __builtin_amdgcn_readfirstlane(tid >> 6);
    const float cshift = 64.0f * QSCALE * wg_absmax(qg, 64, scr, tid) * wg_absmax(kg, 64, scr, tid) + LOG2E * wg_absmax(rpb, NH * 15 * 31, scr, tid);
    const int NU = BATCH * NH * 8, per = (NU + F.G - 1) / F.G;
    for (int ui = 0; ui < per; ++ui) {
        const int u = F.vcu * per + ui; if (u >= NU) break;
        const int R = u & 7, h = (u >> 3) & 15, b = u >> 7;
        for (int idx = tid; idx < 640; idx += NWAVES * 64) {
            float v = NEG; const int e = idx - 16;
            if (e >= 0 && e < 480 && (e & 31) < 31) v = LOG2E * rpb[(h * 15 + (e >> 5)) * 31 + (e & 31)] - cshift;
            ((LAS float*)(lds + TBL_OFF))[idx] = v;
        }
        __syncthreads();
        const bf16* Qb = qkv + ((size_t)(b * 16 + h) * 4096) * 64; const bf16* Kb = Qb + SECB; const bf16* Vb = Kb + SECB;
#pragma unroll 1
        for (int bb = 0; bb < 2; ++bb) {
            const int bi = 2 * wave + bb, rp = bi >> 2, cb = bi & 3;
            const int gr0 = 8 * R + 2 * rp;
            const int q = lane & 31, hi = lane >> 5;
            const int grq = gr0 + (q >> 4), gcq = 16 * cb + (q & 15);
            const int tloc = (2 * rp + (q >> 4)) * 64 + gcq;
            const int kr0 = min(max(gr0 - 4, 0), 56), krl = min(max(gr0 + 1 - 4, 0), 56) + 7, nt = krl - kr0 + 1;
            const int slab0 = min(max(16 * cb - 8, 0), 32);
            const int rsq = min(max(grq - 4, 0), 56), rlo = rsq - kr0, rhi = rlo + 7;
            const int csq = min(max(gcq - 8, 0), 48);
            float cm[16];
#pragma unroll
            for (int r = 0; r < 16; ++r) { const int kc = slab0 + (r & 3) + 8 * (r >> 2) + 4 * hi; cm[r] = ((unsigned)(kc - csq) < 16u) ? 0.f : NEG; }
            const LAS char* tb = lds + TBL_OFF + 4 * (16 + (kr0 - grq + 7) * 32 + (slab0 + 4 * hi - gcq + 15));
            const LAS char* tneg = lds + TBL_OFF + 4 * 576;
            const size_t krow0 = (size_t)(kr0 * 64 + slab0) * 64;
            f32x16 o0, o1; float lsum;
            attn_block<true>(Qb + (size_t)(512 * R + tloc) * 64, Kb + krow0, Vb + krow0, 4096, nt, tb, tneg, rlo, rhi, cm, lds + VST_OFF + wave * 4096, lane, o0, o1, lsum);
            acc_block<true>(o0, o1, lsum, lds, tloc, lane);
        }
        __syncthreads();
        const size_t tok0 = (size_t)b * 4096 + 512 * R;
        final_pass(lds, gate + tok0 * 1024 + h * 64, y + tok0 * 1024 + h * 64, tid);
        __syncthreads();
    }
}
}
struct Args { const float* in[12]; float* out; unsigned char* ws; int ph_lo, ph_hi; };
__global__ void __launch_bounds__(NWAVES * 64, 2) fwd_kernel(Args args) {
    extern __shared__ __attribute__((aligned(16))) unsigned char lds[];
    Frame F;
    F.lds = (LAS unsigned char*)lds;
    F.MISC = (volatile LAS unsigned*)(F.lds + MISC_OFF);
    F.tid = threadIdx.x; F.lane = F.tid & 63; F.wave = __builtin_amdgcn_readfirstlane(F.tid >> 6);
    F.G = gridDim.x; { const int bx = blockIdx.x; F.vcu = (F.G % 8 == 0) ? (bx % 8) * (F.G / 8) + bx / 8 : bx; }
    unsigned char* ws = args.ws;
    F.ctl = (gu32*)(ws + WS_CTL);
    for (int u = F.tid; u < (LDS_BYTES - LDSCTL_OFF) / 4; u += NWAVES * 64) ((LAS unsigned*)(F.lds + LDSCTL_OFF))[u] = 0u;
    __syncthreads();
    XcdBarrier bar = xcd_barrier_post((unsigned*)(F.ctl + CW_BAR), F.MISC + 8);
    const int lo = args.ph_lo, hi = args.ph_hi;
#define IN(k) (lo <= (k) && (k) < hi)
#define BOTH(k) (IN(k) && IN((k) + 1))
    const float* x = args.in[0]; const float* norm_gain = args.in[1];
    bf16* XB = (bf16*)(ws + WS_XB);
    float* rstd1 = (float*)(ws + WS_RSTD1); float* part2 = (float*)(ws + WS_PART2);

    if (IN(0)) {
        LAS float* scr = (LAS float*)(F.lds + RING_OFF + F.wave * 16384);
        const int gw = F.vcu * NWAVES + F.wave, NGW = F.G * NWAVES;
        constexpr int I_AIN = (DM / 64) * (NA_IN / 32), I_O = (DM / 64) * (DM / 32), I_BIN = (DM / 64) * (NB_IN / 32);
        constexpr int NITEMS = I_AIN + I_O + I_BIN + I_O;
        for (int it = gw; it < NITEMS; it += NGW) {
            int r = it;
            if (r < I_AIN) { p0_transpose_item(args.in[2], DM, NA_IN, (bf16*)(ws + WS_WAIN), norm_gain, scr, r, F.lane); continue; } r -= I_AIN;
            if (r < I_O) { p0_transpose_item(args.in[3], DM, DM, (bf16*)(ws + WS_WAOUT), nullptr, scr, r, F.lane); continue; } r -= I_O;
            if (r < I_BIN) { p0_transpose_item(args.in[7], DM, NB_IN, (bf16*)(ws + WS_WBIN), norm_gain + DM, scr, r, F.lane); continue; } r -= I_BIN;
            p0_transpose_item(args.in[8], DM, DM, (bf16*)(ws + WS_WBOUT), nullptr, scr, r, F.lane);
        }
        for (int m = gw; m < MTOK; m += NGW) {
            const GAS f32x4* xr = (const GAS f32x4*)(x + (size_t)m * DM) + F.lane;
            f32x4 v[4]; float s = 0.f;
#pragma unroll
            for (int j = 0; j < 4; ++j) { v[j] = xr[64 * j]; s += (v[j].x * v[j].x + v[j].y * v[j].y) + (v[j].z * v[j].z + v[j].w * v[j].w); }
            s = wave_sum(s);
            if (F.lane == 0) rstd1[m] = __builtin_amdgcn_rsqf(s * (1.0f / DM) + pg8::RMS_EPS);
            GAS v2u* o8 = (GAS v2u*)(XB + (size_t)m * DM) + F.lane;
#pragma unroll
            for (int j = 0; j < 4; ++j) { v2u w; w.x = pk2(v[j].x, v[j].y); w.y = pk2(v[j].z, v[j].w); o8[64 * j] = w; }
        }
        if (BOTH(0)) xcd_barrier(bar);
    }
    for (int hf = 0; hf < 2; ++hf) {
        if (IN(1 + 2 * hf)) {
            pg8::Gemm g{XB + (size_t)hf * MHALF * DM, (const bf16*)(ws + WS_WAIN), MHALF, NA_IN, DM};
            pg8::StaticOrder S; S.init(MHALF, NA_IN, F.G, (int)blockIdx.x);
            pg8::EpiIn<0> E{(bf16*)(ws + WS_QKVA), SECA, (bf16*)(ws + WS_GATEA), rstd1, args.in[4], args.in[5], hf * MHALF, QSCALE};
            pg8::gemm_phase<pg8::EpiIn<0>, pg8::StaticOrder, true>(F.lds + RING_OFF, g, S, E);
            if (BOTH(1 + 2 * hf)) xcd_barrier(bar);
        }
        if (IN(2 + 2 * hf)) {
            att::attn_a_phase(F, (const bf16*)(ws + WS_QKVA), (const bf16*)(ws + WS_GATEA), XB + (size_t)hf * MHALF * DM, args.in[6], args.in[4], args.in[5]);
            if (BOTH(2 + 2 * hf)) xcd_barrier(bar);
        }
    }
    if (IN(5)) {
        pg8::Gemm g{XB, (const bf16*)(ws + WS_WAOUT), MTOK, DM, DM};
        pg8::StaticOrder S; S.init(MTOK, DM, F.G, (int)blockIdx.x);
        pg8::EpiOut E{x, args.out, (bf16*)(ws + WS_X1B), part2};
        pg8::gemm_phase<pg8::EpiOut, pg8::StaticOrder, true>(F.lds + RING_OFF, g, S, E);
        if (BOTH(5)) xcd_barrier(bar);
    }
    if (IN(6)) {
        pg8::Gemm g{(const bf16*)(ws + WS_X1B), (const bf16*)(ws + WS_WBIN), MTOK, NB_IN, DM};
        pg8::StaticOrder S; S.init(MTOK, NB_IN, F.G, (int)blockIdx.x);
        pg8::EpiIn<1> E{(bf16*)(ws + WS_QKVB), SECB, (bf16*)(ws + WS_GATEB), part2, args.in[9], args.in[10], 0, QSCALE};
        pg8::gemm_phase<pg8::EpiIn<1>, pg8::StaticOrder, true>(F.lds + RING_OFF, g, S, E);
        if (BOTH(6)) xcd_barrier(bar);
    }
    if (IN(7)) {
        att::attn_b_phase(F, (const bf16*)(ws + WS_QKVB), (const bf16*)(ws + WS_GATEB), XB, args.in[11], args.in[9], args.in[10]);
        if (BOTH(7)) xcd_barrier(bar);
    }
    if (IN(8)) {
        pg8::Gemm g{XB, (const bf16*)(ws + WS_WBOUT), MTOK, DM, DM};
        pg8::StaticOrder S; S.init(MTOK, DM, F.G, (int)blockIdx.x);
        pg8::EpiOut E{args.out, args.out, nullptr, nullptr};
        pg8::gemm_phase<pg8::EpiOut, pg8::StaticOrder, true>(F.lds + RING_OFF, g, S, E);
    }
#undef IN
#undef BOTH
}

extern "C" void kernel_launch(void* const* d_in, const int* in_sizes, int n_in, void* d_out, int out_size, void* d_ws, size_t ws_size, hipStream_t stream) {
    static int grid = 0;
    if (grid == 0) {
        if (n_in != 12 || in_sizes[0] != MTOK * DM || out_size != MTOK * DM || ws_size < WS_END) { fprintf(stderr, "kernel_launch: unexpected shapes / workspace (%d inputs, ws %zu)\n", n_in, ws_size); grid = -1; return; }
        int dev = 0, cus = 0, per_cu = 0;
        if (hipGetDevice(&dev) != hipSuccess || hipDeviceGetAttribute(&cus, hipDeviceAttributeMultiprocessorCount, dev) != hipSuccess) { grid = -1; return; }
        if (hipFuncSetAttribute((const void*)fwd_kernel, hipFuncAttributeMaxDynamicSharedMemorySize, LDS_BYTES) != hipSuccess) { fprintf(stderr, "kernel_launch: hipFuncSetAttribute failed\n"); grid = -1; return; }
        if (hipOccupancyMaxActiveBlocksPerMultiprocessor(&per_cu, (const void*)fwd_kernel, NWAVES * 64, LDS_BYTES) != hipSuccess || per_cu < 1) { fprintf(stderr, "kernel_launch: occupancy query says %d blocks per CU\n", per_cu); per_cu = 1; }
        (void)hipGetLastError();
        grid = cus;
    }
    if (grid < 0) return;
    (void)hipMemsetAsync((char*)d_ws + WS_CTL, 0, CTL_ZERO_BYTES, stream);
    Args a{};
    for (int i = 0; i < 12; ++i) a.in[i] = (const float*)d_in[i];
    a.out = (float*)d_out; a.ws = (unsigned char*)d_ws;
    a.ph_lo = 0; a.ph_hi = 9;
    void* kargs[] = {&a};
    hipError_t e = hipLaunchCooperativeKernel((const void*)fwd_kernel, dim3(grid), dim3(NWAVES * 64), kargs, LDS_BYTES, stream);
    if (e != hipSuccess) fprintf(stderr, "kernel_launch: cooperative launch failed: %s (grid %d)\n", hipGetErrorString(e), grid);
}
```

```cpp
#define PROBE_REP -1
#include <hip/hip_runtime.h>
#include <cstdio>
#include <cstdint>
template <int CTRL> __device__ __forceinline__ float dpp_mov(float v) { return __int_as_float(__builtin_amdgcn_update_dpp(0, __float_as_int(v), CTRL, 0xF, 0xF, true)); }
__device__ __forceinline__ void swap16(float v, float& a, float& b) { auto r = __builtin_amdgcn_permlane16_swap(__float_as_uint(v), __float_as_uint(v), false, false); const unsigned r0 = r[0], r1 = r[1]; a = __uint_as_float(r0); b = __uint_as_float(r1); }
__device__ __forceinline__ void swap32(float v, float& a, float& b) { auto r = __builtin_amdgcn_permlane32_swap(__float_as_uint(v), __float_as_uint(v), false, false); const unsigned r0 = r[0], r1 = r[1]; a = __uint_as_float(r0); b = __uint_as_float(r1); }
__device__ __forceinline__ float sum_x16(float v) { float a, b; swap16(v, a, b); return a + b; }
__device__ __forceinline__ float sum_x32(float v) { float a, b; swap32(v, a, b); return a + b; }
__device__ __forceinline__ float max_x16(float v) { float a, b; swap16(v, a, b); return fmaxf(a, b); }
__device__ __forceinline__ float max_x32(float v) { float a, b; swap32(v, a, b); return fmaxf(a, b); }
__device__ __forceinline__ float wave_sum(float v) { v += dpp_mov<0xB1>(v); v += dpp_mov<0x4E>(v); v += dpp_mov<0x141>(v); v += dpp_mov<0x140>(v); v = sum_x16(v); return sum_x32(v); }
__device__ __forceinline__ float wave_max(float v) { v = fmaxf(v, dpp_mov<0xB1>(v)); v = fmaxf(v, dpp_mov<0x4E>(v)); v = fmaxf(v, dpp_mov<0x141>(v)); v = fmaxf(v, dpp_mov<0x140>(v)); v = max_x16(v); return max_x32(v); }
namespace pg8 {
#define PG8_LAS __attribute__((address_space(3)))
typedef unsigned short bf16_t;
typedef short bf16x8 __attribute__((ext_vector_type(8)));
typedef float f32x4 __attribute__((ext_vector_type(4)));
typedef unsigned u32x4 __attribute__((ext_vector_type(4)));
typedef unsigned u32x2 __attribute__((ext_vector_type(2)));
constexpr int BM = 256, BK = 64, HALF = 128, HTB = HALF * BK * 2  , STAGE_BYTES = 8 * HTB, NXCD = 8, WGM = 8;

__host__ __device__ __forceinline__ int lds_byte(int r, int c) { const int st = (r >> 4) * 2 + (c >> 5), rr = r & 15, cc = c & 31, ob = rr * 64 + cc * 2; return st * 1024 + (ob ^ (((ob >> 9) & 1) << 5)); }
__host__ __device__ __forceinline__ void stage_rc(int b, int& R, int& C) { const int st = b / 1024, sb = b % 1024, swz = sb ^ (((sb >> 9) & 1) << 5); R = (st >> 1) * 16 + swz / 64; C = (st & 1) * 32 + (swz % 64) / 2; }
__host__ __device__ __forceinline__ int perm32(int rho) { const int n = rho >> 4, i = rho & 15; return 8 * (i >> 2) + 4 * n + (i & 3); }

struct Unit { int pm, pn; };
struct Gemm { const bf16_t* A; const bf16_t* Bt; int M, N, K; };

struct StaticOrder {
    int nM, nN, nwg, G, c;
    __host__ __device__ void init(int M, int N, int G_, int c_) { nM = M / BM; nN = N / BM; nwg = nM * nN; G = G_; c = c_; }
    __host__ __device__ bool next(int i, Unit& u) const {
        const long L = (long)i * G + c; if (L >= nwg) return false;
        int wgid = (int)L; { const int q = nwg / NXCD, r = nwg % NXCD, xcd = wgid % NXCD, off = wgid / NXCD; wgid = (xcd < r ? xcd * (q + 1) : r * (q + 1) + (xcd - r) * q) + off; }
        const int nig = WGM * nN, gid = wgid / nig, fm = gid * WGM, gsz = (nM - fm) < WGM ? (nM - fm) : WGM;
        u.pm = fm + ((wgid % nig) % gsz); u.pn = (wgid % nig) / gsz; return true;
    }
};

__device__ __forceinline__ unsigned cvt_pk_bf16(float lo, float hi) { unsigned r; asm volatile("v_cvt_pk_bf16_f32 %0, %1, %2" : "=v"(r) : "v"(lo), "v"(hi)); return r; }


constexpr float RMS_EPS = 1e-6f;
template <int MODE> struct EpiIn {
    static constexpr bool HEADMAP = true;
    bf16_t* qkv; size_t sec_stride; bf16_t* gate; const float* rs; const float* qg; const float* kg; int row_base; float qscale;
    __device__ __forceinline__ void operator()(const f32x4 (&acc)[2][2][4][2], const Unit& u, int wr, int wc, int fr, int fq) const {
        const int sec = u.pn >> 2, hq = u.pn & 3, h = hq * 4 + wc;
        int type, g = 0;
        if (MODE == 0) { if (sec == 9) type = 3; else { g = sec / 3; type = sec - 3 * g; } } else type = sec;
        const int shift = (MODE == 0) ? 2 * g : 0;
        f32x4 gv[2][2];
#pragma unroll
        for (int bj = 0; bj < 2; ++bj)
#pragma unroll
            for (int n = 0; n < 2; ++n) gv[bj][n] = (f32x4){1.f, 1.f, 1.f, 1.f};
        if (type < 2) {
            const float* gp = (type == 0 ? qg : kg) + (MODE == 0 ? g * 64 : 0) + 8 * fq;
            const float sc = (type == 0) ? qscale : 1.f;
#pragma unroll
            for (int bj = 0; bj < 2; ++bj)
#pragma unroll
                for (int n = 0; n < 2; ++n) gv[bj][n] = *(const f32x4*)(gp + 32 * bj + 4 * n) * sc;
        }
#pragma unroll
        for (int ai = 0; ai < 2; ++ai)
#pragma unroll
            for (int m = 0; m < 4; ++m) {
                const int r = u.pm * BM + ai * HALF + wr * 64 + m * 16 + fr;
                float rsv;
                if (MODE == 0) rsv = rs[row_base + r];
                else { const f32x4 pp = *(const f32x4*)(rs + (size_t)(row_base + r) * 16 + 4 * fq); float s = (pp[0] + pp[1]) + (pp[2] + pp[3]); s = sum_x16(s); s = sum_x32(s); rsv = __builtin_amdgcn_rsqf(s * (1.0f / 1024.0f) + RMS_EPS); }
                f32x4 v[2][2];
#pragma unroll
                for (int bj = 0; bj < 2; ++bj)
#pragma unroll
                    for (int n = 0; n < 2; ++n) v[bj][n] = acc[ai][bj][m][n] * rsv;
                if (type < 2) {
                    float ss = 0.f;
#pragma unroll
                    for (int bj = 0; bj < 2; ++bj)
#pragma unroll
                        for (int n = 0; n < 2; ++n) { const f32x4 x = v[bj][n]; ss += (x[0] * x[0] + x[1] * x[1]) + (x[2] * x[2] + x[3] * x[3]); }
                    ss = sum_x16(ss); ss = sum_x32(ss);
                    const float inv = __builtin_amdgcn_rsqf(ss * (1.0f / 64.0f) + RMS_EPS);
#pragma unroll
                    for (int bj = 0; bj < 2; ++bj)
#pragma unroll
                        for (int n = 0; n < 2; ++n) v[bj][n] = v[bj][n] * gv[bj][n] * inv;
                } else if (type == 3) {
#pragma unroll
                    for (int bj = 0; bj < 2; ++bj)
#pragma unroll
                        for (int n = 0; n < 2; ++n)
#pragma unroll
                            for (int i = 0; i < 4; ++i) { const float x = v[bj][n][i]; v[bj][n][i] = x * __builtin_amdgcn_rcpf(1.0f + __expf(-x)); }
                }
                bf16_t* p;
                if (type < 3) { const int t = r & 4095, bl = r >> 12; const int pos = ((t & ((1 << shift) - 1)) << (12 - shift)) | (t >> shift);
                    p = qkv + (size_t)sec * sec_stride + ((size_t)(bl * 16 + h) * 4096 + pos) * 64 + 8 * fq; }
                else p = gate + (size_t)r * 1024 + hq * 256 + wc * 64 + 8 * fq;
#pragma unroll
                for (int bj = 0; bj < 2; ++bj) { u32x4 w; w.x = cvt_pk_bf16(v[bj][0][0], v[bj][0][1]); w.y = cvt_pk_bf16(v[bj][0][2], v[bj][0][3]); w.z = cvt_pk_bf16(v[bj][1][0], v[bj][1][1]); w.w = cvt_pk_bf16(v[bj][1][2], v[bj][1][3]);
                    *(u32x4*)(p + 32 * bj) = w; }
            }
    }
};

struct EpiOut {
    static constexpr bool HEADMAP = false;
    const float* base; float* out; bf16_t* xb; float* part;
    __device__ __forceinline__ void operator()(const f32x4 (&acc)[2][2][4][2], const Unit& u, int wr, int wc, int fr, int fq) const {
#pragma unroll
        for (int ai = 0; ai < 2; ++ai)
#pragma unroll
            for (int m = 0; m < 4; ++m) {
                const int r = u.pm * BM + ai * HALF + wr * 64 + m * 16 + fr;
                const size_t off = (size_t)r * 1024 + u.pn * BM + wc * 32 + 4 * fq;
                float ss = 0.f;
#pragma unroll
                for (int bj = 0; bj < 2; ++bj)
#pragma unroll
                    for (int n = 0; n < 2; ++n) {
                        const f32x4 bs = *(const f32x4*)(base + off + bj * HALF + n * 16);
                        const f32x4 o = bs + acc[ai][bj][m][n];
                        *(f32x4*)(out + off + bj * HALF + n * 16) = o;
                        if (xb) { u32x2 w; w.x = cvt_pk_bf16(o[0], o[1]); w.y = cvt_pk_bf16(o[2], o[3]); *(u32x2*)(xb + off + bj * HALF + n * 16) = w; }
                        ss += (o[0] * o[0] + o[1] * o[1]) + (o[2] * o[2] + o[3] * o[3]);
                    }
                if (part) { ss = sum_x16(ss); ss = sum_x32(ss); if (fq == 0) part[(size_t)r * 16 + u.pn * 4 + wc] = ss; }
            }
    }
};

template <class Epi, class Sched, bool ALIGN_EPI>
__device__ __forceinline__ void gemm_phase(PG8_LAS unsigned char* lds, const Gemm g, const Sched& S, const Epi& E, const int wave_) {
    int tid_ = wave_ * 64 + (int)__builtin_amdgcn_mbcnt_hi(~0u, __builtin_amdgcn_mbcnt_lo(~0u, 0u)); asm volatile("" : "+v"(tid_));
    const int tid = tid_, wid = __builtin_amdgcn_readfirstlane(tid >> 6), lane = tid & 63, wr = wid >> 2, wc = wid & 3, fr = lane & 15, fq = lane >> 4;
    const int K = g.K, nt = K / BK;
    unsigned voffA[2], voffB[2];
#pragma unroll
    for (int i = 0; i < 2; ++i) { int R, C; stage_rc(tid * 16 + i * 8192, R, C);
        const int Rb = Epi::HEADMAP ? (64 * (R >> 5) + perm32(R & 31)) : R;
        voffA[i] = (unsigned)(R * K + C) * 2u; voffB[i] = (unsigned)(Rb * K + C) * 2u; }
    const size_t kstep = (size_t)(BK * 2);
    const size_t hstep = (size_t)HALF * K * 2;
    const size_t hstepB = Epi::HEADMAP ? (size_t)32 * K * 2 : hstep;
    const size_t tstep = 2 * hstep;
    const unsigned ldsw = (unsigned)wid * 1024u;
    const int aoff = lds_byte(wr * 64 + fr, fq * 8), boff = lds_byte(wc * 32 + fr, fq * 8);
#define PG8_SA(b, h) (((b) * 2 + (h)) * HTB)
#define PG8_SB(b, h) ((4 + (b) * 2 + (h)) * HTB)
#define PG8_STAGE(bufoff, gbase, voff) do { _Pragma("unroll") for (int _i = 0; _i < 2; ++_i) \
        __builtin_amdgcn_global_load_lds((const unsigned*)((const char*)(gbase) + (voff)[_i]), (PG8_LAS unsigned*)(lds + (bufoff) + ldsw + _i * 8192), 16, 0, 0); } while (0)
#define PG8_LDA(dst, b, h) do { _Pragma("unroll") for (int m = 0; m < 4; ++m) _Pragma("unroll") for (int k = 0; k < 2; ++k) dst[m][k] = *(const PG8_LAS bf16x8*)(lds + PG8_SA(b, h) + aoff + m * 2048 + k * 1024); } while (0)
#define PG8_LDB(dst, b, h) do { _Pragma("unroll") for (int n = 0; n < 2; ++n) _Pragma("unroll") for (int k = 0; k < 2; ++k) dst[n][k] = *(const PG8_LAS bf16x8*)(lds + PG8_SB(b, h) + boff + n * 2048 + k * 1024); } while (0)
#define PG8_MMA(ai, bj, At, Bt) do { __builtin_amdgcn_s_setprio(1); _Pragma("unroll") for (int m = 0; m < 4; ++m) _Pragma("unroll") for (int n = 0; n < 2; ++n) _Pragma("unroll") for (int k = 0; k < 2; ++k) \
        acc[ai][bj][m][n] = __builtin_amdgcn_mfma_f32_16x16x32_bf16(Bt[n][k], At[m][k], acc[ai][bj][m][n], 0, 0, 0); __builtin_amdgcn_s_setprio(0); } while (0)
#define PG8_WAIT_V(n) asm volatile("s_waitcnt vmcnt(" #n ")" ::: "memory")
#define PG8_WAIT_L(n) asm volatile("s_waitcnt lgkmcnt(" #n ")" ::: "memory")
#define PG8_BAR __builtin_amdgcn_s_barrier()
#define PG8_SCHED __builtin_amdgcn_sched_barrier(0)
    Unit cur, nxt; int ui = 0;
    if (!S.next(0, cur)) return;
    f32x4 acc[2][2][4][2];
#pragma unroll
    for (int a = 0; a < 2; ++a)
#pragma unroll
        for (int b = 0; b < 2; ++b)
#pragma unroll
            for (int m = 0; m < 4; ++m)
#pragma unroll
                for (int n = 0; n < 2; ++n) acc[a][b][m][n] = (f32x4){0.f, 0.f, 0.f, 0.f};
    bf16x8 At[4][2], B0[2][2], B1[2][2];
    const char* cA = (const char*)g.A + (size_t)cur.pm * tstep; const char* cB = (const char*)g.Bt + (size_t)cur.pn * tstep;
    PG8_STAGE(PG8_SB(0, 0), cB, voffB); PG8_STAGE(PG8_SB(0, 1), cB + hstepB, voffB); PG8_STAGE(PG8_SA(0, 0), cA, voffA); PG8_STAGE(PG8_SA(0, 1), cA + hstep, voffA);
    if (wr == 1) PG8_BAR;
    PG8_WAIT_V(2); PG8_BAR;
    PG8_STAGE(PG8_SB(1, 0), cB + kstep, voffB); PG8_STAGE(PG8_SA(1, 0), cA + kstep, voffA); PG8_STAGE(PG8_SB(1, 1), cB + hstepB + kstep, voffB);
    PG8_WAIT_V(6); PG8_BAR;
    for (;;) {
        const bool has_next = S.next(ui + 1, nxt);
        const char* nA = has_next ? (const char*)g.A + (size_t)nxt.pm * tstep : cA; const char* nB = has_next ? (const char*)g.Bt + (size_t)nxt.pn * tstep : cB;
        for (int t = 0; t < nt; t += 2) {
            const bool last = (t == nt - 2);
            const char* a1 = cA + (size_t)(t + 1) * kstep;
            const char* a2 = last ? nA : cA + (size_t)(t + 2) * kstep; const char* b2 = last ? nB : cB + (size_t)(t + 2) * kstep;
            const char* a3 = a2 + kstep; const char* b3 = b2 + kstep;
            PG8_LDB(B0, 0, 0); PG8_LDB(B1, 0, 1); PG8_SCHED; PG8_LDA(At, 0, 0); PG8_STAGE(PG8_SA(1, 1), a1 + hstep, voffA);
            PG8_WAIT_V(8); PG8_WAIT_L(0); PG8_BAR; PG8_MMA(0, 0, At, B0); PG8_MMA(0, 1, At, B1); PG8_BAR; PG8_SCHED;
            PG8_LDA(At, 0, 1); PG8_STAGE(PG8_SB(0, 0), b2, voffB); PG8_STAGE(PG8_SB(0, 1), b2 + hstepB, voffB); PG8_STAGE(PG8_SA(0, 0), a2, voffA);
            PG8_WAIT_V(8); PG8_WAIT_L(0); PG8_BAR; PG8_MMA(1, 0, At, B0); PG8_MMA(1, 1, At, B1); PG8_BAR; PG8_SCHED;
            PG8_LDB(B0, 1, 0); PG8_LDB(B1, 1, 1); PG8_SCHED; PG8_LDA(At, 1, 0); PG8_STAGE(PG8_SA(0, 1), a2 + hstep, voffA);
            PG8_WAIT_V(8); PG8_WAIT_L(0); PG8_BAR; PG8_MMA(0, 0, At, B0); PG8_MMA(0, 1, At, B1); PG8_BAR; PG8_SCHED;
            PG8_LDA(At, 1, 1); PG8_STAGE(PG8_SB(1, 0), b3, voffB); PG8_STAGE(PG8_SB(1, 1), b3 + hstepB, voffB); PG8_STAGE(PG8_SA(1, 0), a3, voffA);
            PG8_WAIT_V(8); PG8_WAIT_L(0); PG8_BAR; PG8_MMA(1, 0, At, B0); PG8_MMA(1, 1, At, B1); PG8_BAR; PG8_SCHED;
        }
        if constexpr (ALIGN_EPI) { if (wr == 0) PG8_BAR; }
        E(acc, cur, wr, wc, fr, fq);
        if (!has_next) break;
#pragma unroll
        for (int a = 0; a < 2; ++a)
#pragma unroll
            for (int b = 0; b < 2; ++b)
#pragma unroll
                for (int m = 0; m < 4; ++m)
#pragma unroll
                    for (int n = 0; n < 2; ++n) acc[a][b][m][n] = (f32x4){0.f, 0.f, 0.f, 0.f};
        cur = nxt; cA = nA; cB = nB; ++ui;
        if constexpr (ALIGN_EPI) { if (wr == 1) PG8_BAR; }
    }
    PG8_WAIT_V(0);
    if constexpr (!ALIGN_EPI) { if (wr == 0) PG8_BAR; }
    PG8_BAR;
#undef PG8_SA
#undef PG8_SB
#undef PG8_STAGE
#undef PG8_LDA
#undef PG8_LDB
#undef PG8_MMA
#undef PG8_WAIT_V
#undef PG8_WAIT_L
#undef PG8_BAR
#undef PG8_SCHED
}
}
constexpr int NWAVES = 8;
constexpr int BATCH = 8, SEQ = 4096, DM = 1024, NH = 16, HD = 64;
constexpr int MTOK = BATCH * SEQ;
constexpr int MHALF = MTOK / 2;
constexpr int NA_IN = 10240, NB_IN = 4096;
constexpr float LOG2E = 1.4426950408889634f;
constexpr float QSCALE = 0.125f * LOG2E;

constexpr size_t MiB = 1u << 20;
constexpr size_t WS_CTL = 0, CTL_ZERO_BYTES = 1 * MiB;
constexpr size_t WS_RSTD1 = 1 * MiB;
constexpr size_t WS_PART2 = 2 * MiB;
constexpr size_t WS_WAIN = 4 * MiB, WS_WAOUT = 24 * MiB, WS_WBIN = 26 * MiB, WS_WBOUT = 34 * MiB;
constexpr size_t WS_XB = 36 * MiB;
constexpr size_t WS_QKVA = 100 * MiB;
constexpr size_t SECA = (size_t)4 * NH * SEQ * HD;
constexpr size_t WS_GATEA = WS_QKVA + 9 * 32 * MiB;
constexpr size_t WS_X1B = 100 * MiB;
constexpr size_t WS_QKVB = 164 * MiB;
constexpr size_t SECB = (size_t)8 * NH * SEQ * HD;
constexpr size_t WS_GATEB = WS_QKVB + 3 * 64 * MiB;
constexpr size_t WS_END = 420 * MiB;
static_assert(WS_GATEA + 32 * MiB <= WS_END && WS_GATEB + 64 * MiB <= WS_END && WS_X1B + 64 * MiB <= WS_QKVB, "ws map");
constexpr int CW_BAR = 4096;

constexpr int RING_OFF = 0, RING_BYTES = 131072;
constexpr int PHASE_LDS = 155648;
constexpr int LDSCTL_OFF = PHASE_LDS, MISC_OFF = LDSCTL_OFF + 320;
constexpr int LDS_BYTES = 159744;

#define GAS __attribute__((address_space(1)))
#define LAS __attribute__((address_space(3)))
typedef unsigned short bf16;
typedef unsigned v4u __attribute__((ext_vector_type(4)));
typedef unsigned v2u __attribute__((ext_vector_type(2)));
typedef float f32x4 __attribute__((ext_vector_type(4)));
typedef short bf16x8 __attribute__((ext_vector_type(8)));
typedef GAS unsigned gu32;
#define RLX_AGENT __ATOMIC_RELAXED, __HIP_MEMORY_SCOPE_AGENT
#define LDS_WAIT() asm volatile("s_waitcnt lgkmcnt(0)" ::: "memory")
#define VM_WAIT() asm volatile("s_waitcnt vmcnt(0)" ::: "memory")
__device__ __forceinline__ unsigned f2bf(float f) { unsigned u = __builtin_bit_cast(unsigned, f); return (u + 0x7fffu + ((u >> 16) & 1u)) >> 16; }
__device__ __forceinline__ unsigned pk2(float lo, float hi) { return f2bf(lo) | (f2bf(hi) << 16); }
__device__ __forceinline__ float bf2f(unsigned short h) { return __builtin_bit_cast(float, (unsigned)h << 16); }

__device__ __forceinline__ int lane_id() { return (int)__builtin_amdgcn_mbcnt_hi(~0u, __builtin_amdgcn_mbcnt_lo(~0u, 0u)); }
#define XB_TMO      128
#define XB_XCNT(j)  (256  + 64 * (j))
#define XB_XSUB(j)  (1280 + 64 * (j))
#define XB_XGEN(j)  (2304 + 64 * (j))
#define XB_TOP      3328
#define XB_TOPGEN   3392
#define XCD_BAR_WORDS 3456
#define XB_SPIN_CAP (1u << 18)
__device__ __forceinline__ unsigned xb_ld(unsigned* p)              { return __hip_atomic_load(p, __ATOMIC_RELAXED, __HIP_MEMORY_SCOPE_AGENT); }
__device__ __forceinline__ unsigned xb_add(unsigned* p, unsigned v) { return __hip_atomic_fetch_add(p, v, __ATOMIC_RELAXED, __HIP_MEMORY_SCOPE_AGENT); }
__device__ __forceinline__ unsigned xb_xcc_id() { return (unsigned)__builtin_amdgcn_s_getreg((3 << 11) | 20) & 0xFu; }
#define XB_SPIN(cond, bar) do { unsigned _sp = 0; while (cond) { __builtin_amdgcn_s_sleep(1); \
    if ((++_sp & 255u) == 0u) { if (xb_ld(&(bar)[XB_TMO])) break; if (_sp > XB_SPIN_CAP) { atomicAdd(&(bar)[XB_TMO], 1u); break; } } } } while (0)
struct XcdBarrier { unsigned* bar; unsigned x; volatile LAS unsigned* st; int wave; };
__device__ __forceinline__ XcdBarrier xcd_barrier_post(unsigned* bar, volatile LAS unsigned* st, int wave) {
    XcdBarrier b; b.bar = bar; b.x = xb_xcc_id(); b.st = st; b.wave = wave;
    if (wave == 0 && lane_id() == 0) (void)xb_add(&bar[XB_XCNT(b.x)], 1u);
    return b;
}
__device__ __forceinline__ void xcd_barrier_complete(unsigned* bar, unsigned x, unsigned& nloc, unsigned& nx) {
    const unsigned G = gridDim.x * gridDim.y * gridDim.z;
    unsigned sum, cnt, mine, sp = 0u;
    for (;;) {
        sum = 0u; cnt = 0u; mine = 0u;
#pragma unroll
        for (unsigned j = 0; j < 16; ++j) { const unsigned c = xb_ld(&bar[XB_XCNT(j)]); sum += c; cnt += (c > 0u) ? 1u : 0u; mine = (j == x) ? c : mine; }
        if (sum == G) break;
        __builtin_amdgcn_s_sleep(1);
        if ((++sp & 255u) == 0u) { if (xb_ld(&bar[XB_TMO])) break; if (sp > XB_SPIN_CAP) { atomicAdd(&bar[XB_TMO], 1u); break; } }
    }
    nloc = mine > 0u ? mine : 1u; nx = cnt > 0u ? cnt : 1u;
}
__device__ __forceinline__ void xcd_barrier(const XcdBarrier& b) {
    asm volatile("s_waitcnt vmcnt(0)" ::: "memory");
    __syncthreads();
    if (b.wave == 0 && lane_id() == 0) {
        unsigned* bar = b.bar; asm volatile("" : "+s"(bar));
        __builtin_amdgcn_s_waitcnt(0);
        unsigned nloc = b.st[0], nx = b.st[1];
        if (nloc == 0u) { xcd_barrier_complete(bar, b.x, nloc, nx); b.st[0] = nloc; b.st[1] = nx; }
        const unsigned old = xb_add(&bar[XB_XSUB(b.x)], 1u);
        const unsigned gen = old / nloc;
        if (old + 1u == (gen + 1u) * nloc) {
            __builtin_amdgcn_fence(__ATOMIC_RELEASE, "agent");
            asm volatile("s_waitcnt vmcnt(0)" ::: "memory");
            const unsigned og = xb_add(&bar[XB_TOP], 1u);
            const unsigned tg = og / nx;
            if (og + 1u == (tg + 1u) * nx) xb_add(&bar[XB_TOPGEN], 1u);
            else XB_SPIN(xb_ld(&bar[XB_TOPGEN]) == tg, bar);
            __builtin_amdgcn_fence(__ATOMIC_ACQUIRE, "agent");
            xb_add(&bar[XB_XGEN(b.x)], 1u);
            asm volatile("s_waitcnt vmcnt(0)" ::: "memory");
        } else {
            XB_SPIN(xb_ld(&bar[XB_XGEN(b.x)]) == gen, bar);
            __builtin_amdgcn_fence(__ATOMIC_ACQUIRE, "agent");
            asm volatile("s_waitcnt vmcnt(0)" ::: "memory");
        }
    }
    __syncthreads();
}

struct Frame {
    LAS unsigned char* lds;
    volatile LAS unsigned* MISC;
    gu32* ctl;
    int tid, lane, wave, vcu, G;
};

__device__ __forceinline__ void p0_transpose_item(const float* W, int K, int N, bf16* WT, const float* gk, LAS float* scr, int item, int lane) {
    const int nblk = N / 32, kb = item / nblk, nb = item % nblk, k0 = 64 * kb, n0 = 32 * nb;
#pragma unroll 8
    for (int i = 0; i < 32; ++i) { const int kk = 2 * i + (lane >> 5); const float gsc = gk ? gk[k0 + kk] : 1.0f; scr[kk * 33 + (lane & 31)] = W[(size_t)(k0 + kk) * N + n0 + (lane & 31)] * gsc; }
    LDS_WAIT(); asm volatile("" ::: "memory");
    const int c = lane & 7;
#pragma unroll
    for (int j = 0; j < 4; ++j) { const int n = (lane >> 3) + 8 * j; const LAS float* s = scr + (8 * c) * 33 + n;
        v4u o; o.x = pk2(s[0 * 33], s[1 * 33]); o.y = pk2(s[2 * 33], s[3 * 33]); o.z = pk2(s[4 * 33], s[5 * 33]); o.w = pk2(s[6 * 33], s[7 * 33]);
        *(GAS v4u*)(WT + (size_t)(n0 + n) * K + k0 + 8 * c) = o; }
    LDS_WAIT(); asm volatile("" ::: "memory");
}
__device__ __forceinline__ int t5_bucket_dev(int rel) {
    const int n = rel < 0 ? -rel : rel;
    const int b = n < 8 ? n : 8 + (n >= 15) + (n >= 27) + (n >= 50) + (n >= 91) + (n >= 167) + (n >= 305) + (n >= 559);
    return b + (rel > 0 ? 16 : 0);
}
namespace att {
typedef float f32x16 __attribute__((ext_vector_type(16)));
typedef short s16x4 __attribute__((ext_vector_type(4)));
typedef short v4i16_t __attribute__((ext_vector_type(4)));
typedef float f32x2_t __attribute__((ext_vector_type(2)));
typedef __bf16 bf16x2_t __attribute__((ext_vector_type(2)));
constexpr float NEG = -1e30f;
constexpr int ACC_PITCH = 136;
constexpr int ACC_OFF = 0, LACC_OFF = 512 * ACC_PITCH, TBL_OFF = LACC_OFF + 2048, TBL_BYTES = 4096  , SCR_OFF = TBL_OFF + 2 * TBL_BYTES, VST_OFF = SCR_OFF + 256, STAGE_BYTES = 8192, LDS_END = VST_OFF + 8 * STAGE_BYTES;
static_assert(VST_OFF % 16 == 0 && LDS_END <= PHASE_LDS, "attention LDS map");
__device__ __forceinline__ int rho(int t) { return t ^ ((t >> 5) & 15); }
__device__ __forceinline__ unsigned cvtpk(float lo, float hi) { f32x2_t v = {lo, hi}; bf16x2_t b = __builtin_convertvector(v, bf16x2_t); return __builtin_bit_cast(unsigned, b); }
__device__ __forceinline__ s16x4 vtr(const LAS char* p) { return __builtin_bit_cast(s16x4, __builtin_amdgcn_ds_read_tr16_b64_v4i16((LAS v4i16_t*)p)); }

struct Seg {
    const bf16* qA; const bf16* qB;
    const bf16* kt; const bf16* vt;
    const LAS char* tbA; const LAS char* tbB; const LAS char* tneg;
    int tstride, nt, aHi, bLo, bHi;
    int raLo, rbLo;
    int tlocA, tlocB;
    int first, dual;
};
struct St { bf16x8 qA[4], qB[4]; };
struct Lay { unsigned kOffE, kOffO, vOff; int rdK[4]; int vrd; };
__device__ __forceinline__ void lay_init(Lay& L, int lane) {
    const int l3 = (lane >> 3) & 1, l4 = (lane >> 4) & 1, l5 = (lane >> 5) & 1, c7 = lane & 7;
    const unsigned rows = 1024u * l3 + 512u * l5 + 256u * l4;
    L.kOffE = rows + 16u * (unsigned)(c7 ^ (4 * l5 + 2 * l4));
    L.kOffO = rows + 128u + 16u * (unsigned)(c7 ^ (4 * l5 + 2 * l4 + 1));
    L.vOff = (unsigned)((lane >> 2) * 128 + (lane & 3) * 16);
    const int r32 = lane & 31, hi = lane >> 5, kp = (r32 & ~9) | ((r32 & 1) << 3) | ((r32 >> 3) & 1), m = r32 & 7;
#pragma unroll
    for (int d0 = 0; d0 < 4; ++d0) L.rdK[d0] = 128 * kp + 16 * ((2 * d0 + hi) ^ m);
    L.vrd = 4096 + ((lane >> 4) & 1) * 32 + (lane & 3) * 8 + (4 * hi + ((lane & 15) >> 2)) * 64;
}
#define ATT_GLDS(g, l) __builtin_amdgcn_global_load_lds((const unsigned*)(g), (LAS unsigned*)(l), 16, 0, 0)
__device__ __forceinline__ void dma_tile(const bf16* kt, const bf16* vt, LAS char* stage, const Lay& L) {
    const char* kb = (const char*)kt; const char* vb = (const char*)vt + L.vOff;
    ATT_GLDS(kb + L.kOffE, stage); ATT_GLDS(kb + L.kOffO, stage + 1024); ATT_GLDS(kb + L.kOffE + 2048, stage + 2048); ATT_GLDS(kb + L.kOffO + 2048, stage + 3072);
    ATT_GLDS(vb, stage + 4096); ATT_GLDS(vb + 2048, stage + 5120); ATT_GLDS(vb + 64, stage + 6144); ATT_GLDS(vb + 2048 + 64, stage + 7168);
}
__device__ __forceinline__ void seg_start(const Seg& s, St& st, int lane) {
    const int hi = lane >> 5;
#pragma unroll
    for (int d0 = 0; d0 < 4; ++d0) { st.qA[d0] = *(const bf16x8*)(s.qA + d0 * 16 + hi * 8); st.qB[d0] = *(const bf16x8*)(s.qB + d0 * 16 + hi * 8); }
}
template <bool CM>
__device__ __forceinline__ void cinit(f32x16& p, const LAS char* tb, const LAS char* tneg, int t, int rlo, const float (&cm)[16]) {
    const LAS char* ta = tb + 128 * t;
    if (CM) ta = ((unsigned)(t - rlo) < 8u) ? ta : tneg;
#pragma unroll
    for (int r = 0; r < 16; ++r) { p[r] = *(const LAS float*)(ta + 4 * ((r & 3) + 8 * (r >> 2))); if (CM) p[r] += cm[r]; }
}
__device__ __forceinline__ void softmax_pack(f32x16& p, float& lsum, bf16x8& pf0, bf16x8& pf1) {
#pragma unroll
    for (int r = 0; r < 16; ++r) { p[r] = __builtin_amdgcn_exp2f(p[r]); lsum += p[r]; }
    v4u pk0, pk1;
    pk0.x = cvtpk(p[0], p[1]); pk0.y = cvtpk(p[2], p[3]); pk0.z = cvtpk(p[4], p[5]); pk0.w = cvtpk(p[6], p[7]);
    pk1.x = cvtpk(p[8], p[9]); pk1.y = cvtpk(p[10], p[11]); pk1.z = cvtpk(p[12], p[13]); pk1.w = cvtpk(p[14], p[15]);
    pf0 = __builtin_bit_cast(bf16x8, pk0); pf1 = __builtin_bit_cast(bf16x8, pk1);
}
template <bool CM>
__device__ __forceinline__ void tile_step(int t, const bf16x8 (&kf)[4], const bf16x8 (&vf)[4], const bf16x8 (&q)[4], const LAS char* tb, const LAS char* tneg, int rlo,
                                          const float (&cm)[16], f32x16& o0, f32x16& o1, float& lsum) {
    f32x16 p; cinit<CM>(p, tb, tneg, t, rlo, cm);
#pragma unroll
    for (int d0 = 0; d0 < 4; ++d0) p = __builtin_amdgcn_mfma_f32_32x32x16_bf16(kf[d0], q[d0], p, 0, 0, 0);
    bf16x8 pf0, pf1; softmax_pack(p, lsum, pf0, pf1);
    o0 = __builtin_amdgcn_mfma_f32_32x32x16_bf16(vf[0], pf0, o0, 0, 0, 0);
    o0 = __builtin_amdgcn_mfma_f32_32x32x16_bf16(vf[1], pf1, o0, 0, 0, 0);
    o1 = __builtin_amdgcn_mfma_f32_32x32x16_bf16(vf[2], pf0, o1, 0, 0, 0);
    o1 = __builtin_amdgcn_mfma_f32_32x32x16_bf16(vf[3], pf1, o1, 0, 0, 0);
}
template <bool CM>
__device__ __forceinline__ void tile_step2(int t, const bf16x8 (&kf)[4], const bf16x8 (&vf)[4], const St& st, const Seg& s, const float (&cm)[16],
                                           f32x16& oA0, f32x16& oA1, float& lA, f32x16& oB0, f32x16& oB1, float& lB) {
    f32x16 pA, pB; cinit<CM>(pA, s.tbA, s.tneg, t, s.raLo, cm); cinit<CM>(pB, s.tbB, s.tneg, t, s.rbLo, cm);
#pragma unroll
    for (int d0 = 0; d0 < 4; ++d0) pA = __builtin_amdgcn_mfma_f32_32x32x16_bf16(kf[d0], st.qA[d0], pA, 0, 0, 0);
#pragma unroll
    for (int d0 = 0; d0 < 4; ++d0) pB = __builtin_amdgcn_mfma_f32_32x32x16_bf16(kf[d0], st.qB[d0], pB, 0, 0, 0);
    bf16x8 pf0, pf1; softmax_pack(pA, lA, pf0, pf1);
    oA0 = __builtin_amdgcn_mfma_f32_32x32x16_bf16(vf[0], pf0, oA0, 0, 0, 0);
    oA0 = __builtin_amdgcn_mfma_f32_32x32x16_bf16(vf[1], pf1, oA0, 0, 0, 0);
    oA1 = __builtin_amdgcn_mfma_f32_32x32x16_bf16(vf[2], pf0, oA1, 0, 0, 0);
    oA1 = __builtin_amdgcn_mfma_f32_32x32x16_bf16(vf[3], pf1, oA1, 0, 0, 0);
    bf16x8 pg0, pg1; softmax_pack(pB, lB, pg0, pg1);
    oB0 = __builtin_amdgcn_mfma_f32_32x32x16_bf16(vf[0], pg0, oB0, 0, 0, 0);
    oB0 = __builtin_amdgcn_mfma_f32_32x32x16_bf16(vf[1], pg1, oB0, 0, 0, 0);
    oB1 = __builtin_amdgcn_mfma_f32_32x32x16_bf16(vf[2], pg0, oB1, 0, 0, 0);
    oB1 = __builtin_amdgcn_mfma_f32_32x32x16_bf16(vf[3], pg1, oB1, 0, 0, 0);
}
template <bool CM>
__device__ __forceinline__ void seg_run(const Seg& s, const St& st, const Lay& L, const bf16* nkt, const bf16* nvt, const float (&cm)[16], LAS char* stage,
                                        f32x16& oA0, f32x16& oA1, float& lA, f32x16& oB0, f32x16& oB1, float& lB) {
    oA0 = f32x16{}; oA1 = f32x16{}; lA = 0.f; oB0 = f32x16{}; oB1 = f32x16{}; lB = 0.f;
    const int nt = s.nt, ntl = nt - 1;
    const int aHi = min(s.aHi, ntl), bLo = s.bLo, bHi = min(s.bHi, ntl);
#pragma unroll 1
    for (int t = 0; t < nt; ++t) {
        asm volatile("s_waitcnt vmcnt(0)" ::: "memory");
        bf16x8 kf[4], vf[4];
#pragma unroll
        for (int d0 = 0; d0 < 4; ++d0) kf[d0] = *(const LAS bf16x8*)(stage + L.rdK[d0]);
#pragma unroll
        for (int i_ = 0; i_ < 4; ++i_) { const s16x4 lo_ = vtr(stage + L.vrd + i_ * 1024), hh_ = vtr(stage + L.vrd + i_ * 1024 + 512); vf[i_] = (bf16x8){lo_[0], lo_[1], lo_[2], lo_[3], hh_[0], hh_[1], hh_[2], hh_[3]}; }
        asm volatile("s_waitcnt lgkmcnt(0)" ::: "memory");
        if (t < ntl) dma_tile(s.kt + (size_t)(t + 1) * s.tstride, s.vt + (size_t)(t + 1) * s.tstride, stage, L);
        else if (nkt) dma_tile(nkt, nvt, stage, L);
        const bool a_ = (t <= aHi), b_ = (t >= bLo && t <= bHi);
        if (a_ && b_) tile_step2<CM>(t, kf, vf, st, s, cm, oA0, oA1, lA, oB0, oB1, lB);
        else if (a_) tile_step<CM>(t, kf, vf, st.qA, s.tbA, s.tneg, s.raLo, cm, oA0, oA1, lA);
        else if (b_) tile_step<CM>(t, kf, vf, st.qB, s.tbB, s.tneg, s.rbLo, cm, oB0, oB1, lB);
    }
}
__device__ __forceinline__ void acc_block(const bool FIRST, const f32x16& o0, const f32x16& o1, float lsum, LAS char* lds, int tloc, int lane) {
    const int hi = lane >> 5;
    LAS char* row = lds + ACC_OFF + rho(tloc) * ACC_PITCH + 8 * hi;
#pragma unroll
    for (int dh = 0; dh < 2; ++dh)
#pragma unroll
        for (int c4 = 0; c4 < 4; ++c4) {
            float v0 = dh ? o1[4 * c4] : o0[4 * c4], v1 = dh ? o1[4 * c4 + 1] : o0[4 * c4 + 1], v2 = dh ? o1[4 * c4 + 2] : o0[4 * c4 + 2], v3 = dh ? o1[4 * c4 + 3] : o0[4 * c4 + 3];
            LAS v2u* a = (LAS v2u*)(row + 64 * dh + 16 * c4);
            if (!FIRST) { const v2u old = *a; v0 += __builtin_bit_cast(float, old.x << 16); v1 += __builtin_bit_cast(float, old.x & 0xffff0000u); v2 += __builtin_bit_cast(float, old.y << 16); v3 += __builtin_bit_cast(float, old.y & 0xffff0000u); }
            v2u w; w.x = cvtpk(v0, v1); w.y = cvtpk(v2, v3); *a = w;
        }
    float l = sum_x32(lsum);
    if (hi == 0) { LAS float* la = (LAS float*)(lds + LACC_OFF) + tloc; if (!FIRST) l += *la; *la = l; }
}
__device__ __forceinline__ void gate_load(v4u (&gw)[8], const bf16* grow, int tid) {
#pragma unroll
    for (int it = 0; it < 8; ++it) gw[it] = *(const v4u*)(grow + (size_t)((tid >> 3) + 64 * it) * 1024 + 8 * (tid & 7));
}
__device__ __forceinline__ void final_store(const v4u (&gw)[8], LAS char* lds, bf16* yrow, int tid) {
#pragma unroll
    for (int it = 0; it < 8; ++it) {
        const int tloc = (tid >> 3) + 64 * it, c = tid & 7;
        const LAS char* row = lds + ACC_OFF + rho(tloc) * ACC_PITCH + 16 * c;
        const v2u a0 = *(const LAS v2u*)row, a1 = *(const LAS v2u*)(row + 8);
        const float inv = __builtin_amdgcn_rcpf(*((const LAS float*)(lds + LACC_OFF) + tloc));
        const v4u g = gw[it];
        v4u w;
        w.x = cvtpk(__builtin_bit_cast(float, a0.x << 16) * inv * __builtin_bit_cast(float, g.x << 16), __builtin_bit_cast(float, a0.x & 0xffff0000u) * inv * __builtin_bit_cast(float, g.x & 0xffff0000u));
        w.y = cvtpk(__builtin_bit_cast(float, a0.y << 16) * inv * __builtin_bit_cast(float, g.y << 16), __builtin_bit_cast(float, a0.y & 0xffff0000u) * inv * __builtin_bit_cast(float, g.y & 0xffff0000u));
        w.z = cvtpk(__builtin_bit_cast(float, a1.x << 16) * inv * __builtin_bit_cast(float, g.z << 16), __builtin_bit_cast(float, a1.x & 0xffff0000u) * inv * __builtin_bit_cast(float, g.z & 0xffff0000u));
        w.w = cvtpk(__builtin_bit_cast(float, a1.y << 16) * inv * __builtin_bit_cast(float, g.w << 16), __builtin_bit_cast(float, a1.y & 0xffff0000u) * inv * __builtin_bit_cast(float, g.w & 0xffff0000u));
        *(v4u*)(yrow + (size_t)tloc * 1024 + 8 * c) = w;
    }
}
__device__ __forceinline__ float wg_absmax(const float* p, int n, LAS float* scr, int tid) {
    float m = 0.f;
    for (int i = tid; i < n; i += NWAVES * 64) m = fmaxf(m, fabsf(p[i]));
    m = wave_max(m);
    __syncthreads();
    if ((tid & 63) == 0) scr[tid >> 6] = m;
    __syncthreads();
    float r = scr[0];
#pragma unroll
    for (int i = 1; i < NWAVES; ++i) r = fmaxf(r, scr[i]);
    return r;
}

__device__ __forceinline__ void seg_a(Seg& sg, int u, int si, int tblbuf, const bf16* qkv, LAS char* lds, int lane, int wave) {
    const int s = u & 7, h = (u >> 3) & 15, bl = u >> 7;
    const int g = (si < 2) ? 2 : 3 - si, bb = (si < 2) ? si : 0;
    const bool dual = (g < 2);
    const int sh = 2 * g, L = SEQ >> sh;
    const int bi = 2 * wave + bb, res = bi >> (4 - sh), i = bi & ((16 >> sh) - 1);
    const int pos0 = ((512 * s) >> sh) + 32 * i;
    const int T0 = max(0, 2 - (pos0 >> 5)), T1 = min(dual ? 5 : 4, 2 + ((L - 32 - pos0) >> 5));
    const int q = lane & 31, hi = lane >> 5;
    const bf16* Qg = qkv + (size_t)(3 * g) * SECA + ((size_t)(bl * 16 + h) * 4096) * 64;
    sg.qA = Qg + (size_t)(res * L + pos0 + q) * 64; sg.qB = dual ? sg.qA + 32 * 64 : sg.qA;
    const size_t krow0 = (size_t)(res * L + pos0 + 32 * (T0 - 2)) * 64;
    sg.kt = Qg + SECA + krow0; sg.vt = Qg + 2 * SECA + krow0;
    sg.tbA = lds + TBL_OFF + tblbuf * TBL_BYTES + 4 * (g * 192 + 32 * T0 + 31 + 4 * hi - q); sg.tbB = sg.tbA - 128; sg.tneg = sg.tbA;
    sg.tstride = 2048; sg.nt = T1 - T0 + 1; sg.aHi = 4 - T0; sg.bLo = dual ? 1 - T0 : 1; sg.bHi = dual ? T1 - T0 : 0;
    sg.raLo = 0; sg.rbLo = 0;
    sg.tlocA = ((32 * i + q) << sh) + res; sg.tlocB = ((32 * i + 32 + q) << sh) + res;
    sg.first = (g == 2) ? 1 : 0; sg.dual = dual ? 1 : 0;
}
__device__ __forceinline__ void tbl_a(int u, int tblbuf, const float* t5, float cshift, LAS char* lds, int tid) {
    const int h = (u >> 3) & 15;
    for (int idx = tid; idx < 3 * 192; idx += NWAVES * 64) {
        const int g = idx / 192, rel = idx % 192 - 95; const int ar = rel < 0 ? -rel : rel;
        float v = NEG; if (ar <= 64) v = LOG2E * t5[(g * 16 + h) * 32 + t5_bucket_dev(rel << (2 * g))] - cshift;
        ((LAS float*)(lds + TBL_OFF + tblbuf * TBL_BYTES))[idx] = v;
    }
}
__device__ __forceinline__ void attn_a_phase(Frame& F, const bf16* qkv, const bf16* gate, bf16* y, const float* t5, const float* qg, const float* kg) {
    LAS char* lds = (LAS char*)F.lds;
    LAS float* scr = (LAS float*)(lds + SCR_OFF);
    int tid_ = F.wave * 64 + lane_id(); asm volatile("" : "+v"(tid_));
    const int tid = tid_, lane = tid & 63, wave = __builtin_amdgcn_readfirstlane(tid >> 6);
    const float cshift = 64.0f * QSCALE * wg_absmax(qg, 192, scr, tid) * wg_absmax(kg, 192, scr, tid) + LOG2E * wg_absmax(t5, 48 * 32, scr, tid);
    const int NU = 4 * NH * 8, per = (NU + F.G - 1) / F.G, u0 = F.vcu * per, nu = min(per, NU - u0);
    if (nu <= 0) return;
    const float zero16[16] = {0.f, 0.f, 0.f, 0.f, 0.f, 0.f, 0.f, 0.f, 0.f, 0.f, 0.f, 0.f, 0.f, 0.f, 0.f, 0.f};
    LAS char* stage = lds + VST_OFF + wave * STAGE_BYTES;
    Lay L; lay_init(L, lane);
    tbl_a(u0, 0, t5, cshift, lds, tid);
    __syncthreads();
    Seg cur; St st;
    seg_a(cur, u0, 0, 0, qkv, lds, lane, wave); seg_start(cur, st, lane); dma_tile(cur.kt, cur.vt, stage, L);
#pragma unroll 1
    for (int ui = 0; ui < nu; ++ui) {
        const int u = u0 + ui;
#pragma unroll 1
        for (int si = 0; si < 4; ++si) {
            Seg nxt = cur;
            const bool more = (si < 3) || (ui + 1 < nu);
            if (more) { if (si < 3) seg_a(nxt, u, si + 1, ui & 1, qkv, lds, lane, wave); else seg_a(nxt, u + 1, 0, (ui + 1) & 1, qkv, lds, lane, wave); }
            f32x16 oA0, oA1, oB0, oB1; float lA, lB;
            seg_run<false>(cur, st, L, more ? nxt.kt : nullptr, nxt.vt, zero16, stage, oA0, oA1, lA, oB0, oB1, lB);
            if (more) seg_start(nxt, st, lane);
            if ((si == 0 && ui > 0) || si >= 2) __syncthreads();
            acc_block(cur.first != 0, oA0, oA1, lA, lds, cur.tlocA, lane);
            if (cur.dual) acc_block(false, oB0, oB1, lB, lds, cur.tlocB, lane);
            cur = nxt;
        }
        if (ui + 1 < nu) tbl_a(u + 1, (ui + 1) & 1, t5, cshift, lds, tid);
        const int s = u & 7, h = (u >> 3) & 15, bl = u >> 7;
        const size_t tok0 = (size_t)bl * 4096 + 512 * s;
        int tidf = tid; asm volatile("" : "+v"(tidf));
        v4u gw[8]; gate_load(gw, gate + tok0 * 1024 + h * 64, tidf);
        __syncthreads();
        final_store(gw, lds, y + tok0 * 1024 + h * 64, tidf);
    }
    asm volatile("s_waitcnt vmcnt(0)" ::: "memory");
}
__device__ __forceinline__ void seg_b(Seg& sg, int u, int tblbuf, const bf16* qkv, LAS char* lds, int lane, int wave) {
    const int R = u & 7, h = (u >> 3) & 15, b = u >> 7;
    const bf16* Qb = qkv + ((size_t)(b * 16 + h) * 4096) * 64;
    const int cb = wave & 3, gr0 = 8 * R + 4 * (wave >> 2);
    const int q = lane & 31, hi = lane >> 5;
    const int gcq = 16 * cb + (q & 15);
    const int grA = gr0 + (q >> 4), grB = grA + 2;
    sg.tlocA = (4 * (wave >> 2) + (q >> 4)) * 64 + gcq; sg.tlocB = sg.tlocA + 128;
    const int kr0 = min(max(gr0 - 4, 0), 56), krl = min(max(gr0 + 3 - 4, 0), 56) + 7;
    sg.nt = krl - kr0 + 1; sg.aHi = min(max(gr0 + 1 - 4, 0), 56) + 7 - kr0; sg.bLo = min(max(gr0 + 2 - 4, 0), 56) - kr0; sg.bHi = sg.nt - 1;
    const int slab0 = min(max(16 * cb - 8, 0), 32);
    sg.raLo = min(max(grA - 4, 0), 56) - kr0; sg.rbLo = min(max(grB - 4, 0), 56) - kr0;
    sg.tbA = lds + TBL_OFF + tblbuf * TBL_BYTES + 4 * (16 + (kr0 - grA + 7) * 32 + (slab0 + 4 * hi - gcq + 15)); sg.tbB = sg.tbA - 2 * 128;
    sg.tneg = lds + TBL_OFF + tblbuf * TBL_BYTES + 4 * 576;
    const size_t krow0 = (size_t)(kr0 * 64 + slab0) * 64;
    sg.qA = Qb + (size_t)(512 * R + sg.tlocA) * 64; sg.qB = sg.qA + 128 * 64;
    sg.kt = Qb + SECB + krow0; sg.vt = Qb + 2 * SECB + krow0;
    sg.tstride = 4096; sg.first = 1; sg.dual = 1;
}
__device__ __forceinline__ void tbl_b(int u, int tblbuf, const float* rpb, float cshift, LAS char* lds, int tid) {
    const int h = (u >> 3) & 15;
    for (int idx = tid; idx < 640; idx += NWAVES * 64) {
        float v = NEG; const int e = idx - 16;
        if (e >= 0 && e < 480 && (e & 31) < 31) v = LOG2E * rpb[(h * 15 + (e >> 5)) * 31 + (e & 31)] - cshift;
        ((LAS float*)(lds + TBL_OFF + tblbuf * TBL_BYTES))[idx] = v;
    }
}
__device__ __forceinline__ void attn_b_phase(Frame& F, const bf16* qkv, const bf16* gate, bf16* y, const float* rpb, const float* qg, const float* kg) {
    LAS char* lds = (LAS char*)F.lds;
    LAS float* scr = (LAS float*)(lds + SCR_OFF);
    int tid_ = F.wave * 64 + lane_id(); asm volatile("" : "+v"(tid_));
    const int tid = tid_, lane = tid & 63, wave = __builtin_amdgcn_readfirstlane(tid >> 6);
    const float cshift = 64.0f * QSCALE * wg_absmax(qg, 64, scr, tid) * wg_absmax(kg, 64, scr, tid) + LOG2E * wg_absmax(rpb, NH * 15 * 31, scr, tid);
    const int NU = BATCH * NH * 8, per = (NU + F.G - 1) / F.G, u0 = F.vcu * per, nu = min(per, NU - u0);
    if (nu <= 0) return;
    float cm[16];
    { const int cb = wave & 3, q = lane & 31, hi = lane >> 5, gcq = 16 * cb + (q & 15), slab0 = min(max(16 * cb - 8, 0), 32), csq = min(max(gcq - 8, 0), 48);
#pragma unroll
      for (int r = 0; r < 16; ++r) { const int kc = slab0 + (r & 3) + 8 * (r >> 2) + 4 * hi; cm[r] = ((unsigned)(kc - csq) < 16u) ? 0.f : NEG; } }
    LAS char* stage = lds + VST_OFF + wave * STAGE_BYTES;
    Lay L; lay_init(L, lane);
    tbl_b(u0, 0, rpb, cshift, lds, tid);
    __syncthreads();
    Seg cur; St st;
    seg_b(cur, u0, 0, qkv, lds, lane, wave); seg_start(cur, st, lane); dma_tile(cur.kt, cur.vt, stage, L);
#pragma unroll 1
    for (int ui = 0; ui < nu; ++ui) {
        const int u = u0 + ui;
        Seg nxt = cur;
        const bool more = (ui + 1 < nu);
        if (more) seg_b(nxt, u + 1, (ui + 1) & 1, qkv, lds, lane, wave);
        f32x16 oA0, oA1, oB0, oB1; float lA, lB;
        seg_run<true>(cur, st, L, more ? nxt.kt : nullptr, nxt.vt, cm, stage, oA0, oA1, lA, oB0, oB1, lB);
        if (more) seg_start(nxt, st, lane);
        if (ui > 0) __syncthreads();
        acc_block(true, oA0, oA1, lA, lds, cur.tlocA, lane);
        acc_block(true, oB0, oB1, lB, lds, cur.tlocB, lane);
        cur = nxt;
        if (more) tbl_b(u + 1, (ui + 1) & 1, rpb, cshift, lds, tid);
        const int R = u & 7, h = (u >> 3) & 15, b = u >> 7;
        const size_t tok0 = (size_t)b * 4096 + 512 * R;
        int tidf = tid; asm volatile("" : "+v"(tidf));
        v4u gw[8]; gate_load(gw, gate + tok0 * 1024 + h * 64, tidf);
        __syncthreads();
        final_store(gw, lds, y + tok0 * 1024 + h * 64, tidf);
    }
    asm volatile("s_waitcnt vmcnt(0)" ::: "memory");
}
}
struct Args { const float* in[12]; float* out; unsigned char* ws; int ph_lo, ph_hi; };
__global__ void __launch_bounds__(NWAVES * 64, 2) fwd_kernel(Args args) {
    extern __shared__ __attribute__((aligned(16))) unsigned char lds[];
    Frame F;
    F.lds = (LAS unsigned char*)lds;
    F.MISC = (volatile LAS unsigned*)(F.lds + MISC_OFF);
    F.wave = __builtin_amdgcn_readfirstlane(threadIdx.x >> 6); F.lane = lane_id(); F.tid = F.wave * 64 + F.lane;
    F.G = gridDim.x; { const int bx = blockIdx.x; F.vcu = (F.G % 8 == 0) ? (bx % 8) * (F.G / 8) + bx / 8 : bx; }
    unsigned char* ws = args.ws;
    F.ctl = (gu32*)(ws + WS_CTL);
    for (int u = F.tid; u < (LDS_BYTES - LDSCTL_OFF) / 4; u += NWAVES * 64) ((LAS unsigned*)(F.lds + LDSCTL_OFF))[u] = 0u;
    __syncthreads();
    XcdBarrier bar = xcd_barrier_post((unsigned*)(F.ctl + CW_BAR), F.MISC + 8, F.wave);
    const int lo = args.ph_lo, hi = args.ph_hi;
#ifndef PROBE_REP
#define PROBE_REP (-1)
#endif
#define NREP(k) (((k) == PROBE_REP) ? 2 : 1)
#define IN(k) (lo <= (k) && (k) < hi)
#define BOTH(k) (IN(k) && IN((k) + 1))
    const float* x = args.in[0]; const float* norm_gain = args.in[1];
    bf16* XB = (bf16*)(ws + WS_XB);
    float* rstd1 = (float*)(ws + WS_RSTD1); float* part2 = (float*)(ws + WS_PART2);

_Pragma("unroll 1") for (int rep_ = 0; rep_ < NREP(0); ++rep_) {
    if (IN(0)) {
        int tid0_ = F.wave * 64 + lane_id(); asm volatile("" : "+v"(tid0_)); F.tid = tid0_; F.lane = tid0_ & 63;
        LAS float* scr = (LAS float*)(F.lds + RING_OFF + F.wave * 16384);
        const int gw = F.vcu * NWAVES + F.wave, NGW = F.G * NWAVES;
        constexpr int I_AIN = (DM / 64) * (NA_IN / 32), I_O = (DM / 64) * (DM / 32), I_BIN = (DM / 64) * (NB_IN / 32);
        constexpr int NITEMS = I_AIN + I_O + I_BIN + I_O;
        for (int it = gw; it < NITEMS; it += NGW) {
            int r = it;
            if (r < I_AIN) { p0_transpose_item(args.in[2], DM, NA_IN, (bf16*)(ws + WS_WAIN), norm_gain, scr, r, F.lane); continue; } r -= I_AIN;
            if (r < I_O) { p0_transpose_item(args.in[3], DM, DM, (bf16*)(ws + WS_WAOUT), nullptr, scr, r, F.lane); continue; } r -= I_O;
            if (r < I_BIN) { p0_transpose_item(args.in[7], DM, NB_IN, (bf16*)(ws + WS_WBIN), norm_gain + DM, scr, r, F.lane); continue; } r -= I_BIN;
            p0_transpose_item(args.in[8], DM, DM, (bf16*)(ws + WS_WBOUT), nullptr, scr, r, F.lane);
        }
        for (int m = gw; m < MTOK; m += NGW) {
            const GAS f32x4* xr = (const GAS f32x4*)(x + (size_t)m * DM) + F.lane;
            f32x4 v[4]; float s = 0.f;
#pragma unroll
            for (int j = 0; j < 4; ++j) { v[j] = xr[64 * j]; s += (v[j].x * v[j].x + v[j].y * v[j].y) + (v[j].z * v[j].z + v[j].w * v[j].w); }
            s = wave_sum(s);
            if (F.lane == 0) rstd1[m] = __builtin_amdgcn_rsqf(s * (1.0f / DM) + pg8::RMS_EPS);
            GAS v2u* o8 = (GAS v2u*)(XB + (size_t)m * DM) + F.lane;
#pragma unroll
            for (int j = 0; j < 4; ++j) { v2u w; w.x = pk2(v[j].x, v[j].y); w.y = pk2(v[j].z, v[j].w); o8[64 * j] = w; }
        }
        if (BOTH(0)) xcd_barrier(bar);
    }
}

    for (int hf = 0; hf < 2; ++hf) {
_Pragma("unroll 1") for (int rep_ = 0; rep_ < NREP(1 + 2 * hf); ++rep_) {
        if (IN(1 + 2 * hf)) {
            pg8::Gemm g{XB + (size_t)hf * MHALF * DM, (const bf16*)(ws + WS_WAIN), MHALF, NA_IN, DM};
            pg8::StaticOrder S; S.init(MHALF, NA_IN, F.G, (int)blockIdx.x);
            pg8::EpiIn<0> E{(bf16*)(ws + WS_QKVA), SECA, (bf16*)(ws + WS_GATEA), rstd1, args.in[4], args.in[5], hf * MHALF, QSCALE};
            pg8::gemm_phase<pg8::EpiIn<0>, pg8::StaticOrder, true>(F.lds + RING_OFF, g, S, E, F.wave);
            if (BOTH(1 + 2 * hf)) xcd_barrier(bar);
        }
}

_Pragma("unroll 1") for (int rep_ = 0; rep_ < NREP(2 + 2 * hf); ++rep_) {
        if (IN(2 + 2 * hf)) {
            att::attn_a_phase(F, (const bf16*)(ws + WS_QKVA), (const bf16*)(ws + WS_GATEA), XB + (size_t)hf * MHALF * DM, args.in[6], args.in[4], args.in[5]);
            if (BOTH(2 + 2 * hf)) xcd_barrier(bar);
        }
}

    }
_Pragma("unroll 1") for (int rep_ = 0; rep_ < NREP(5); ++rep_) {
    if (IN(5)) {
        pg8::Gemm g{XB, (const bf16*)(ws + WS_WAOUT), MTOK, DM, DM};
        pg8::StaticOrder S; S.init(MTOK, DM, F.G, (int)blockIdx.x);
        pg8::EpiOut E{x, args.out, (bf16*)(ws + WS_X1B), part2};
        pg8::gemm_phase<pg8::EpiOut, pg8::StaticOrder, true>(F.lds + RING_OFF, g, S, E, F.wave);
        if (BOTH(5)) xcd_barrier(bar);
    }
}

_Pragma("unroll 1") for (int rep_ = 0; rep_ < NREP(6); ++rep_) {
    if (IN(6)) {
        pg8::Gemm g{(const bf16*)(ws + WS_X1B), (const bf16*)(ws + WS_WBIN), MTOK, NB_IN, DM};
        pg8::StaticOrder S; S.init(MTOK, NB_IN, F.G, (int)blockIdx.x);
        pg8::EpiIn<1> E{(bf16*)(ws + WS_QKVB), SECB, (bf16*)(ws + WS_GATEB), part2, args.in[9], args.in[10], 0, QSCALE};
        pg8::gemm_phase<pg8::EpiIn<1>, pg8::StaticOrder, true>(F.lds + RING_OFF, g, S, E, F.wave);
        if (BOTH(6)) xcd_barrier(bar);
    }
}

_Pragma("unroll 1") for (int rep_ = 0; rep_ < NREP(7); ++rep_) {
    if (IN(7)) {
        att::attn_b_phase(F, (const bf16*)(ws + WS_QKVB), (const bf16*)(ws + WS_GATEB), XB, args.in[11], args.in[9], args.in[10]);
        if (BOTH(7)) xcd_barrier(bar);
    }
}

    if (IN(8)) {
        pg8::Gemm g{XB, (const bf16*)(ws + WS_WBOUT), MTOK, DM, DM};
        pg8::StaticOrder S; S.init(MTOK, DM, F.G, (int)blockIdx.x);
        pg8::EpiOut E{args.out, args.out, nullptr, nullptr};
        pg8::gemm_phase<pg8::EpiOut, pg8::StaticOrder, true>(F.lds + RING_OFF, g, S, E, F.wave);
    }
#undef IN
#undef BOTH
}

extern "C" void kernel_launch(void* const* d_in, const int* in_sizes, int n_in, void* d_out, int out_size, void* d_ws, size_t ws_size, hipStream_t stream) {
    static int grid = 0;
    if (grid == 0) {
        if (n_in != 12 || in_sizes[0] != MTOK * DM || out_size != MTOK * DM || ws_size < WS_END) { fprintf(stderr, "kernel_launch: unexpected shapes / workspace (%d inputs, ws %zu)\n", n_in, ws_size); grid = -1; return; }
        int dev = 0, cus = 0, per_cu = 0;
        if (hipGetDevice(&dev) != hipSuccess || hipDeviceGetAttribute(&cus, hipDeviceAttributeMultiprocessorCount, dev) != hipSuccess) { grid = -1; return; }
        if (hipFuncSetAttribute((const void*)fwd_kernel, hipFuncAttributeMaxDynamicSharedMemorySize, LDS_BYTES) != hipSuccess) { fprintf(stderr, "kernel_launch: hipFuncSetAttribute failed\n"); grid = -1; return; }
        if (hipOccupancyMaxActiveBlocksPerMultiprocessor(&per_cu, (const void*)fwd_kernel, NWAVES * 64, LDS_BYTES) != hipSuccess || per_cu < 1) { fprintf(stderr, "kernel_launch: occupancy query says %d blocks per CU\n", per_cu); per_cu = 1; }
        (void)hipGetLastError();
        grid = cus;
    }
    if (grid < 0) return;
    (void)hipMemsetAsync((char*)d_ws + WS_CTL, 0, CTL_ZERO_BYTES, stream);
    Args a{};
    for (int i = 0; i < 12; ++i) a.in[i] = (const float*)d_in[i];
    a.out = (float*)d_out; a.ws = (unsigned char*)d_ws;
    a.ph_lo = 0; a.ph_hi = 9;
    void* kargs[] = {&a};
    hipError_t e = hipLaunchCooperativeKernel((const void*)fwd_kernel, dim3(grid), dim3(NWAVES * 64), kargs, LDS_BYTES, stream);
    if (e != hipSuccess) fprintf(stderr, "kernel_launch: cooperative launch failed: %s (grid %d)\n", hipGetErrorString(e), grid);
}
```

```cpp
#define NCH_A 4
#define NCH_B 1
#include <hip/hip_runtime.h>
#include <cstdio>
#include <cstdint>
template <int CTRL> __device__ __forceinline__ float dpp_mov(float v) { return __int_as_float(__builtin_amdgcn_update_dpp(0, __float_as_int(v), CTRL, 0xF, 0xF, true)); }
__device__ __forceinline__ void swap16(float v, float& a, float& b) { auto r = __builtin_amdgcn_permlane16_swap(__float_as_uint(v), __float_as_uint(v), false, false); const unsigned r0 = r[0], r1 = r[1]; a = __uint_as_float(r0); b = __uint_as_float(r1); }
__device__ __forceinline__ void swap32(float v, float& a, float& b) { auto r = __builtin_amdgcn_permlane32_swap(__float_as_uint(v), __float_as_uint(v), false, false); const unsigned r0 = r[0], r1 = r[1]; a = __uint_as_float(r0); b = __uint_as_float(r1); }
__device__ __forceinline__ float sum_x16(float v) { float a, b; swap16(v, a, b); return a + b; }
__device__ __forceinline__ float sum_x32(float v) { float a, b; swap32(v, a, b); return a + b; }
__device__ __forceinline__ float max_x16(float v) { float a, b; swap16(v, a, b); return fmaxf(a, b); }
__device__ __forceinline__ float max_x32(float v) { float a, b; swap32(v, a, b); return fmaxf(a, b); }
__device__ __forceinline__ float wave_sum(float v) { v += dpp_mov<0xB1>(v); v += dpp_mov<0x4E>(v); v += dpp_mov<0x141>(v); v += dpp_mov<0x140>(v); v = sum_x16(v); return sum_x32(v); }
__device__ __forceinline__ float wave_max(float v) { v = fmaxf(v, dpp_mov<0xB1>(v)); v = fmaxf(v, dpp_mov<0x4E>(v)); v = fmaxf(v, dpp_mov<0x141>(v)); v = fmaxf(v, dpp_mov<0x140>(v)); v = max_x16(v); return max_x32(v); }
namespace pg8 {
#define PG8_LAS __attribute__((address_space(3)))
typedef unsigned short bf16_t;
typedef short bf16x8 __attribute__((ext_vector_type(8)));
typedef float f32x4 __attribute__((ext_vector_type(4)));
typedef unsigned u32x4 __attribute__((ext_vector_type(4)));
typedef unsigned u32x2 __attribute__((ext_vector_type(2)));
constexpr int BM = 256, BK = 64, HALF = 128, HTB = HALF * BK * 2  , STAGE_BYTES = 8 * HTB, NXCD = 8, WGM = 8;

__host__ __device__ __forceinline__ int lds_byte(int r, int c) { const int st = (r >> 4) * 2 + (c >> 5), rr = r & 15, cc = c & 31, ob = rr * 64 + cc * 2; return st * 1024 + (ob ^ (((ob >> 9) & 1) << 5)); }
__host__ __device__ __forceinline__ void stage_rc(int b, int& R, int& C) { const int st = b / 1024, sb = b % 1024, swz = sb ^ (((sb >> 9) & 1) << 5); R = (st >> 1) * 16 + swz / 64; C = (st & 1) * 32 + (swz % 64) / 2; }
__host__ __device__ __forceinline__ int perm32(int rho) { const int n = rho >> 4, i = rho & 15; return 8 * (i >> 2) + 4 * n + (i & 3); }

struct Unit { int pm, pn; };
struct Gemm { const bf16_t* A; const bf16_t* Bt; int M, N, K; };

struct StaticOrder {
    int nM, nN, nwg, G, c;
    __host__ __device__ void init(int M, int N, int G_, int c_) { nM = M / BM; nN = N / BM; nwg = nM * nN; G = G_; c = c_; }
    __host__ __device__ bool next(int i, Unit& u) const {
        const long L = (long)i * G + c; if (L >= nwg) return false;
        int wgid = (int)L; { const int q = nwg / NXCD, r = nwg % NXCD, xcd = wgid % NXCD, off = wgid / NXCD; wgid = (xcd < r ? xcd * (q + 1) : r * (q + 1) + (xcd - r) * q) + off; }
        const int nig = WGM * nN, gid = wgid / nig, fm = gid * WGM, gsz = (nM - fm) < WGM ? (nM - fm) : WGM;
        u.pm = fm + ((wgid % nig) % gsz); u.pn = (wgid % nig) / gsz; return true;
    }
};

#ifndef WT_STORES
#define WT_STORES 0
#endif
__device__ __forceinline__ void st16_wt(void* p, u32x4 v) { if (WT_STORES) asm volatile("global_store_dwordx4 %0, %1, off sc1\n\ts_nop 1" :: "v"(p), "v"(v) : "memory"); else *(u32x4*)p = v; }
__device__ __forceinline__ void st8_wt(void* p, u32x2 v) { if (WT_STORES) asm volatile("global_store_dwordx2 %0, %1, off sc1\n\ts_nop 1" :: "v"(p), "v"(v) : "memory"); else *(u32x2*)p = v; }
typedef _Float16 f16x2_t __attribute__((ext_vector_type(2)));
typedef _Float16 f16x8_t __attribute__((ext_vector_type(8)));
typedef float f32x2_t __attribute__((ext_vector_type(2)));
__device__ __forceinline__ unsigned cvt_pk_f16(float lo, float hi) { const f32x2_t v = {lo, hi}; const f16x2_t h = __builtin_convertvector(v, f16x2_t); return __builtin_bit_cast(unsigned, h); }
__device__ __forceinline__ f32x4 f16x4_to_f32(u32x2 w) { const unsigned w0 = w.x, w1 = w.y;
    const f16x2_t a = __builtin_bit_cast(f16x2_t, w0), b = __builtin_bit_cast(f16x2_t, w1); return (f32x4){(float)a[0], (float)a[1], (float)b[0], (float)b[1]}; }
__device__ __forceinline__ unsigned cvt_pk_bf16(float lo, float hi) { unsigned r; asm volatile("v_cvt_pk_bf16_f32 %0, %1, %2" : "=v"(r) : "v"(lo), "v"(hi)); return r; }


constexpr float RMS_EPS = 1e-6f;
struct NoSide { };
template <int MODE> struct EpiIn {
    static constexpr bool HEADMAP = true;
    static constexpr bool F16 = (MODE == 1);
    const float* xs; bf16_t* xd; int xrows, upc;
    struct Side { f32x4 v[4]; int row; };
    __device__ __forceinline__ void side_issue(Side& s, int ui, int c, int wid, int lane) const {
        s.row = (c * upc + ui) * 8 + wid;
        if (MODE == 0 && s.row < xrows) { const f32x4* xr = (const f32x4*)(xs + (size_t)s.row * 1024) + lane;
#pragma unroll
            for (int j = 0; j < 4; ++j) s.v[j] = __builtin_nontemporal_load(xr + 64 * j); }
    }
    __device__ __forceinline__ void side_finish(const Side& s, int lane) const {
        if (MODE == 0 && s.row < xrows) {
            float q = 0.f;
#pragma unroll
            for (int j = 0; j < 4; ++j) q += (s.v[j][0] * s.v[j][0] + s.v[j][1] * s.v[j][1]) + (s.v[j][2] * s.v[j][2] + s.v[j][3] * s.v[j][3]);
            const float rstd = __builtin_amdgcn_rsqf(wave_sum(q) * (1.0f / 1024.0f) + 1e-6f);
            const bool odd = lane & 1;
            bf16_t* orow = xd + (size_t)s.row * 1024 + 4 * (lane & ~1);
#pragma unroll
            for (int jp = 0; jp < 2; ++jp) {
                const int ja = 2 * jp, jb = 2 * jp + 1;
                const unsigned pax = cvt_pk_bf16(s.v[ja][0] * rstd, s.v[ja][1] * rstd), pay = cvt_pk_bf16(s.v[ja][2] * rstd, s.v[ja][3] * rstd);
                const unsigned pbx = cvt_pk_bf16(s.v[jb][0] * rstd, s.v[jb][1] * rstd), pby = cvt_pk_bf16(s.v[jb][2] * rstd, s.v[jb][3] * rstd);
                const unsigned rx = (unsigned)__builtin_amdgcn_update_dpp(0, (int)(odd ? pax : pbx), 0xB1, 0xF, 0xF, true), ry = (unsigned)__builtin_amdgcn_update_dpp(0, (int)(odd ? pay : pby), 0xB1, 0xF, 0xF, true);
                u32x4 w; w.x = odd ? rx : pax; w.y = odd ? ry : pay; w.z = odd ? pbx : rx; w.w = odd ? pby : ry;
                *(u32x4*)(orow + (odd ? 256 * jb : 256 * ja)) = w;
            }
        }
    }
    bf16_t* qkv; size_t sec_stride; bf16_t* gate; const float* rs; const float* qg; const float* kg; int row_base; float qscale;
    __device__ __forceinline__ void operator()(const f32x4 (&acc)[2][2][4][2], const Unit& u, int wr, int wc, int fr, int fq) const {
        const int sec = u.pn >> 2, hq = u.pn & 3, h = hq * 4 + wc;
        int type, g = 0;
        if (MODE == 0) { if (sec == 9) type = 3; else { g = sec / 3; type = sec - 3 * g; } } else type = sec;
        const int shift = (MODE == 0) ? 2 * g : 0;
        f32x4 gv[2][2];
#pragma unroll
        for (int bj = 0; bj < 2; ++bj)
#pragma unroll
            for (int n = 0; n < 2; ++n) gv[bj][n] = (f32x4){1.f, 1.f, 1.f, 1.f};
        if (type < 2) {
            const float* gp = (type == 0 ? qg : kg) + (MODE == 0 ? g * 64 : 0) + 8 * fq;
            const float sc = (type == 0) ? qscale : 1.f;
#pragma unroll
            for (int bj = 0; bj < 2; ++bj)
#pragma unroll
                for (int n = 0; n < 2; ++n) gv[bj][n] = *(const f32x4*)(gp + 32 * bj + 4 * n) * sc;
        }
        bf16_t* p0; size_t step16;
        { const int r0 = u.pm * BM + wr * 64 + fr;
          if (type < 3) { const int t = r0 & 4095, bl = r0 >> 12; const int pos = ((t & ((1 << shift) - 1)) << (12 - shift)) | (t >> shift);
              p0 = qkv + (size_t)sec * sec_stride + ((size_t)(bl * 16 + h) * 4096 + pos) * 64 + 8 * fq; step16 = (size_t)(16 >> shift) * 64; }
          else { p0 = gate + (size_t)r0 * 1024 + hq * 256 + wc * 64 + 8 * fq; step16 = (size_t)16 * 1024; } }
        float rs1[2][4]; f32x4 rs4[2][4];
#pragma unroll
        for (int ai = 0; ai < 2; ++ai)
#pragma unroll
            for (int m = 0; m < 4; ++m) { const int r = u.pm * BM + ai * HALF + wr * 64 + m * 16 + fr;
                if (MODE == 0) rs1[ai][m] = 1.0f; else rs4[ai][m] = *(const f32x4*)(rs + (size_t)(row_base + r) * 16 + 4 * fq); }
#pragma unroll
        for (int ai = 0; ai < 2; ++ai)
#pragma unroll
            for (int m = 0; m < 4; ++m) {
                const int r = u.pm * BM + ai * HALF + wr * 64 + m * 16 + fr;
                float rsv;
                if (MODE == 0) rsv = rs1[ai][m];
                else { const f32x4 pp = rs4[ai][m]; float s = (pp[0] + pp[1]) + (pp[2] + pp[3]); s = sum_x16(s); s = sum_x32(s); rsv = __builtin_amdgcn_rsqf(s * (1.0f / 1024.0f) + RMS_EPS); }
                f32x4 v[2][2];
#pragma unroll
                for (int bj = 0; bj < 2; ++bj)
#pragma unroll
                    for (int n = 0; n < 2; ++n) v[bj][n] = acc[ai][bj][m][n] * rsv;
                if (type < 2) {
                    float ss = 0.f;
#pragma unroll
                    for (int bj = 0; bj < 2; ++bj)
#pragma unroll
                        for (int n = 0; n < 2; ++n) { const f32x4 x = v[bj][n]; ss += (x[0] * x[0] + x[1] * x[1]) + (x[2] * x[2] + x[3] * x[3]); }
                    ss = sum_x16(ss); ss = sum_x32(ss);
                    const float inv = __builtin_amdgcn_rsqf(ss * (1.0f / 64.0f) + RMS_EPS);
#pragma unroll
                    for (int bj = 0; bj < 2; ++bj)
#pragma unroll
                        for (int n = 0; n < 2; ++n) v[bj][n] = v[bj][n] * gv[bj][n] * inv;
                } else if (type == 3) {
#pragma unroll
                    for (int bj = 0; bj < 2; ++bj)
#pragma unroll
                        for (int n = 0; n < 2; ++n)
#pragma unroll
                            for (int e = 0; e < 4; ++e) { const float a = v[bj][n][e]; v[bj][n][e] = a * __builtin_amdgcn_rcpf(1.0f + __builtin_amdgcn_exp2f(-1.4426950408889634f * a)); }
                }
                bf16_t* p = p0 + (size_t)(8 * ai + m) * step16;
#pragma unroll
                for (int bj = 0; bj < 2; ++bj) { u32x4 w; w.x = cvt_pk_bf16(v[bj][0][0], v[bj][0][1]); w.y = cvt_pk_bf16(v[bj][0][2], v[bj][0][3]); w.z = cvt_pk_bf16(v[bj][1][0], v[bj][1][1]); w.w = cvt_pk_bf16(v[bj][1][2], v[bj][1][3]);
                    st16_wt(p + 32 * bj, w); }
            }
    }
};

template <bool FIRST> struct EpiOut {
    static constexpr bool HEADMAP = false;
    static constexpr bool F16 = false;
    struct Side { };
    __device__ __forceinline__ void side_issue(Side&, int, int, int, int) const {}
    __device__ __forceinline__ void side_finish(const Side&, int) const {}
    const float* base; float* out; bf16_t* xh; float* part;
    static __device__ __forceinline__ void swap2(unsigned a, unsigned b, unsigned& ra, unsigned& rb) { auto r = __builtin_amdgcn_permlane16_swap(a, b, false, false); const unsigned r0 = r[0], r1 = r[1]; ra = r0; rb = r1; }
    __device__ __forceinline__ void operator()(const f32x4 (&acc)[2][2][4][2], const Unit& u, int wr, int wc, int fr, int fq) const {
        f32x4 pre[FIRST ? 4 : 1][2][2]; u32x4 preh[FIRST ? 1 : 4][2]; float ssq[8];
        const size_t off0 = (size_t)(u.pm * BM + wr * 64 + fr) * 1024 + u.pn * BM + wc * 32 + 4 * fq;
        const size_t offw = off0 + ((fq & 1) ? 12 : 0);
#define EPO_ROW(rg) ((size_t)(((rg) >> 2) * HALF + ((rg) & 3) * 16) * 1024)
#define EPO_LOAD(rg) do { _Pragma("unroll") for (int bj = 0; bj < 2; ++bj) { \
            if (FIRST) { _Pragma("unroll") for (int n = 0; n < 2; ++n) pre[(rg) & 3][bj][n] = *(const f32x4*)(base + off0 + EPO_ROW(rg) + bj * HALF + n * 16); } \
            else preh[(rg) & 3][bj] = *(const u32x4*)(xh + offw + EPO_ROW(rg) + bj * HALF); } } while (0)
        EPO_LOAD(0); EPO_LOAD(1); EPO_LOAD(2); EPO_LOAD(3);
#pragma unroll
        for (int rg = 0; rg < 8; ++rg) {
            const int ai = rg >> 2, m = rg & 3;
            float ss = 0.f;
#pragma unroll
            for (int bj = 0; bj < 2; ++bj) {
                f32x4 p0, p1;
                if (FIRST) { p0 = pre[rg & 3][bj][0]; p1 = pre[rg & 3][bj][1]; }
                else { const u32x4 L = preh[rg & 3][bj]; const unsigned lx = L.x, ly = L.y, lz = L.z, lw = L.w; u32x2 X, Y; unsigned a0, b0, a1, b1; swap2(lx, lz, a0, b0); swap2(ly, lw, a1, b1);
                       X.x = a0; X.y = a1; Y.x = b0; Y.y = b1; p0 = f16x4_to_f32(X); p1 = f16x4_to_f32(Y); }
                const f32x4 o0 = p0 + acc[ai][bj][m][0], o1 = p1 + acc[ai][bj][m][1];
                if (FIRST) {
                    const unsigned x0 = cvt_pk_f16(o0[0], o0[1]), x1 = cvt_pk_f16(o0[2], o0[3]), y0 = cvt_pk_f16(o1[0], o1[1]), y1 = cvt_pk_f16(o1[2], o1[3]);
                    unsigned a0, b0, a1, b1; swap2(x0, y0, a0, b0); swap2(x1, y1, a1, b1);
                    u32x4 w; w.x = a0; w.y = a1; w.z = b0; w.w = b1;
                    st16_wt(xh + offw + EPO_ROW(rg) + bj * HALF, w);
                    ss += ((o0[0] * o0[0] + o0[1] * o0[1]) + (o0[2] * o0[2] + o0[3] * o0[3])) + ((o1[0] * o1[0] + o1[1] * o1[1]) + (o1[2] * o1[2] + o1[3] * o1[3]));
                } else {
                    st16_wt(out + off0 + EPO_ROW(rg) + bj * HALF, __builtin_bit_cast(u32x4, o0));
                    st16_wt(out + off0 + EPO_ROW(rg) + bj * HALF + 16, __builtin_bit_cast(u32x4, o1));
                }
            }
            if (rg + 4 < 8) EPO_LOAD(rg + 4);
            if (FIRST) { ss = sum_x16(ss); ss = sum_x32(ss); ssq[rg] = ss; }
        }
        if (FIRST) {
#pragma unroll
            for (int hh = 0; hh < 2; ++hh) {
                const float v = (fq == 0) ? ssq[4 * hh] : (fq == 1) ? ssq[4 * hh + 1] : (fq == 2) ? ssq[4 * hh + 2] : ssq[4 * hh + 3];
                const int r = u.pm * BM + hh * HALF + wr * 64 + fq * 16 + fr;
                part[(size_t)r * 16 + u.pn * 4 + wc] = v;
            }
        }
#undef EPO_ROW
#undef EPO_LOAD
    }
};

template <class Epi, class Sched, bool ALIGN_EPI>
__device__ __forceinline__ void gemm_phase(PG8_LAS unsigned char* lds, const Gemm g, const Sched& S, const Epi& E, const int wave_, const unsigned* war_cnt = nullptr, const unsigned war_need = 0u) {
    int lane_; asm volatile("v_mbcnt_lo_u32_b32 %0, -1, 0\n\tv_mbcnt_hi_u32_b32 %0, -1, %0" : "=v"(lane_)); const int tid_ = wave_ * 64 + lane_;
    const int tid = tid_, wid = __builtin_amdgcn_readfirstlane(tid >> 6), lane = tid & 63, wr = wid >> 2, wc = wid & 3, fr = lane & 15, fq = lane >> 4;
    const int K = g.K, nt = K / BK;
    unsigned voffA[2], voffB[2];
#pragma unroll
    for (int i = 0; i < 2; ++i) { int R, C; stage_rc(tid * 16 + i * 8192, R, C);
        const int Rb = Epi::HEADMAP ? (64 * (R >> 5) + perm32(R & 31)) : R;
        voffA[i] = (unsigned)(R * K + C) * 2u; voffB[i] = (unsigned)(Rb * K + C) * 2u; }
    const size_t kstep = (size_t)(BK * 2);
    const size_t hstep = (size_t)HALF * K * 2;
    const size_t hstepB = Epi::HEADMAP ? (size_t)32 * K * 2 : hstep;
    const size_t tstep = 2 * hstep;
    const unsigned ldsw = (unsigned)wid * 1024u;
    const int aoff = lds_byte(wr * 64 + fr, fq * 8), boff = lds_byte(wc * 32 + fr, fq * 8);
#define PG8_SA(b, h) (((b) * 2 + (h)) * HTB)
#define PG8_SB(b, h) ((4 + (b) * 2 + (h)) * HTB)
#define PG8_STAGE(bufoff, gbase, voff) do { _Pragma("unroll") for (int _i = 0; _i < 2; ++_i) \
        __builtin_amdgcn_global_load_lds((const unsigned*)((const char*)(gbase) + (voff)[_i]), (PG8_LAS unsigned*)(lds + (bufoff) + ldsw + _i * 8192), 16, 0, 0); } while (0)
#define PG8_LDA(dst, b, h) do { _Pragma("unroll") for (int m = 0; m < 4; ++m) _Pragma("unroll") for (int k = 0; k < 2; ++k) dst[m][k] = *(const PG8_LAS bf16x8*)(lds + PG8_SA(b, h) + aoff + m * 2048 + k * 1024); } while (0)
#define PG8_LDB(dst, b, h) do { _Pragma("unroll") for (int n = 0; n < 2; ++n) _Pragma("unroll") for (int k = 0; k < 2; ++k) dst[n][k] = *(const PG8_LAS bf16x8*)(lds + PG8_SB(b, h) + boff + n * 2048 + k * 1024); } while (0)
#define PG8_MMA(ai, bj, At, Bt) do { __builtin_amdgcn_s_setprio(1); _Pragma("unroll") for (int m = 0; m < 4; ++m) _Pragma("unroll") for (int n = 0; n < 2; ++n) _Pragma("unroll") for (int k = 0; k < 2; ++k) \
        acc[ai][bj][m][n] = Epi::F16 ? __builtin_amdgcn_mfma_f32_16x16x32_f16(__builtin_bit_cast(f16x8_t, Bt[n][k]), __builtin_bit_cast(f16x8_t, At[m][k]), acc[ai][bj][m][n], 0, 0, 0) \
                                     : __builtin_amdgcn_mfma_f32_16x16x32_bf16(Bt[n][k], At[m][k], acc[ai][bj][m][n], 0, 0, 0); __builtin_amdgcn_s_setprio(0); } while (0)
#define PG8_WAIT_V(n) asm volatile("s_waitcnt vmcnt(" #n ")" ::: "memory")
#define PG8_WAIT_L(n) asm volatile("s_waitcnt lgkmcnt(" #n ")" ::: "memory")
#define PG8_BAR __builtin_amdgcn_s_barrier()
#define PG8_SCHED __builtin_amdgcn_sched_barrier(0)
    Unit cur, nxt; int ui = 0;
    if (!S.next(0, cur)) return;
    f32x4 acc[2][2][4][2];
#pragma unroll
    for (int a = 0; a < 2; ++a)
#pragma unroll
        for (int b = 0; b < 2; ++b)
#pragma unroll
            for (int m = 0; m < 4; ++m)
#pragma unroll
                for (int n = 0; n < 2; ++n) acc[a][b][m][n] = (f32x4){0.f, 0.f, 0.f, 0.f};
    bf16x8 At[4][2], B0[2][2], B1[2][2];
    const char* cA = (const char*)g.A + (size_t)cur.pm * tstep; const char* cB = (const char*)g.Bt + (size_t)cur.pn * tstep;
    PG8_STAGE(PG8_SB(0, 0), cB, voffB); PG8_STAGE(PG8_SB(0, 1), cB + hstepB, voffB); PG8_STAGE(PG8_SA(0, 0), cA, voffA); PG8_STAGE(PG8_SA(0, 1), cA + hstep, voffA);
    if (wr == 1) PG8_BAR;
    PG8_WAIT_V(2); PG8_BAR;
    PG8_STAGE(PG8_SB(1, 0), cB + kstep, voffB); PG8_STAGE(PG8_SA(1, 0), cA + kstep, voffA); PG8_STAGE(PG8_SB(1, 1), cB + hstepB + kstep, voffB);
    PG8_WAIT_V(6); PG8_BAR;
    for (;;) {
        const bool has_next = S.next(ui + 1, nxt);
        const char* nA = has_next ? (const char*)g.A + (size_t)nxt.pm * tstep : cA; const char* nB = has_next ? (const char*)g.Bt + (size_t)nxt.pn * tstep : cB;
        for (int t = 0; t < nt; t += 2) {
            const bool last = (t == nt - 2);
            const char* a1 = cA + (size_t)(t + 1) * kstep;
            const char* a2 = last ? nA : cA + (size_t)(t + 2) * kstep; const char* b2 = last ? nB : cB + (size_t)(t + 2) * kstep;
            const char* a3 = a2 + kstep; const char* b3 = b2 + kstep;
            PG8_LDB(B0, 0, 0); PG8_LDB(B1, 0, 1); PG8_SCHED; PG8_LDA(At, 0, 0); PG8_STAGE(PG8_SA(1, 1), a1 + hstep, voffA);
            PG8_WAIT_V(8); PG8_WAIT_L(0); PG8_BAR; PG8_MMA(0, 0, At, B0); PG8_MMA(0, 1, At, B1); PG8_BAR; PG8_SCHED;
            PG8_LDA(At, 0, 1); PG8_STAGE(PG8_SB(0, 0), b2, voffB); PG8_STAGE(PG8_SB(0, 1), b2 + hstepB, voffB); PG8_STAGE(PG8_SA(0, 0), a2, voffA);
            PG8_WAIT_V(8); PG8_WAIT_L(0); PG8_BAR; PG8_MMA(1, 0, At, B0); PG8_MMA(1, 1, At, B1); PG8_BAR; PG8_SCHED;
            PG8_LDB(B0, 1, 0); PG8_LDB(B1, 1, 1); PG8_SCHED; PG8_LDA(At, 1, 0); PG8_STAGE(PG8_SA(0, 1), a2 + hstep, voffA);
            PG8_WAIT_V(8); PG8_WAIT_L(0); PG8_BAR; PG8_MMA(0, 0, At, B0); PG8_MMA(0, 1, At, B1); PG8_BAR; PG8_SCHED;
            PG8_LDA(At, 1, 1); PG8_STAGE(PG8_SB(1, 0), b3, voffB); PG8_STAGE(PG8_SB(1, 1), b3 + hstepB, voffB); PG8_STAGE(PG8_SA(1, 0), a3, voffA);
            PG8_WAIT_V(8); PG8_WAIT_L(0); PG8_BAR; PG8_MMA(1, 0, At, B0); PG8_MMA(1, 1, At, B1); PG8_BAR; PG8_SCHED;
        }
        if constexpr (ALIGN_EPI) { if (wr == 0) PG8_BAR; }
        if (war_cnt && ui == 0) { unsigned sp_ = 0; while (__hip_atomic_load(war_cnt, __ATOMIC_RELAXED, __HIP_MEMORY_SCOPE_AGENT) < war_need && ++sp_ < (1u << 22)) __builtin_amdgcn_s_sleep(2); }
        typename Epi::Side side_; E.side_issue(side_, ui, S.c, wid, lane);
        E(acc, cur, wr, wc, fr, fq);
        E.side_finish(side_, lane);
        if (!has_next) break;
#pragma unroll
        for (int a = 0; a < 2; ++a)
#pragma unroll
            for (int b = 0; b < 2; ++b)
#pragma unroll
                for (int m = 0; m < 4; ++m)
#pragma unroll
                    for (int n = 0; n < 2; ++n) acc[a][b][m][n] = (f32x4){0.f, 0.f, 0.f, 0.f};
        cur = nxt; cA = nA; cB = nB; ++ui;
        if constexpr (ALIGN_EPI) { if (wr == 1) PG8_BAR; }
    }
    PG8_WAIT_V(0);
    if constexpr (!ALIGN_EPI) { if (wr == 0) PG8_BAR; }
    PG8_BAR;
#undef PG8_SA
#undef PG8_SB
#undef PG8_STAGE
#undef PG8_LDA
#undef PG8_LDB
#undef PG8_MMA
#undef PG8_WAIT_V
#undef PG8_WAIT_L
#undef PG8_BAR
#undef PG8_SCHED
}
}
constexpr int NWAVES = 8;
constexpr int BATCH = 8, SEQ = 4096, DM = 1024, NH = 16, HD = 64;
constexpr int MTOK = BATCH * SEQ;
#ifndef NCH_A
#define NCH_A 2
#endif
constexpr int NCH = NCH_A;
constexpr int MCH = MTOK / NCH, BCH = BATCH / NCH;
#ifndef NCH_B
#define NCH_B 1
#endif
constexpr int NCHB = NCH_B;
constexpr int MCHB = MTOK / NCHB, BCHB = BATCH / NCHB;
constexpr int NA_IN = 10240, NB_IN = 4096;
constexpr float LOG2E = 1.4426950408889634f;
constexpr float QSCALE = 0.125f * LOG2E;

constexpr size_t MiB = 1u << 20;
constexpr size_t WS_CTL = 0, CTL_ZERO_BYTES = 64 * 1024;
constexpr size_t WS_CSHIFT = 1 * MiB + 512 * 1024;
constexpr size_t WS_RSTD1 = 1 * MiB;
constexpr size_t WS_PART2 = 2 * MiB;
constexpr size_t WS_WAIN = 4 * MiB, WS_WAOUT = 24 * MiB, WS_WBIN = 26 * MiB, WS_WBOUT = 34 * MiB;
constexpr size_t WS_XB = 36 * MiB;
constexpr size_t WS_QKVA = 100 * MiB;
constexpr size_t SECA = (size_t)BCH * NH * SEQ * HD;
constexpr size_t WS_GATEA = WS_QKVA + 9 * SECA * 2;
constexpr size_t QKVA_BUF = 10 * SECA * 2;
constexpr int QKVA_NBUF = 1;
constexpr size_t WS_X1B = 100 * MiB;
constexpr size_t WS_QKVB = 164 * MiB;
constexpr size_t SECB = (size_t)BCHB * NH * SEQ * HD;
constexpr size_t WS_GATEB = WS_QKVB + 3 * SECB * 2;
constexpr size_t WS_END = 420 * MiB;
static_assert(WS_QKVA + (size_t)QKVA_NBUF * QKVA_BUF <= WS_END && WS_GATEB + (size_t)MCHB * DM * 2 <= WS_END && WS_X1B + 64 * MiB <= WS_QKVB, "ws map");
constexpr int CW_BAR = 4096;
constexpr int CW_WAR = 8192;

constexpr int RING_OFF = 0, RING_BYTES = 131072;
constexpr int PHASE_LDS = 155648;
constexpr int LDSCTL_OFF = PHASE_LDS, MISC_OFF = LDSCTL_OFF + 320;
constexpr int LDS_BYTES = 159744;

#define GAS __attribute__((address_space(1)))
#define LAS __attribute__((address_space(3)))
typedef unsigned short bf16;
typedef unsigned v4u __attribute__((ext_vector_type(4)));
typedef unsigned v2u __attribute__((ext_vector_type(2)));
typedef float f32x4 __attribute__((ext_vector_type(4)));
typedef short bf16x8 __attribute__((ext_vector_type(8)));
typedef GAS unsigned gu32;
#define RLX_AGENT __ATOMIC_RELAXED, __HIP_MEMORY_SCOPE_AGENT
#define LDS_WAIT() asm volatile("s_waitcnt lgkmcnt(0)" ::: "memory")
#define VM_WAIT() asm volatile("s_waitcnt vmcnt(0)" ::: "memory")
__device__ __forceinline__ unsigned f2bf(float f) { unsigned u = __builtin_bit_cast(unsigned, f); return (u + 0x7fffu + ((u >> 16) & 1u)) >> 16; }
__device__ __forceinline__ unsigned pk2(float lo, float hi) { return f2bf(lo) | (f2bf(hi) << 16); }
__device__ __forceinline__ float bf2f(unsigned short h) { return __builtin_bit_cast(float, (unsigned)h << 16); }

__device__ __forceinline__ int lane_id() { int l; asm volatile("v_mbcnt_lo_u32_b32 %0, -1, 0\n\tv_mbcnt_hi_u32_b32 %0, -1, %0" : "=v"(l)); return l; }
#define XB_TMO      128
#define XB_XCNT(j)  (256  + 64 * (j))
#define XB_XSUB(j)  (1280 + 64 * (j))
#define XB_XGEN(j)  (2304 + 64 * (j))
#define XB_TOP      3328
#define XB_TOPGEN   3392
#define XCD_BAR_WORDS 3456
#define XB_SPIN_CAP (1u << 18)
__device__ __forceinline__ unsigned xb_ld(unsigned* p)              { return __hip_atomic_load(p, __ATOMIC_RELAXED, __HIP_MEMORY_SCOPE_AGENT); }
__device__ __forceinline__ unsigned xb_add(unsigned* p, unsigned v) { return __hip_atomic_fetch_add(p, v, __ATOMIC_RELAXED, __HIP_MEMORY_SCOPE_AGENT); }
__device__ __forceinline__ unsigned xb_xcc_id() { return (unsigned)__builtin_amdgcn_s_getreg((3 << 11) | 20) & 0xFu; }
#define XB_SPIN(cond, bar) do { unsigned _sp = 0; while (cond) { __builtin_amdgcn_s_sleep(1); \
    if ((++_sp & 255u) == 0u) { if (xb_ld(&(bar)[XB_TMO])) break; if (_sp > XB_SPIN_CAP) { atomicAdd(&(bar)[XB_TMO], 1u); break; } } } } while (0)
struct XcdBarrier { unsigned* bar; unsigned x; volatile LAS unsigned* st; int wave; };
__device__ __forceinline__ XcdBarrier xcd_barrier_post(unsigned* bar, volatile LAS unsigned* st, int wave) {
    XcdBarrier b; b.bar = bar; b.x = xb_xcc_id(); b.st = st; b.wave = wave;
    if (wave == 0 && lane_id() == 0) (void)xb_add(&bar[XB_XCNT(b.x)], 1u);
    return b;
}
__device__ __forceinline__ void xcd_barrier_complete(unsigned* bar, unsigned x, unsigned& nloc, unsigned& nx) {
    const unsigned G = gridDim.x * gridDim.y * gridDim.z;
    unsigned sum, cnt, mine, sp = 0u;
    for (;;) {
        sum = 0u; cnt = 0u; mine = 0u;
#pragma unroll
        for (unsigned j = 0; j < 16; ++j) { const unsigned c = xb_ld(&bar[XB_XCNT(j)]); sum += c; cnt += (c > 0u) ? 1u : 0u; mine = (j == x) ? c : mine; }
        if (sum == G) break;
        __builtin_amdgcn_s_sleep(1);
        if ((++sp & 255u) == 0u) { if (xb_ld(&bar[XB_TMO])) break; if (sp > XB_SPIN_CAP) { atomicAdd(&bar[XB_TMO], 1u); break; } }
    }
    nloc = mine > 0u ? mine : 1u; nx = cnt > 0u ? cnt : 1u;
}
__device__ __forceinline__ void xcd_barrier(const XcdBarrier& b) {
    asm volatile("s_waitcnt vmcnt(0)" ::: "memory");
    __syncthreads();
    if (b.wave == 0 && lane_id() == 0) {
        unsigned* bar = b.bar; asm volatile("" : "+s"(bar));
        __builtin_amdgcn_s_waitcnt(0);
        unsigned nloc = b.st[0], nx = b.st[1];
        if (nloc == 0u) { xcd_barrier_complete(bar, b.x, nloc, nx); b.st[0] = nloc; b.st[1] = nx; }
        const unsigned old = xb_add(&bar[XB_XSUB(b.x)], 1u);
        const unsigned gen = old / nloc;
        if (old + 1u == (gen + 1u) * nloc) {
            __builtin_amdgcn_fence(__ATOMIC_RELEASE, "agent");
            asm volatile("s_waitcnt vmcnt(0)" ::: "memory");
            const unsigned og = xb_add(&bar[XB_TOP], 1u);
            const unsigned tg = og / nx;
            if (og + 1u == (tg + 1u) * nx) xb_add(&bar[XB_TOPGEN], 1u);
            else XB_SPIN(xb_ld(&bar[XB_TOPGEN]) == tg, bar);
            __builtin_amdgcn_fence(__ATOMIC_ACQUIRE, "agent");
            xb_add(&bar[XB_XGEN(b.x)], 1u);
            asm volatile("s_waitcnt vmcnt(0)" ::: "memory");
        } else {
            XB_SPIN(xb_ld(&bar[XB_XGEN(b.x)]) == gen, bar);
            __builtin_amdgcn_fence(__ATOMIC_ACQUIRE, "agent");
            asm volatile("s_waitcnt vmcnt(0)" ::: "memory");
        }
    }
    __syncthreads();
}

struct Frame {
    LAS unsigned char* lds;
    volatile LAS unsigned* MISC;
    gu32* ctl;
    int tid, lane, wave, vcu, G;
};

template <bool F16 = false>
__device__ __forceinline__ void p0_transpose_item(const float* W, int K, int N, bf16* WT, const float* gk, LAS float* scr, int item, int lane) {
    const int nblk = N / 32, kb = item / nblk, nb = item % nblk, k0 = 64 * kb, n0 = 32 * nb;
    float wv[32];
#pragma unroll
    for (int i = 0; i < 32; ++i) { const int kk = 2 * i + (lane >> 5); wv[i] = __builtin_nontemporal_load(W + (size_t)(k0 + kk) * N + n0 + (lane & 31)); }
#pragma unroll
    for (int i = 0; i < 32; ++i) { const int kk = 2 * i + (lane >> 5); const float gsc = gk ? gk[k0 + kk] : 1.0f; scr[kk * 33 + (lane & 31)] = wv[i] * gsc; }
    LDS_WAIT(); asm volatile("" ::: "memory");
    const int c = lane & 7;
#pragma unroll
    for (int j = 0; j < 4; ++j) { const int n = (lane >> 3) + 8 * j; const LAS float* s = scr + (8 * c) * 33 + n;
        v4u o;
        if (F16) { o.x = pg8::cvt_pk_f16(s[0 * 33], s[1 * 33]); o.y = pg8::cvt_pk_f16(s[2 * 33], s[3 * 33]); o.z = pg8::cvt_pk_f16(s[4 * 33], s[5 * 33]); o.w = pg8::cvt_pk_f16(s[6 * 33], s[7 * 33]); }
        else { o.x = pk2(s[0 * 33], s[1 * 33]); o.y = pk2(s[2 * 33], s[3 * 33]); o.z = pk2(s[4 * 33], s[5 * 33]); o.w = pk2(s[6 * 33], s[7 * 33]); }
        *(GAS v4u*)(WT + (size_t)(n0 + n) * K + k0 + 8 * c) = o; }
    LDS_WAIT(); asm volatile("" ::: "memory");
}
__device__ __forceinline__ int t5_bucket_dev(int rel) {
    const int n = rel < 0 ? -rel : rel;
    const int b = n < 8 ? n : 8 + (n >= 15) + (n >= 27) + (n >= 50) + (n >= 91) + (n >= 167) + (n >= 305) + (n >= 559);
    return b + (rel > 0 ? 16 : 0);
}
namespace att {
typedef float f32x16 __attribute__((ext_vector_type(16)));
typedef short s16x4 __attribute__((ext_vector_type(4)));
typedef short v4i16_t __attribute__((ext_vector_type(4)));
typedef float f32x2_t __attribute__((ext_vector_type(2)));
typedef __bf16 bf16x2_t __attribute__((ext_vector_type(2)));
constexpr float NEG = -1e30f;
constexpr int ACC_PITCH = 136;
constexpr int ACC_OFF = 0, LACC_OFF = 512 * ACC_PITCH, TBL_OFF = LACC_OFF + 2048, TBL_BYTES = 4096  , SCR_OFF = TBL_OFF + 2 * TBL_BYTES, VST_OFF = SCR_OFF + 256, STAGE_BYTES = 8192, LDS_END = VST_OFF + 8 * STAGE_BYTES;
static_assert(VST_OFF % 16 == 0 && LDS_END <= PHASE_LDS, "attention LDS map");
__device__ __forceinline__ int rho(int t) { return t ^ ((t >> 5) & 15); }
__device__ __forceinline__ unsigned cvtpk(float lo, float hi) { f32x2_t v = {lo, hi}; bf16x2_t b = __builtin_convertvector(v, bf16x2_t); return __builtin_bit_cast(unsigned, b); }
__device__ __forceinline__ s16x4 vtr(const LAS char* p) { return __builtin_bit_cast(s16x4, __builtin_amdgcn_ds_read_tr16_b64_v4i16((LAS v4i16_t*)p)); }

struct Seg {
    const bf16* qA; const bf16* qB;
    const bf16* kt; const bf16* vt;
    const LAS char* tbA; const LAS char* tbB; const LAS char* tneg;
    int tstride, nt, aHi, bLo, bHi;
    int raLo, rbLo;
    int tlocA, tlocB;
    int first, dual;
};
struct St { bf16x8 qA[4], qB[4]; };
struct Lay { unsigned kOffE, kOffO, vOff; int rdK[4]; int vrd; };
__device__ __forceinline__ void lay_init(Lay& L, int lane) {
    const int l3 = (lane >> 3) & 1, l4 = (lane >> 4) & 1, l5 = (lane >> 5) & 1, c7 = lane & 7;
    const unsigned rows = 1024u * l3 + 512u * l5 + 256u * l4;
    L.kOffE = rows + 16u * (unsigned)(c7 ^ (4 * l5 + 2 * l4));
    L.kOffO = rows + 128u + 16u * (unsigned)(c7 ^ (4 * l5 + 2 * l4 + 1));
    L.vOff = (unsigned)((lane >> 2) * 128 + (lane & 3) * 16);
    const int r32 = lane & 31, hi = lane >> 5, kp = (r32 & ~9) | ((r32 & 1) << 3) | ((r32 >> 3) & 1), m = r32 & 7;
#pragma unroll
    for (int d0 = 0; d0 < 4; ++d0) L.rdK[d0] = 128 * kp + 16 * ((2 * d0 + hi) ^ m);
    L.vrd = 4096 + ((lane >> 4) & 1) * 32 + (lane & 3) * 8 + (4 * hi + ((lane & 15) >> 2)) * 64;
}
#define ATT_GLDS(g, l) __builtin_amdgcn_global_load_lds((const unsigned*)(g), (LAS unsigned*)(l), 16, 0, 0)
__device__ __forceinline__ void dma_tile(const bf16* kt, const bf16* vt, LAS char* stage, const Lay& L) {
    const char* kb = (const char*)kt; const char* vb = (const char*)vt + L.vOff;
    ATT_GLDS(kb + L.kOffE, stage); ATT_GLDS(kb + L.kOffO, stage + 1024); ATT_GLDS(kb + L.kOffE + 2048, stage + 2048); ATT_GLDS(kb + L.kOffO + 2048, stage + 3072);
    ATT_GLDS(vb, stage + 4096); ATT_GLDS(vb + 2048, stage + 5120); ATT_GLDS(vb + 64, stage + 6144); ATT_GLDS(vb + 2048 + 64, stage + 7168);
}
__device__ __forceinline__ void seg_start(const Seg& s, St& st, int lane) {
    const int hi = lane >> 5;
#pragma unroll
    for (int d0 = 0; d0 < 4; ++d0) { st.qA[d0] = *(const bf16x8*)(s.qA + d0 * 16 + hi * 8); st.qB[d0] = *(const bf16x8*)(s.qB + d0 * 16 + hi * 8); }
}
template <bool CM>
__device__ __forceinline__ void cinit(f32x16& p, const LAS char* tb, const LAS char* tneg, int t, int rlo, const float (&cm)[16]) {
    const LAS char* ta = tb + 128 * t;
    if (CM) ta = ((unsigned)(t - rlo) < 8u) ? ta : tneg;
#pragma unroll
    for (int r = 0; r < 16; ++r) { p[r] = *(const LAS float*)(ta + 4 * ((r & 3) + 8 * (r >> 2))); if (CM) p[r] += cm[r]; }
}
__device__ __forceinline__ void softmax_pack(f32x16& p, float& lsum, bf16x8& pf0, bf16x8& pf1) {
#pragma unroll
    for (int r = 0; r < 16; ++r) { p[r] = __builtin_amdgcn_exp2f(p[r]); lsum += p[r]; }
    v4u pk0, pk1;
    pk0.x = cvtpk(p[0], p[1]); pk0.y = cvtpk(p[2], p[3]); pk0.z = cvtpk(p[4], p[5]); pk0.w = cvtpk(p[6], p[7]);
    pk1.x = cvtpk(p[8], p[9]); pk1.y = cvtpk(p[10], p[11]); pk1.z = cvtpk(p[12], p[13]); pk1.w = cvtpk(p[14], p[15]);
    pf0 = __builtin_bit_cast(bf16x8, pk0); pf1 = __builtin_bit_cast(bf16x8, pk1);
}
template <bool CM>
__device__ __forceinline__ void tile_step(int t, const bf16x8 (&kf)[4], const bf16x8 (&vf)[4], const bf16x8 (&q)[4], const LAS char* tb, const LAS char* tneg, int rlo,
                                          const float (&cm)[16], f32x16& o0, f32x16& o1, float& lsum) {
    f32x16 p; cinit<CM>(p, tb, tneg, t, rlo, cm);
#pragma unroll
    for (int d0 = 0; d0 < 4; ++d0) p = __builtin_amdgcn_mfma_f32_32x32x16_bf16(kf[d0], q[d0], p, 0, 0, 0);
    bf16x8 pf0, pf1; softmax_pack(p, lsum, pf0, pf1);
    o0 = __builtin_amdgcn_mfma_f32_32x32x16_bf16(vf[0], pf0, o0, 0, 0, 0);
    o0 = __builtin_amdgcn_mfma_f32_32x32x16_bf16(vf[1], pf1, o0, 0, 0, 0);
    o1 = __builtin_amdgcn_mfma_f32_32x32x16_bf16(vf[2], pf0, o1, 0, 0, 0);
    o1 = __builtin_amdgcn_mfma_f32_32x32x16_bf16(vf[3], pf1, o1, 0, 0, 0);
}
template <bool CM>
__device__ __forceinline__ void tile_step2(int t, const bf16x8 (&kf)[4], const bf16x8 (&vf)[4], const St& st, const Seg& s, const float (&cm)[16],
                                           f32x16& oA0, f32x16& oA1, float& lA, f32x16& oB0, f32x16& oB1, float& lB) {
    f32x16 pA, pB; cinit<CM>(pA, s.tbA, s.tneg, t, s.raLo, cm); cinit<CM>(pB, s.tbB, s.tneg, t, s.rbLo, cm);
#pragma unroll
    for (int d0 = 0; d0 < 4; ++d0) pA = __builtin_amdgcn_mfma_f32_32x32x16_bf16(kf[d0], st.qA[d0], pA, 0, 0, 0);
#pragma unroll
    for (int d0 = 0; d0 < 4; ++d0) pB = __builtin_amdgcn_mfma_f32_32x32x16_bf16(kf[d0], st.qB[d0], pB, 0, 0, 0);
    bf16x8 pf0, pf1; softmax_pack(pA, lA, pf0, pf1);
    oA0 = __builtin_amdgcn_mfma_f32_32x32x16_bf16(vf[0], pf0, oA0, 0, 0, 0);
    oA0 = __builtin_amdgcn_mfma_f32_32x32x16_bf16(vf[1], pf1, oA0, 0, 0, 0);
    oA1 = __builtin_amdgcn_mfma_f32_32x32x16_bf16(vf[2], pf0, oA1, 0, 0, 0);
    oA1 = __builtin_amdgcn_mfma_f32_32x32x16_bf16(vf[3], pf1, oA1, 0, 0, 0);
    bf16x8 pg0, pg1; softmax_pack(pB, lB, pg0, pg1);
    oB0 = __builtin_amdgcn_mfma_f32_32x32x16_bf16(vf[0], pg0, oB0, 0, 0, 0);
    oB0 = __builtin_amdgcn_mfma_f32_32x32x16_bf16(vf[1], pg1, oB0, 0, 0, 0);
    oB1 = __builtin_amdgcn_mfma_f32_32x32x16_bf16(vf[2], pg0, oB1, 0, 0, 0);
    oB1 = __builtin_amdgcn_mfma_f32_32x32x16_bf16(vf[3], pg1, oB1, 0, 0, 0);
}
template <bool CM>
__device__ __forceinline__ void seg_run(const Seg& s, const St& st, const Lay& L, const bf16* nkt, const bf16* nvt, const float (&cm)[16], LAS char* stage,
                                        f32x16& oA0, f32x16& oA1, float& lA, f32x16& oB0, f32x16& oB1, float& lB) {
    oA0 = f32x16{}; oA1 = f32x16{}; lA = 0.f; oB0 = f32x16{}; oB1 = f32x16{}; lB = 0.f;
    const int nt = s.nt, ntl = nt - 1;
    const int aHi = min(s.aHi, ntl), bLo = s.bLo, bHi = min(s.bHi, ntl);
#pragma unroll 1
    for (int t = 0; t < nt; ++t) {
        asm volatile("s_waitcnt vmcnt(0)" ::: "memory");
        bf16x8 kf[4], vf[4];
#pragma unroll
        for (int d0 = 0; d0 < 4; ++d0) kf[d0] = *(const LAS bf16x8*)(stage + L.rdK[d0]);
#pragma unroll
        for (int i_ = 0; i_ < 4; ++i_) { const s16x4 lo_ = vtr(stage + L.vrd + i_ * 1024), hh_ = vtr(stage + L.vrd + i_ * 1024 + 512); vf[i_] = (bf16x8){lo_[0], lo_[1], lo_[2], lo_[3], hh_[0], hh_[1], hh_[2], hh_[3]}; }
        asm volatile("s_waitcnt lgkmcnt(0)" ::: "memory");
        if (t < ntl) dma_tile(s.kt + (size_t)(t + 1) * s.tstride, s.vt + (size_t)(t + 1) * s.tstride, stage, L);
        else if (nkt) dma_tile(nkt, nvt, stage, L);
        const bool a_ = (t <= aHi), b_ = (t >= bLo && t <= bHi);
        if (a_) tile_step<CM>(t, kf, vf, st.qA, s.tbA, s.tneg, s.raLo, cm, oA0, oA1, lA);
        if (b_) tile_step<CM>(t, kf, vf, st.qB, s.tbB, s.tneg, s.rbLo, cm, oB0, oB1, lB);
    }
}
__device__ __forceinline__ void acc_block(const bool FIRST, const f32x16& o0, const f32x16& o1, float lsum, LAS char* lds, int tloc, int lane) {
    const int hi = lane >> 5;
    LAS char* row = lds + ACC_OFF + rho(tloc) * ACC_PITCH + 8 * hi;
#pragma unroll
    for (int dh = 0; dh < 2; ++dh)
#pragma unroll
        for (int c4 = 0; c4 < 4; ++c4) {
            float v0 = dh ? o1[4 * c4] : o0[4 * c4], v1 = dh ? o1[4 * c4 + 1] : o0[4 * c4 + 1], v2 = dh ? o1[4 * c4 + 2] : o0[4 * c4 + 2], v3 = dh ? o1[4 * c4 + 3] : o0[4 * c4 + 3];
            LAS v2u* a = (LAS v2u*)(row + 64 * dh + 16 * c4);
            if (!FIRST) { const v2u old = *a; v0 += __builtin_bit_cast(float, old.x << 16); v1 += __builtin_bit_cast(float, old.x & 0xffff0000u); v2 += __builtin_bit_cast(float, old.y << 16); v3 += __builtin_bit_cast(float, old.y & 0xffff0000u); }
            v2u w; w.x = cvtpk(v0, v1); w.y = cvtpk(v2, v3); *a = w;
        }
    float l = sum_x32(lsum);
    if (hi == 0) { LAS float* la = (LAS float*)(lds + LACC_OFF) + tloc; if (!FIRST) l += *la; *la = l; }
}
__device__ __forceinline__ void gate_load(v4u (&gw)[8], const bf16* grow, int tid) {
#pragma unroll
    for (int it = 0; it < 8; ++it) gw[it] = *(const v4u*)(grow + (size_t)((tid >> 3) + 64 * it) * 1024 + 8 * (tid & 7));
}
template <bool NT = false>
__device__ __forceinline__ void final_store(const v4u (&gw)[8], LAS char* lds, bf16* yrow, int tid) {
#pragma unroll
    for (int it = 0; it < 8; ++it) {
        const int tloc = (tid >> 3) + 64 * it, c = tid & 7;
        const LAS char* row = lds + ACC_OFF + rho(tloc) * ACC_PITCH + 16 * c;
        const v2u a0 = *(const LAS v2u*)row, a1 = *(const LAS v2u*)(row + 8);
        const float inv = __builtin_amdgcn_rcpf(*((const LAS float*)(lds + LACC_OFF) + tloc));
        v4u g = gw[it];
        float gs[8];
        { const unsigned gu[4] = {g.x, g.y, g.z, g.w};
#pragma unroll
          for (int k = 0; k < 4; ++k) { gs[2 * k] = __builtin_bit_cast(float, gu[k] << 16); gs[2 * k + 1] = __builtin_bit_cast(float, gu[k] & 0xffff0000u); } }
        v4u w;
        w.x = cvtpk(__builtin_bit_cast(float, a0.x << 16) * inv * gs[0], __builtin_bit_cast(float, a0.x & 0xffff0000u) * inv * gs[1]);
        w.y = cvtpk(__builtin_bit_cast(float, a0.y << 16) * inv * gs[2], __builtin_bit_cast(float, a0.y & 0xffff0000u) * inv * gs[3]);
        w.z = cvtpk(__builtin_bit_cast(float, a1.x << 16) * inv * gs[4], __builtin_bit_cast(float, a1.x & 0xffff0000u) * inv * gs[5]);
        w.w = cvtpk(__builtin_bit_cast(float, a1.y << 16) * inv * gs[6], __builtin_bit_cast(float, a1.y & 0xffff0000u) * inv * gs[7]);
        if (NT) __builtin_nontemporal_store(w, (v4u*)(yrow + (size_t)tloc * 1024 + 8 * c)); else *(v4u*)(yrow + (size_t)tloc * 1024 + 8 * c) = w;
    }
}
__device__ __forceinline__ float wg_absmax(const float* p, int n, LAS float* scr, int tid) {
    float m = 0.f;
    for (int i = tid; i < n; i += NWAVES * 64) m = fmaxf(m, fabsf(p[i]));
    m = wave_max(m);
    __syncthreads();
    if ((tid & 63) == 0) scr[tid >> 6] = m;
    __syncthreads();
    float r = scr[0];
#pragma unroll
    for (int i = 1; i < NWAVES; ++i) r = fmaxf(r, scr[i]);
    return r;
}

__device__ __forceinline__ void seg_a(Seg& sg, int u, int si, int tblbuf, const bf16* qkv, LAS char* lds, int lane, int wave) {
    const int s = u & 7, h = (u >> 3) & 15, bl = u >> 7;
    const int g = (si < 2) ? 2 : 3 - si, bb = (si < 2) ? si : 0;
    const bool dual = (g < 2);
    const int sh = 2 * g, L = SEQ >> sh;
    const int bi = 2 * wave + bb, res = bi >> (4 - sh), i = bi & ((16 >> sh) - 1);
    const int pos0 = ((512 * s) >> sh) + 32 * i;
    const int T0 = max(0, 2 - (pos0 >> 5)), T1 = min(dual ? 5 : 4, 2 + ((L - 32 - pos0) >> 5));
    const int q = lane & 31, hi = lane >> 5;
    const bf16* Qg = qkv + (size_t)(3 * g) * SECA + ((size_t)(bl * 16 + h) * 4096) * 64;
    sg.qA = Qg + (size_t)(res * L + pos0 + q) * 64; sg.qB = dual ? sg.qA + 32 * 64 : sg.qA;
    const size_t krow0 = (size_t)(res * L + pos0 + 32 * (T0 - 2)) * 64;
    sg.kt = Qg + SECA + krow0; sg.vt = Qg + 2 * SECA + krow0;
    sg.tbA = lds + TBL_OFF + tblbuf * TBL_BYTES + 4 * (g * 192 + 32 * T0 + 31 + 4 * hi - q); sg.tbB = sg.tbA - 128; sg.tneg = sg.tbA;
    sg.tstride = 2048; sg.nt = T1 - T0 + 1; sg.aHi = 4 - T0; sg.bLo = dual ? 1 - T0 : 1; sg.bHi = dual ? T1 - T0 : 0;
    sg.raLo = 0; sg.rbLo = 0;
    sg.tlocA = ((32 * i + q) << sh) + res; sg.tlocB = ((32 * i + 32 + q) << sh) + res;
    sg.first = (g == 2) ? 1 : 0; sg.dual = dual ? 1 : 0;
}
__device__ __forceinline__ void tbl_a(int u, int tblbuf, const float* t5, float cshift, LAS char* lds, int tid) {
    const int h = (u >> 3) & 15;
    for (int idx = tid; idx < 3 * 192; idx += NWAVES * 64) {
        const int g = idx / 192, rel = idx % 192 - 95; const int ar = rel < 0 ? -rel : rel;
        float v = NEG; if (ar <= 64) v = LOG2E * t5[(g * 16 + h) * 32 + t5_bucket_dev(rel << (2 * g))] - cshift;
        ((LAS float*)(lds + TBL_OFF + tblbuf * TBL_BYTES))[idx] = v;
    }
}
__device__ __forceinline__ void attn_a_phase(Frame& F, const float cshift, const bf16* qkv, const bf16* gate, bf16* y, const float* t5, const float* qg, const float* kg) {
    LAS char* lds = (LAS char*)F.lds;
    LAS float* scr = (LAS float*)(lds + SCR_OFF);
    int tid_ = F.wave * 64 + lane_id(); asm volatile("" : "+v"(tid_));
    const int tid = tid_, lane = tid & 63, wave = __builtin_amdgcn_readfirstlane(tid >> 6);
    const int NU = BCH * NH * 8, per = (NU + F.G - 1) / F.G, u0 = F.vcu * per, nu = min(per, NU - u0);
    if (nu <= 0) return;
    const float zero16[16] = {0.f, 0.f, 0.f, 0.f, 0.f, 0.f, 0.f, 0.f, 0.f, 0.f, 0.f, 0.f, 0.f, 0.f, 0.f, 0.f};
    LAS char* stage = lds + VST_OFF + wave * STAGE_BYTES;
    Lay L; lay_init(L, lane);
    Seg cur; St st;
    seg_a(cur, u0, 0, 0, qkv, lds, lane, wave); seg_start(cur, st, lane); dma_tile(cur.kt, cur.vt, stage, L);
    tbl_a(u0, 0, t5, cshift, lds, tid);
    __syncthreads();
#pragma unroll 1
    for (int ui = 0; ui < nu; ++ui) {
        const int u = u0 + ui;
#pragma unroll 1
        for (int si = 0; si < 4; ++si) {
            Seg nxt = cur;
            const bool more = (si < 3) || (ui + 1 < nu);
            if (more) { if (si < 3) seg_a(nxt, u, si + 1, ui & 1, qkv, lds, lane, wave); else seg_a(nxt, u + 1, 0, (ui + 1) & 1, qkv, lds, lane, wave); }
            f32x16 oA0, oA1, oB0, oB1; float lA, lB;
            seg_run<false>(cur, st, L, more ? nxt.kt : nullptr, nxt.vt, zero16, stage, oA0, oA1, lA, oB0, oB1, lB);
            if (more) seg_start(nxt, st, lane);
            if ((si == 0 && ui > 0) || si >= 2) __syncthreads();
            acc_block(cur.first != 0, oA0, oA1, lA, lds, cur.tlocA, lane);
            if (cur.dual) acc_block(false, oB0, oB1, lB, lds, cur.tlocB, lane);
            cur = nxt;
        }
        if (ui + 1 < nu) tbl_a(u + 1, (ui + 1) & 1, t5, cshift, lds, tid);
        const int s = u & 7, h = (u >> 3) & 15, bl = u >> 7;
        const size_t tok0 = (size_t)bl * 4096 + 512 * s;
        int tidf = tid; asm volatile("" : "+v"(tidf));
        v4u gw[8]; gate_load(gw, gate + tok0 * 1024 + h * 64, tidf);
        __syncthreads();
        final_store<true>(gw, lds, y + tok0 * 1024 + h * 64, tidf);
    }
    asm volatile("s_waitcnt vmcnt(0)" ::: "memory");
    __syncthreads();
}
__device__ __forceinline__ const bf16* uniform_ptr(const bf16* p) {
    const unsigned long long v = (unsigned long long)p;
    const unsigned lo = __builtin_amdgcn_readfirstlane((unsigned)v), hi = __builtin_amdgcn_readfirstlane((unsigned)(v >> 32));
    return (const bf16*)(((unsigned long long)hi << 32) | lo);
}
constexpr int RING_SLOT = 16384;
struct UnitB { const bf16* Kr; const bf16* Vr; int nrows, R, h, b; };
__device__ __forceinline__ void unit_b(UnitB& U, int u, const bf16* qkv) {
    U.R = u & 7; U.h = (u >> 3) & 15; U.b = u >> 7;
    const int kr0 = min(max(8 * U.R - 4, 0), 56), krl = min(max(8 * U.R + 7 - 4, 0), 56) + 7;
    U.nrows = krl - kr0 + 1;
    const bf16* Qb = qkv + ((size_t)(U.b * 16 + U.h) * 4096) * 64;
    U.Kr = uniform_ptr(Qb + SECB + (size_t)kr0 * 4096); U.Vr = uniform_ptr(Qb + 2 * SECB + (size_t)kr0 * 4096);
}
__device__ __forceinline__ void tbl_b(int u, int tblbuf, const float* rpb, float cshift, LAS char* lds, int tid) {
    const int h = (u >> 3) & 15;
    for (int idx = tid; idx < 640; idx += NWAVES * 64) {
        float v = NEG; const int e = idx - 16;
        if (e >= 0 && e < 480 && (e & 31) < 31) v = LOG2E * rpb[(h * 15 + (e >> 5)) * 31 + (e & 31)] - cshift;
        ((LAS float*)(lds + TBL_OFF + tblbuf * TBL_BYTES))[idx] = v;
    }
}
__device__ __forceinline__ void glds16_asm(const void* gsrc, unsigned lds_dst) { unsigned keep;
    asm volatile("s_mov_b32 %0, m0\n\ts_mov_b32 m0, %2\n\ts_nop 0\n\tglobal_load_lds_dwordx4 %1, off\n\ts_mov_b32 m0, %0" : "=&s"(keep) : "v"(gsrc), "s"(lds_dst) : "memory"); }
#define ATT_BAR() do { asm volatile("s_waitcnt lgkmcnt(0)" ::: "memory"); __builtin_amdgcn_s_barrier(); asm volatile("" ::: "memory"); } while (0)
__device__ __forceinline__ void attn_b_phase(Frame& F, const float cshift, const bf16* qkv, const bf16* gate, bf16* y, const float* rpb, const float* qg, const float* kg) {
    LAS char* lds = (LAS char*)F.lds;
    LAS float* scr = (LAS float*)(lds + SCR_OFF);
    int tid_ = F.wave * 64 + lane_id(); asm volatile("" : "+v"(tid_));
    const int tid = tid_, lane = tid & 63, wave = __builtin_amdgcn_readfirstlane(tid >> 6);
    const int NU = BCHB * NH * 8, per = (NU + F.G - 1) / F.G, u0 = F.vcu * per, nu = min(per, NU - u0);
    if (nu <= 0) return;
    const int wq = wave >> 2, cb = wave & 3, q = lane & 31, hi = lane >> 5;
    const int gcq = 16 * cb + (q & 15), slab0 = min(max(16 * cb - 8, 0), 32), csq = min(max(gcq - 8, 0), 48);
    float cm[16];
#pragma unroll
    for (int r = 0; r < 16; ++r) { const int kc = slab0 + (r & 3) + 8 * (r >> 2) + 4 * hi; cm[r] = ((unsigned)(kc - csq) < 16u) ? 0.f : NEG; }
    Lay L; lay_init(L, lane);
    const unsigned kSrc = ((wave & 1) ? L.kOffO : L.kOffE) + 2048u * (unsigned)(wave >> 1), vSrc = L.vOff + 2048u * (unsigned)(wave & 3) + 64u * (unsigned)(wave >> 2);
    const int kDst = wave * 1024, vDst = 8192 + (wave >> 2) * 4096 + (wave & 3) * 1024;
    int rdK[4];
    { const int kq = slab0 + q, kp = (kq & ~9) | ((kq & 1) << 3) | ((kq >> 3) & 1), m = kq & 7;
#pragma unroll
      for (int d0 = 0; d0 < 4; ++d0) rdK[d0] = 128 * kp + 16 * ((2 * d0 + hi) ^ m); }
    const int vrd = 8192 + (slab0 + 4 * hi + ((lane & 15) >> 2)) * 64 + ((lane >> 4) & 1) * 32 + (lane & 3) * 8;
    LAS char* ring = lds + VST_OFF;
    const unsigned ringb = (unsigned)(unsigned long long)ring;
#define ATT_ROWDMA(KR, VR, ROW, SLOT) do { const unsigned sl_ = (unsigned)__builtin_amdgcn_readfirstlane((int)(ringb + (unsigned)(SLOT) * RING_SLOT)); \
        glds16_asm((const char*)((KR) + (size_t)(ROW) * 4096) + kSrc, sl_ + kDst); glds16_asm((const char*)((VR) + (size_t)(ROW) * 4096) + vSrc, sl_ + vDst); } while (0)
    tbl_b(u0, 0, rpb, cshift, lds, tid);
    UnitB cur, nxt; unit_b(cur, u0, qkv); nxt = cur;
    if (nu > 1) unit_b(nxt, u0 + 1, qkv);
    ATT_ROWDMA(cur.Kr, cur.Vr, 0, 0); ATT_ROWDMA(cur.Kr, cur.Vr, 1, 1); ATT_ROWDMA(cur.Kr, cur.Vr, 2, 2);
    St st;
#define ATT_QLOADB(U) do { const bf16* qa_ = qkv + ((size_t)((U).b * 16 + (U).h) * 4096 + 512 * (U).R + (2 * wq + (q >> 4)) * 64 + gcq) * 64; \
        _Pragma("unroll") for (int d0 = 0; d0 < 4; ++d0) { st.qA[d0] = *(const bf16x8*)(qa_ + d0 * 16 + hi * 8); st.qB[d0] = *(const bf16x8*)(qa_ + 256 * 64 + d0 * 16 + hi * 8); } } while (0)
    ATT_QLOADB(cur);
    int rn = 0;
    ATT_BAR();
#pragma unroll 1
    for (int ui = 0; ui < nu; ++ui) {
        const int u = u0 + ui;
        const bool more = (ui + 1 < nu);
        const int R = cur.R, gr0 = 8 * R + 2 * wq, kr0 = min(max(8 * R - 4, 0), 56), nrows = cur.nrows;
        const int grA = gr0 + (q >> 4), grB = grA + 4;
        const int tlocA = (2 * wq + (q >> 4)) * 64 + gcq, tlocB = tlocA + 256;
        Seg sg;
        sg.raLo = min(max(grA - 4, 0), 56) - kr0; sg.rbLo = min(max(grB - 4, 0), 56) - kr0;
        sg.tbA = lds + TBL_OFF + (ui & 1) * TBL_BYTES + 4 * (16 + (kr0 - grA + 7) * 32 + (slab0 + 4 * hi - gcq + 15)); sg.tbB = sg.tbA - 4 * 128;
        sg.tneg = lds + TBL_OFF + (ui & 1) * TBL_BYTES + 4 * 576;
        const int aLo = min(max(gr0 - 4, 0), 56) - kr0, aHi = min(max(gr0 + 1 - 4, 0), 56) + 7 - kr0, bLo = min(max(gr0 + 4 - 4, 0), 56) - kr0, bHi = min(max(gr0 + 5 - 4, 0), 56) + 7 - kr0;
#pragma unroll
        for (int d0 = 0; d0 < 4; ++d0) asm volatile("" : "+v"(st.qA[d0]), "+v"(st.qB[d0]));
        f32x16 oA0 = f32x16{}, oA1 = f32x16{}, oB0 = f32x16{}, oB1 = f32x16{}; float lA = 0.f, lB = 0.f;
#pragma unroll 1
        for (int n = 0; n < nrows; ++n, ++rn) {
            asm volatile("s_waitcnt vmcnt(4)" ::: "memory");
            ATT_BAR();
            { const int j = n + 3;
              if (j < nrows) ATT_ROWDMA(cur.Kr, cur.Vr, j, (rn + 3) & 3);
              else if (more) ATT_ROWDMA(nxt.Kr, nxt.Vr, j - nrows, (rn + 3) & 3);
              else ATT_ROWDMA(cur.Kr, cur.Vr, nrows - 1, (rn + 3) & 3); }
            const bool a_ = (n >= aLo && n <= aHi), b_ = (n >= bLo && n <= bHi);
            if (a_ || b_) {
                const LAS char* sl = ring + (rn & 3) * RING_SLOT;
                bf16x8 kf[4], vf[4];
#pragma unroll
                for (int d0 = 0; d0 < 4; ++d0) kf[d0] = *(const LAS bf16x8*)(sl + rdK[d0]);
#pragma unroll
                for (int i_ = 0; i_ < 4; ++i_) { const s16x4 lo_ = vtr(sl + vrd + (i_ >> 1) * 4096 + (i_ & 1) * 1024), hh_ = vtr(sl + vrd + (i_ >> 1) * 4096 + (i_ & 1) * 1024 + 512);
                    vf[i_] = (bf16x8){lo_[0], lo_[1], lo_[2], lo_[3], hh_[0], hh_[1], hh_[2], hh_[3]}; }
                if (a_) tile_step<true>(n, kf, vf, st.qA, sg.tbA, sg.tneg, sg.raLo, cm, oA0, oA1, lA);
                if (b_) tile_step<true>(n, kf, vf, st.qB, sg.tbB, sg.tneg, sg.rbLo, cm, oB0, oB1, lB);
            }
        }
        if (more) ATT_QLOADB(nxt);
        acc_block(true, oA0, oA1, lA, lds, tlocA, lane);
        acc_block(true, oB0, oB1, lB, lds, tlocB, lane);
        if (more) tbl_b(u + 1, (ui + 1) & 1, rpb, cshift, lds, tid);
        const size_t tok0 = (size_t)cur.b * 4096 + 512 * R; const int h = cur.h;
        int tidf = tid; asm volatile("" : "+v"(tidf));
        v4u gw[8]; gate_load(gw, gate + tok0 * 1024 + h * 64, tidf);
        ATT_BAR();
        final_store(gw, lds, y + tok0 * 1024 + h * 64, tidf);
        cur = nxt;
        if (ui + 2 < nu) unit_b(nxt, u + 2, qkv);
    }
    asm volatile("s_waitcnt vmcnt(0)" ::: "memory");
    ATT_BAR();
#undef ATT_ROWDMA
#undef ATT_QLOADB
}
}
constexpr int PH_OUTA = 1 + 2 * NCH, PH_INB = PH_OUTA + 1  , PH_ATTB = PH_OUTA + 2  , PH_OUTB = PH_OUTA + 1 + 2 * NCHB, NPHASE = PH_OUTB + 1;
constexpr int P0_XROWS = ((MCH / 256) * (NA_IN / 256) * 8 >= MCH && ((MCH / 256) * (NA_IN / 256)) % 256 == 0) ? MCH : MTOK;
#ifndef STAG_IN
#define STAG_IN 0
#endif
#ifndef SPLIT_WAR
#define SPLIT_WAR 1
#endif
#ifndef STAGGER_US
#define STAGGER_US 0
#endif
struct Args { const float* in[12]; float* out; unsigned char* ws; int ph_lo, ph_hi; };
__global__ void __launch_bounds__(NWAVES * 64, 2) fwd_kernel(Args args) {
    extern __shared__ __attribute__((aligned(16))) unsigned char lds[];
    Frame F;
    F.lds = (LAS unsigned char*)lds;
    F.MISC = (volatile LAS unsigned*)(F.lds + MISC_OFF);
    F.wave = __builtin_amdgcn_readfirstlane(threadIdx.x >> 6); F.lane = lane_id(); F.tid = F.wave * 64 + F.lane;
    F.G = gridDim.x; { const int bx = blockIdx.x; F.vcu = (F.G % 8 == 0) ? (bx % 8) * (F.G / 8) + bx / 8 : bx; }
    unsigned char* ws = args.ws;
    F.ctl = (gu32*)(ws + WS_CTL);
    for (int u = F.tid; u < (LDS_BYTES - LDSCTL_OFF) / 4; u += NWAVES * 64) ((LAS unsigned*)(F.lds + LDSCTL_OFF))[u] = 0u;
    __syncthreads();
    XcdBarrier bar = xcd_barrier_post((unsigned*)(F.ctl + CW_BAR), F.MISC + 8, F.wave);
    const int lo = args.ph_lo, hi = args.ph_hi;
#ifndef PROBE_REP
#define PROBE_REP (-1)
#endif
#define NREP(k) (((k) == PROBE_REP) ? 2 : 1)
#define IN(k) (lo <= (k) && (k) < hi)
#define BOTH(k) (IN(k) && IN((k) + 1))
    const float* x = args.in[0]; const float* norm_gain = args.in[1];
    bf16* XB = (bf16*)(ws + WS_XB);
    float* rstd1 = (float*)(ws + WS_RSTD1); float* part2 = (float*)(ws + WS_PART2);

_Pragma("unroll 1") for (int rep_ = 0; rep_ < NREP(0); ++rep_) {
    if (IN(0)) {
        int tid0_ = F.wave * 64 + lane_id(); asm volatile("" : "+v"(tid0_)); F.tid = tid0_; F.lane = tid0_ & 63;
        LAS float* scr = (LAS float*)(F.lds + RING_OFF + F.wave * 16384);
        const int gw = F.vcu * NWAVES + F.wave, NGW = F.G * NWAVES;
        constexpr int I_AIN = (DM / 64) * (NA_IN / 32), I_O = (DM / 64) * (DM / 32), I_BIN = (DM / 64) * (NB_IN / 32);
        constexpr int NITEMS = I_AIN + I_O + I_BIN + I_O;
        for (int it = gw; it < NITEMS; it += NGW) {
            int r = it;
            if (r < I_AIN) { p0_transpose_item(args.in[2], DM, NA_IN, (bf16*)(ws + WS_WAIN), norm_gain, scr, r, F.lane); continue; } r -= I_AIN;
            if (r < I_O) { p0_transpose_item(args.in[3], DM, DM, (bf16*)(ws + WS_WAOUT), nullptr, scr, r, F.lane); continue; } r -= I_O;
            if (r < I_BIN) { p0_transpose_item<true>(args.in[7], DM, NB_IN, (bf16*)(ws + WS_WBIN), norm_gain + DM, scr, r, F.lane); continue; } r -= I_BIN;
            p0_transpose_item(args.in[8], DM, DM, (bf16*)(ws + WS_WBOUT), nullptr, scr, r, F.lane);
        }
        for (int m0 = 4 * gw; m0 < P0_XROWS; m0 += 4 * NGW) {
            f32x4 v[4][4];
#pragma unroll
            for (int rr = 0; rr < 4; ++rr) { const GAS f32x4* xr = (const GAS f32x4*)(x + (size_t)(m0 + rr) * DM) + F.lane;
#pragma unroll
                for (int j = 0; j < 4; ++j) v[rr][j] = __builtin_nontemporal_load(xr + 64 * j); }
#pragma unroll
            for (int rr = 0; rr < 4; ++rr) {
                float s = 0.f;
#pragma unroll
                for (int j = 0; j < 4; ++j) s += (v[rr][j].x * v[rr][j].x + v[rr][j].y * v[rr][j].y) + (v[rr][j].z * v[rr][j].z + v[rr][j].w * v[rr][j].w);
                s = wave_sum(s);
                const float rstd = __builtin_amdgcn_rsqf(s * (1.0f / DM) + pg8::RMS_EPS);
                GAS v2u* o8 = (GAS v2u*)(XB + (size_t)(m0 + rr) * DM) + F.lane;
#pragma unroll
                for (int j = 0; j < 4; ++j) { v2u w; w.x = pk2(v[rr][j].x * rstd, v[rr][j].y * rstd); w.y = pk2(v[rr][j].z * rstd, v[rr][j].w * rstd); o8[64 * j] = w; }
            }
        }
        if (blockIdx.x == 0) {
            LAS float* scr0 = (LAS float*)(F.lds + RING_OFF + 8 * 16384);
            const float ca = 64.0f * QSCALE * att::wg_absmax(args.in[4], 192, scr0, F.tid) * att::wg_absmax(args.in[5], 192, scr0, F.tid) + LOG2E * att::wg_absmax(args.in[6], 48 * 32, scr0, F.tid);
            const float cb = 64.0f * QSCALE * att::wg_absmax(args.in[9], 64, scr0, F.tid) * att::wg_absmax(args.in[10], 64, scr0, F.tid) + LOG2E * att::wg_absmax(args.in[11], NH * 15 * 31, scr0, F.tid);
            if (F.tid == 0) { float* cs = (float*)(ws + WS_CSHIFT); cs[0] = ca; cs[1] = cb; }
        }
        if (BOTH(0)) xcd_barrier(bar);
    }
}

    for (int hf = 0; hf < NCH; ++hf) {
_Pragma("unroll 1") for (int rep_ = 0; rep_ < NREP(1 + 2 * hf); ++rep_) {
        if (IN(1 + 2 * hf)) {
            if (STAG_IN > 0) { const unsigned long long t0_ = __builtin_amdgcn_s_memrealtime(), dl_ = (unsigned long long)((F.vcu % 5) * STAG_IN);
                while (__builtin_amdgcn_s_memrealtime() - t0_ < dl_) __builtin_amdgcn_s_sleep(4); }
            pg8::Gemm g{XB + (size_t)hf * MCH * DM, (const bf16*)(ws + WS_WAIN), MCH, NA_IN, DM};
            pg8::StaticOrder S; S.init(MCH, NA_IN, F.G, (int)blockIdx.x);
            pg8::EpiIn<0> E{(hf + 1 < NCH) ? x + (size_t)(hf + 1) * MCH * DM : nullptr, XB + (size_t)(hf + 1) * MCH * DM, (hf + 1 < NCH) ? MCH : 0, (MCH / 256) * (NA_IN / 256) / (int)F.G,
                            (bf16*)(ws + WS_QKVA + (size_t)(hf % QKVA_NBUF) * QKVA_BUF), SECA, (bf16*)(ws + WS_GATEA + (size_t)(hf % QKVA_NBUF) * QKVA_BUF), rstd1, args.in[4], args.in[5], hf * MCH, QSCALE};
            pg8::gemm_phase<pg8::EpiIn<0>, pg8::StaticOrder, true>(F.lds + RING_OFF, g, S, E, F.wave, (SPLIT_WAR && hf > 0) ? (const unsigned*)(F.ctl + CW_WAR + 64 * (hf - 1)) : nullptr, (unsigned)F.G);
            if (BOTH(1 + 2 * hf)) xcd_barrier(bar);
        }
}

_Pragma("unroll 1") for (int rep_ = 0; rep_ < NREP(2 + 2 * hf); ++rep_) {
        if (IN(2 + 2 * hf)) {
            att::attn_a_phase(F, ((const float*)(ws + WS_CSHIFT))[0], (const bf16*)(ws + WS_QKVA + (size_t)(hf % QKVA_NBUF) * QKVA_BUF), (const bf16*)(ws + WS_GATEA + (size_t)(hf % QKVA_NBUF) * QKVA_BUF), XB + (size_t)hf * MCH * DM, args.in[6], args.in[4], args.in[5]);
            if (BOTH(2 + 2 * hf)) {
                if (SPLIT_WAR && hf < NCH - 1) { if (F.wave == 0 && lane_id() == 0) __hip_atomic_fetch_add((unsigned*)(F.ctl + CW_WAR + 64 * hf), 1u, __ATOMIC_RELAXED, __HIP_MEMORY_SCOPE_AGENT); }
                else xcd_barrier(bar);
            }
        }
}

    }
_Pragma("unroll 1") for (int rep_ = 0; rep_ < NREP(PH_OUTA); ++rep_) {
    if (IN(PH_OUTA)) {
        if (STAGGER_US > 0 && (F.vcu & 1)) { const unsigned long long t0_ = __builtin_amdgcn_s_memrealtime(); while (__builtin_amdgcn_s_memrealtime() - t0_ < (unsigned long long)STAGGER_US * 100ull) __builtin_amdgcn_s_sleep(16); }
        pg8::Gemm g{XB, (const bf16*)(ws + WS_WAOUT), MTOK, DM, DM};
        pg8::StaticOrder S; S.init(MTOK, DM, F.G, (int)blockIdx.x);
        pg8::EpiOut<true> E{x, nullptr, (bf16*)(ws + WS_X1B), part2};
        pg8::gemm_phase<pg8::EpiOut<true>, pg8::StaticOrder, true>(F.lds + RING_OFF, g, S, E, F.wave);
        if (BOTH(PH_OUTA)) xcd_barrier(bar);
    }
}

    for (int cb = 0; cb < NCHB; ++cb) {
_Pragma("unroll 1") for (int rep_ = 0; rep_ < NREP(PH_INB + 2 * cb); ++rep_) {
        if (IN(PH_INB + 2 * cb)) {
            if (STAG_IN > 0) { const unsigned long long t0_ = __builtin_amdgcn_s_memrealtime(), dl_ = (unsigned long long)((F.vcu % 5) * STAG_IN);
                while (__builtin_amdgcn_s_memrealtime() - t0_ < dl_) __builtin_amdgcn_s_sleep(4); }
            pg8::Gemm g{(const bf16*)(ws + WS_X1B) + (size_t)cb * MCHB * DM, (const bf16*)(ws + WS_WBIN), MCHB, NB_IN, DM};
            pg8::StaticOrder S; S.init(MCHB, NB_IN, F.G, (int)blockIdx.x);
            pg8::EpiIn<1> E{nullptr, nullptr, 0, 1, (bf16*)(ws + WS_QKVB), SECB, (bf16*)(ws + WS_GATEB), part2, args.in[9], args.in[10], cb * MCHB, QSCALE};
            pg8::gemm_phase<pg8::EpiIn<1>, pg8::StaticOrder, true>(F.lds + RING_OFF, g, S, E, F.wave);
            if (BOTH(PH_INB + 2 * cb)) xcd_barrier(bar);
        }
}
_Pragma("unroll 1") for (int rep_ = 0; rep_ < NREP(PH_ATTB + 2 * cb); ++rep_) {
        if (IN(PH_ATTB + 2 * cb)) {
            att::attn_b_phase(F, ((const float*)(ws + WS_CSHIFT))[1], (const bf16*)(ws + WS_QKVB), (const bf16*)(ws + WS_GATEB), XB + (size_t)cb * MCHB * DM, args.in[11], args.in[9], args.in[10]);
            if (BOTH(PH_ATTB + 2 * cb)) xcd_barrier(bar);
        }
}
    }

    if (IN(PH_OUTB)) {
        if (STAGGER_US > 0 && (F.vcu & 1)) { const unsigned long long t0_ = __builtin_amdgcn_s_memrealtime(); while (__builtin_amdgcn_s_memrealtime() - t0_ < (unsigned long long)STAGGER_US * 100ull) __builtin_amdgcn_s_sleep(16); }
        pg8::Gemm g{XB, (const bf16*)(ws + WS_WBOUT), MTOK, DM, DM};
        pg8::StaticOrder S; S.init(MTOK, DM, F.G, (int)blockIdx.x);
        pg8::EpiOut<false> E{nullptr, args.out, (bf16*)(ws + WS_X1B), nullptr};
        pg8::gemm_phase<pg8::EpiOut<false>, pg8::StaticOrder, true>(F.lds + RING_OFF, g, S, E, F.wave);
    }
#undef IN
#undef BOTH
}

extern "C" void kernel_launch(void* const* d_in, const int* in_sizes, int n_in, void* d_out, int out_size, void* d_ws, size_t ws_size, hipStream_t stream) {
    static int grid = 0;
    if (grid == 0) {
        if (n_in != 12 || in_sizes[0] != MTOK * DM || out_size != MTOK * DM || ws_size < WS_END) { fprintf(stderr, "kernel_launch: unexpected shapes / workspace (%d inputs, ws %zu)\n", n_in, ws_size); grid = -1; return; }
        int dev = 0, cus = 0, per_cu = 0;
        if (hipGetDevice(&dev) != hipSuccess || hipDeviceGetAttribute(&cus, hipDeviceAttributeMultiprocessorCount, dev) != hipSuccess) { grid = -1; return; }
        if (hipFuncSetAttribute((const void*)fwd_kernel, hipFuncAttributeMaxDynamicSharedMemorySize, LDS_BYTES) != hipSuccess) { fprintf(stderr, "kernel_launch: hipFuncSetAttribute failed\n"); grid = -1; return; }
        if (hipOccupancyMaxActiveBlocksPerMultiprocessor(&per_cu, (const void*)fwd_kernel, NWAVES * 64, LDS_BYTES) != hipSuccess || per_cu < 1) { fprintf(stderr, "kernel_launch: occupancy query says %d blocks per CU\n", per_cu); per_cu = 1; }
        (void)hipGetLastError();
        grid = cus;
    }
    if (grid < 0) return;
    (void)hipMemsetAsync((char*)d_ws + WS_CTL, 0, CTL_ZERO_BYTES, stream);
    Args a{};
    for (int i = 0; i < 12; ++i) a.in[i] = (const float*)d_in[i];
    a.out = (float*)d_out; a.ws = (unsigned char*)d_ws;
    a.ph_lo = 0; a.ph_hi = NPHASE;
    void* kargs[] = {&a};
    hipError_t e = hipLaunchCooperativeKernel((const void*)fwd_kernel, dim3(grid), dim3(NWAVES * 64), kargs, LDS_BYTES, stream);
    if (e != hipSuccess) fprintf(stderr, "kernel_launch: cooperative launch failed: %s (grid %d)\n", hipGetErrorString(e), grid);
}
```

```cpp
#define NCH_A 4
#define NCH_B 1
#include <hip/hip_runtime.h>
#include <cstdio>
#include <cstdint>
template <int CTRL> __device__ __forceinline__ float dpp_mov(float v) { return __int_as_float(__builtin_amdgcn_update_dpp(0, __float_as_int(v), CTRL, 0xF, 0xF, true)); }
__device__ __forceinline__ void swap16(float v, float& a, float& b) { auto r = __builtin_amdgcn_permlane16_swap(__float_as_uint(v), __float_as_uint(v), false, false); const unsigned r0 = r[0], r1 = r[1]; a = __uint_as_float(r0); b = __uint_as_float(r1); }
__device__ __forceinline__ void swap32(float v, float& a, float& b) { auto r = __builtin_amdgcn_permlane32_swap(__float_as_uint(v), __float_as_uint(v), false, false); const unsigned r0 = r[0], r1 = r[1]; a = __uint_as_float(r0); b = __uint_as_float(r1); }
__device__ __forceinline__ float sum_x16(float v) { float a, b; swap16(v, a, b); return a + b; }
__device__ __forceinline__ float sum_x32(float v) { float a, b; swap32(v, a, b); return a + b; }
__device__ __forceinline__ float max_x16(float v) { float a, b; swap16(v, a, b); return fmaxf(a, b); }
__device__ __forceinline__ float max_x32(float v) { float a, b; swap32(v, a, b); return fmaxf(a, b); }
__device__ __forceinline__ float wave_sum(float v) { v += dpp_mov<0xB1>(v); v += dpp_mov<0x4E>(v); v += dpp_mov<0x141>(v); v += dpp_mov<0x140>(v); v = sum_x16(v); return sum_x32(v); }
__device__ __forceinline__ float wave_max(float v) { v = fmaxf(v, dpp_mov<0xB1>(v)); v = fmaxf(v, dpp_mov<0x4E>(v)); v = fmaxf(v, dpp_mov<0x141>(v)); v = fmaxf(v, dpp_mov<0x140>(v)); v = max_x16(v); return max_x32(v); }
namespace pg8 {
#define PG8_LAS __attribute__((address_space(3)))
typedef unsigned short bf16_t;
typedef short bf16x8 __attribute__((ext_vector_type(8)));
typedef float f32x4 __attribute__((ext_vector_type(4)));
typedef unsigned u32x4 __attribute__((ext_vector_type(4)));
typedef unsigned u32x2 __attribute__((ext_vector_type(2)));
constexpr int BM = 256, BK = 64, HALF = 128, HTB = HALF * BK * 2  , STAGE_BYTES = 8 * HTB, NXCD = 8, WGM = 8;

__host__ __device__ __forceinline__ int lds_byte(int r, int c) { const int st = (r >> 4) * 2 + (c >> 5), rr = r & 15, cc = c & 31, ob = rr * 64 + cc * 2; return st * 1024 + (ob ^ (((ob >> 9) & 1) << 5)); }
__host__ __device__ __forceinline__ void stage_rc(int b, int& R, int& C) { const int st = b / 1024, sb = b % 1024, swz = sb ^ (((sb >> 9) & 1) << 5); R = (st >> 1) * 16 + swz / 64; C = (st & 1) * 32 + (swz % 64) / 2; }
__host__ __device__ __forceinline__ int perm32(int rho) { const int n = rho >> 4, i = rho & 15; return 8 * (i >> 2) + 4 * n + (i & 3); }

struct Unit { int pm, pn; };
struct Gemm { const bf16_t* A; const bf16_t* Bt; int M, N, K; };

struct StaticOrder {
    int nM, nN, nwg, G, c;
    __host__ __device__ void init(int M, int N, int G_, int c_) { nM = M / BM; nN = N / BM; nwg = nM * nN; G = G_; c = c_; }
    __host__ __device__ bool next(int i, Unit& u) const {
        const long L = (long)i * G + c; if (L >= nwg) return false;
        int wgid = (int)L; { const int q = nwg / NXCD, r = nwg % NXCD, xcd = wgid % NXCD, off = wgid / NXCD; wgid = (xcd < r ? xcd * (q + 1) : r * (q + 1) + (xcd - r) * q) + off; }
        const int nig = WGM * nN, gid = wgid / nig, fm = gid * WGM, gsz = (nM - fm) < WGM ? (nM - fm) : WGM;
        u.pm = fm + ((wgid % nig) % gsz); u.pn = (wgid % nig) / gsz; return true;
    }
};

#ifndef WT_STORES
#define WT_STORES 0
#endif
__device__ __forceinline__ void st16_wt(void* p, u32x4 v) { if (WT_STORES) asm volatile("global_store_dwordx4 %0, %1, off sc1\n\ts_nop 1" :: "v"(p), "v"(v) : "memory"); else *(u32x4*)p = v; }
__device__ __forceinline__ void st8_wt(void* p, u32x2 v) { if (WT_STORES) asm volatile("global_store_dwordx2 %0, %1, off sc1\n\ts_nop 1" :: "v"(p), "v"(v) : "memory"); else *(u32x2*)p = v; }
typedef _Float16 f16x2_t __attribute__((ext_vector_type(2)));
typedef _Float16 f16x8_t __attribute__((ext_vector_type(8)));
typedef float f32x2_t __attribute__((ext_vector_type(2)));
__device__ __forceinline__ unsigned cvt_pk_f16(float lo, float hi) { const f32x2_t v = {lo, hi}; const f16x2_t h = __builtin_convertvector(v, f16x2_t); return __builtin_bit_cast(unsigned, h); }
__device__ __forceinline__ f32x4 f16x4_to_f32(u32x2 w) { const unsigned w0 = w.x, w1 = w.y;
    const f16x2_t a = __builtin_bit_cast(f16x2_t, w0), b = __builtin_bit_cast(f16x2_t, w1); return (f32x4){(float)a[0], (float)a[1], (float)b[0], (float)b[1]}; }
__device__ __forceinline__ unsigned cvt_pk_bf16(float lo, float hi) { unsigned r; asm volatile("v_cvt_pk_bf16_f32 %0, %1, %2" : "=v"(r) : "v"(lo), "v"(hi)); return r; }


constexpr float RMS_EPS = 1e-6f;
struct NoSide { };
template <int MODE> struct EpiIn {
    static constexpr bool HEADMAP = true;
    static constexpr bool F16 = (MODE == 1);
    const float* xs; bf16_t* xd; int xrows, upc;
    struct Side { f32x4 v[4]; int row; };
    __device__ __forceinline__ void side_issue(Side& s, int ui, int c, int wid, int lane) const {
        s.row = (c * upc + ui) * 8 + wid;
        if (MODE == 0 && s.row < xrows) { const f32x4* xr = (const f32x4*)(xs + (size_t)s.row * 1024) + lane;
#pragma unroll
            for (int j = 0; j < 4; ++j) s.v[j] = __builtin_nontemporal_load(xr + 64 * j); }
    }
    __device__ __forceinline__ void side_finish(const Side& s, int lane) const {
        if (MODE == 0 && s.row < xrows) {
            float q = 0.f;
#pragma unroll
            for (int j = 0; j < 4; ++j) q += (s.v[j][0] * s.v[j][0] + s.v[j][1] * s.v[j][1]) + (s.v[j][2] * s.v[j][2] + s.v[j][3] * s.v[j][3]);
            const float rstd = __builtin_amdgcn_rsqf(wave_sum(q) * (1.0f / 1024.0f) + 1e-6f);
            const bool odd = lane & 1;
            bf16_t* orow = xd + (size_t)s.row * 1024 + 4 * (lane & ~1);
#pragma unroll
            for (int jp = 0; jp < 2; ++jp) {
                const int ja = 2 * jp, jb = 2 * jp + 1;
                const unsigned pax = cvt_pk_bf16(s.v[ja][0] * rstd, s.v[ja][1] * rstd), pay = cvt_pk_bf16(s.v[ja][2] * rstd, s.v[ja][3] * rstd);
                const unsigned pbx = cvt_pk_bf16(s.v[jb][0] * rstd, s.v[jb][1] * rstd), pby = cvt_pk_bf16(s.v[jb][2] * rstd, s.v[jb][3] * rstd);
                const unsigned rx = (unsigned)__builtin_amdgcn_update_dpp(0, (int)(odd ? pax : pbx), 0xB1, 0xF, 0xF, true), ry = (unsigned)__builtin_amdgcn_update_dpp(0, (int)(odd ? pay : pby), 0xB1, 0xF, 0xF, true);
                u32x4 w; w.x = odd ? rx : pax; w.y = odd ? ry : pay; w.z = odd ? pbx : rx; w.w = odd ? pby : ry;
                *(u32x4*)(orow + (odd ? 256 * jb : 256 * ja)) = w;
            }
        }
    }
    bf16_t* qkv; size_t sec_stride; bf16_t* gate; const float* rs; const float* qg; const float* kg; int row_base; float qscale;
    __device__ __forceinline__ void operator()(const f32x4 (&acc)[2][2][4][2], const Unit& u, int wr, int wc, int fr, int fq, const bool reuse, PG8_LAS float* rscr) const {
        const int sec = u.pn >> 2, hq = u.pn & 3, h = hq * 4 + wc;
        int type, g = 0;
        if (MODE == 0) { if (sec == 9) type = 3; else { g = sec / 3; type = sec - 3 * g; } } else type = sec;
        const int shift = (MODE == 0) ? 2 * g : 0;
        f32x4 gv[2][2];
#pragma unroll
        for (int bj = 0; bj < 2; ++bj)
#pragma unroll
            for (int n = 0; n < 2; ++n) gv[bj][n] = (f32x4){1.f, 1.f, 1.f, 1.f};
        if (type < 2) {
            const float* gp = (type == 0 ? qg : kg) + (MODE == 0 ? g * 64 : 0) + 8 * fq;
            const float sc = (type == 0) ? qscale : 1.f;
#pragma unroll
            for (int bj = 0; bj < 2; ++bj)
#pragma unroll
                for (int n = 0; n < 2; ++n) gv[bj][n] = *(const f32x4*)(gp + 32 * bj + 4 * n) * sc;
        }
        bf16_t* p0; size_t step16;
        { const int r0 = u.pm * BM + wr * 64 + fr;
          if (type < 3) { const int t = r0 & 4095, bl = r0 >> 12; const int pos = ((t & ((1 << shift) - 1)) << (12 - shift)) | (t >> shift);
              p0 = qkv + (size_t)sec * sec_stride + ((size_t)(bl * 16 + h) * 4096 + pos) * 64 + 8 * fq; step16 = (size_t)(16 >> shift) * 64; }
          else { p0 = gate + (size_t)r0 * 1024 + hq * 256 + wc * 64 + 8 * fq; step16 = (size_t)16 * 1024; } }
        float rsvv[2][4];
        if (MODE == 1) {
            PG8_LAS float* rsl = rscr + fr;
            if (reuse) {
#pragma unroll
                for (int ai = 0; ai < 2; ++ai)
#pragma unroll
                    for (int m = 0; m < 4; ++m) rsvv[ai][m] = rsl[(ai * 4 + m) * 16];
            } else {
                f32x4 rs4[2][4];
#pragma unroll
                for (int ai = 0; ai < 2; ++ai)
#pragma unroll
                    for (int m = 0; m < 4; ++m) { const int r = u.pm * BM + ai * HALF + wr * 64 + m * 16 + fr; rs4[ai][m] = *(const f32x4*)(rs + (size_t)(row_base + r) * 16 + 4 * fq); }
#pragma unroll
                for (int ai = 0; ai < 2; ++ai)
#pragma unroll
                    for (int m = 0; m < 4; ++m) { const f32x4 pp = rs4[ai][m]; float s = (pp[0] + pp[1]) + (pp[2] + pp[3]); s = sum_x16(s); s = sum_x32(s);
                        rsvv[ai][m] = __builtin_amdgcn_rsqf(s * (1.0f / 1024.0f) + RMS_EPS); if (fq == 0) rsl[(ai * 4 + m) * 16] = rsvv[ai][m]; }
            }
        }
#pragma unroll
        for (int ai = 0; ai < 2; ++ai)
#pragma unroll
            for (int m = 0; m < 4; ++m) {
                const int r = u.pm * BM + ai * HALF + wr * 64 + m * 16 + fr;
                const float rsv = (MODE == 0) ? 1.0f : rsvv[ai][m];
                f32x4 v[2][2];
#pragma unroll
                for (int bj = 0; bj < 2; ++bj)
#pragma unroll
                    for (int n = 0; n < 2; ++n) v[bj][n] = acc[ai][bj][m][n] * rsv;
                if (type < 2) {
                    float ss = 0.f;
#pragma unroll
                    for (int bj = 0; bj < 2; ++bj)
#pragma unroll
                        for (int n = 0; n < 2; ++n) { const f32x4 x = v[bj][n]; ss += (x[0] * x[0] + x[1] * x[1]) + (x[2] * x[2] + x[3] * x[3]); }
                    ss = sum_x16(ss); ss = sum_x32(ss);
                    const float inv = __builtin_amdgcn_rsqf(ss * (1.0f / 64.0f) + RMS_EPS);
#pragma unroll
                    for (int bj = 0; bj < 2; ++bj)
#pragma unroll
                        for (int n = 0; n < 2; ++n) v[bj][n] = v[bj][n] * gv[bj][n] * inv;
                }
                bf16_t* p = p0 + (size_t)(8 * ai + m) * step16;
#pragma unroll
                for (int bj = 0; bj < 2; ++bj) { u32x4 w; w.x = cvt_pk_bf16(v[bj][0][0], v[bj][0][1]); w.y = cvt_pk_bf16(v[bj][0][2], v[bj][0][3]); w.z = cvt_pk_bf16(v[bj][1][0], v[bj][1][1]); w.w = cvt_pk_bf16(v[bj][1][2], v[bj][1][3]);
                    st16_wt(p + 32 * bj, w); }
            }
    }
};

template <bool FIRST> struct EpiOut {
    static constexpr bool HEADMAP = false;
    static constexpr bool F16 = false;
    struct Side { };
    __device__ __forceinline__ void side_issue(Side&, int, int, int, int) const {}
    __device__ __forceinline__ void side_finish(const Side&, int) const {}
    const float* base; float* out; bf16_t* xh; float* part;
    static __device__ __forceinline__ void swap2(unsigned a, unsigned b, unsigned& ra, unsigned& rb) { auto r = __builtin_amdgcn_permlane16_swap(a, b, false, false); const unsigned r0 = r[0], r1 = r[1]; ra = r0; rb = r1; }
    __device__ __forceinline__ void operator()(const f32x4 (&acc)[2][2][4][2], const Unit& u, int wr, int wc, int fr, int fq, bool, PG8_LAS float*) const {
        f32x4 pre[FIRST ? 4 : 1][2][2]; u32x4 preh[FIRST ? 1 : 4][2]; float ssq[8];
        const size_t off0 = (size_t)(u.pm * BM + wr * 64 + fr) * 1024 + u.pn * BM + wc * 32 + 4 * fq;
        const size_t offw = off0 + ((fq & 1) ? 12 : 0);
#define EPO_ROW(rg) ((size_t)(((rg) >> 2) * HALF + ((rg) & 3) * 16) * 1024)
#define EPO_LOAD(rg) do { _Pragma("unroll") for (int bj = 0; bj < 2; ++bj) { \
            if (FIRST) { _Pragma("unroll") for (int n = 0; n < 2; ++n) pre[(rg) & 3][bj][n] = *(const f32x4*)(base + off0 + EPO_ROW(rg) + bj * HALF + n * 16); } \
            else preh[(rg) & 3][bj] = *(const u32x4*)(xh + offw + EPO_ROW(rg) + bj * HALF); } } while (0)
        EPO_LOAD(0); EPO_LOAD(1); EPO_LOAD(2); EPO_LOAD(3);
#pragma unroll
        for (int rg = 0; rg < 8; ++rg) {
            const int ai = rg >> 2, m = rg & 3;
            float ss = 0.f;
#pragma unroll
            for (int bj = 0; bj < 2; ++bj) {
                f32x4 p0, p1;
                if (FIRST) { p0 = pre[rg & 3][bj][0]; p1 = pre[rg & 3][bj][1]; }
                else { const u32x4 L = preh[rg & 3][bj]; const unsigned lx = L.x, ly = L.y, lz = L.z, lw = L.w; u32x2 X, Y; unsigned a0, b0, a1, b1; swap2(lx, lz, a0, b0); swap2(ly, lw, a1, b1);
                       X.x = a0; X.y = a1; Y.x = b0; Y.y = b1; p0 = f16x4_to_f32(X); p1 = f16x4_to_f32(Y); }
                const f32x4 o0 = p0 + acc[ai][bj][m][0], o1 = p1 + acc[ai][bj][m][1];
                if (FIRST) {
                    const unsigned x0 = cvt_pk_f16(o0[0], o0[1]), x1 = cvt_pk_f16(o0[2], o0[3]), y0 = cvt_pk_f16(o1[0], o1[1]), y1 = cvt_pk_f16(o1[2], o1[3]);
                    unsigned a0, b0, a1, b1; swap2(x0, y0, a0, b0); swap2(x1, y1, a1, b1);
                    u32x4 w; w.x = a0; w.y = a1; w.z = b0; w.w = b1;
                    st16_wt(xh + offw + EPO_ROW(rg) + bj * HALF, w);
                    ss += ((o0[0] * o0[0] + o0[1] * o0[1]) + (o0[2] * o0[2] + o0[3] * o0[3])) + ((o1[0] * o1[0] + o1[1] * o1[1]) + (o1[2] * o1[2] + o1[3] * o1[3]));
                } else {
                    st16_wt(out + off0 + EPO_ROW(rg) + bj * HALF, __builtin_bit_cast(u32x4, o0));
                    st16_wt(out + off0 + EPO_ROW(rg) + bj * HALF + 16, __builtin_bit_cast(u32x4, o1));
                }
            }
            if (rg + 4 < 8) EPO_LOAD(rg + 4);
            if (FIRST) { ss = sum_x16(ss); ss = sum_x32(ss); ssq[rg] = ss; }
        }
        if (FIRST) {
#pragma unroll
            for (int hh = 0; hh < 2; ++hh) {
                const float v = (fq == 0) ? ssq[4 * hh] : (fq == 1) ? ssq[4 * hh + 1] : (fq == 2) ? ssq[4 * hh + 2] : ssq[4 * hh + 3];
                const int r = u.pm * BM + hh * HALF + wr * 64 + fq * 16 + fr;
                part[(size_t)r * 16 + u.pn * 4 + wc] = v;
            }
        }
#undef EPO_ROW
#undef EPO_LOAD
    }
};

template <class Epi, class Sched, bool ALIGN_EPI>
__device__ __forceinline__ void gemm_phase(PG8_LAS unsigned char* lds, const Gemm g, const Sched& S, const Epi& E, const int wave_, const unsigned* war_cnt = nullptr, const unsigned war_need = 0u) {
    int lane_; asm volatile("v_mbcnt_lo_u32_b32 %0, -1, 0\n\tv_mbcnt_hi_u32_b32 %0, -1, %0" : "=v"(lane_)); const int tid_ = wave_ * 64 + lane_;
    const int tid = tid_, wid = __builtin_amdgcn_readfirstlane(tid >> 6), lane = tid & 63, wr = wid >> 2, wc = wid & 3, fr = lane & 15, fq = lane >> 4;
    const int K = g.K, nt = K / BK;
    unsigned voffA[2], voffB[2];
#pragma unroll
    for (int i = 0; i < 2; ++i) { int R, C; stage_rc(tid * 16 + i * 8192, R, C);
        const int Rb = Epi::HEADMAP ? (64 * (R >> 5) + perm32(R & 31)) : R;
        voffA[i] = (unsigned)(R * K + C) * 2u; voffB[i] = (unsigned)(Rb * K + C) * 2u; }
    const size_t kstep = (size_t)(BK * 2);
    const size_t hstep = (size_t)HALF * K * 2;
    const size_t hstepB = Epi::HEADMAP ? (size_t)32 * K * 2 : hstep;
    const size_t tstep = 2 * hstep;
    const unsigned ldsw = (unsigned)wid * 1024u;
    const int aoff = lds_byte(wr * 64 + fr, fq * 8), boff = lds_byte(wc * 32 + fr, fq * 8);
#define PG8_SA(b, h) (((b) * 2 + (h)) * HTB)
#define PG8_SB(b, h) ((4 + (b) * 2 + (h)) * HTB)
#define PG8_STAGE(bufoff, gbase, voff) do { _Pragma("unroll") for (int _i = 0; _i < 2; ++_i) \
        __builtin_amdgcn_global_load_lds((const unsigned*)((const char*)(gbase) + (voff)[_i]), (PG8_LAS unsigned*)(lds + (bufoff) + ldsw + _i * 8192), 16, 0, 0); } while (0)
#define PG8_LDA(dst, b, h) do { _Pragma("unroll") for (int m = 0; m < 4; ++m) _Pragma("unroll") for (int k = 0; k < 2; ++k) dst[m][k] = *(const PG8_LAS bf16x8*)(lds + PG8_SA(b, h) + aoff + m * 2048 + k * 1024); } while (0)
#define PG8_LDB(dst, b, h) do { _Pragma("unroll") for (int n = 0; n < 2; ++n) _Pragma("unroll") for (int k = 0; k < 2; ++k) dst[n][k] = *(const PG8_LAS bf16x8*)(lds + PG8_SB(b, h) + boff + n * 2048 + k * 1024); } while (0)
#define PG8_MMA(ai, bj, At, Bt) do { __builtin_amdgcn_s_setprio(1); _Pragma("unroll") for (int m = 0; m < 4; ++m) _Pragma("unroll") for (int n = 0; n < 2; ++n) _Pragma("unroll") for (int k = 0; k < 2; ++k) \
        acc[ai][bj][m][n] = Epi::F16 ? __builtin_amdgcn_mfma_f32_16x16x32_f16(__builtin_bit_cast(f16x8_t, Bt[n][k]), __builtin_bit_cast(f16x8_t, At[m][k]), acc[ai][bj][m][n], 0, 0, 0) \
                                     : __builtin_amdgcn_mfma_f32_16x16x32_bf16(Bt[n][k], At[m][k], acc[ai][bj][m][n], 0, 0, 0); __builtin_amdgcn_s_setprio(0); } while (0)
#define PG8_WAIT_V(n) asm volatile("s_waitcnt vmcnt(" #n ")" ::: "memory")
#define PG8_WAIT_L(n) asm volatile("s_waitcnt lgkmcnt(" #n ")" ::: "memory")
#define PG8_BAR __builtin_amdgcn_s_barrier()
#define PG8_SCHED __builtin_amdgcn_sched_barrier(0)
    Unit cur, nxt; int ui = 0; int prev_pm = -1;
    if (!S.next(0, cur)) return;
    f32x4 acc[2][2][4][2];
#pragma unroll
    for (int a = 0; a < 2; ++a)
#pragma unroll
        for (int b = 0; b < 2; ++b)
#pragma unroll
            for (int m = 0; m < 4; ++m)
#pragma unroll
                for (int n = 0; n < 2; ++n) acc[a][b][m][n] = (f32x4){0.f, 0.f, 0.f, 0.f};
    bf16x8 At[4][2], B0[2][2], B1[2][2];
    const char* cA = (const char*)g.A + (size_t)cur.pm * tstep; const char* cB = (const char*)g.Bt + (size_t)cur.pn * tstep;
    PG8_STAGE(PG8_SB(0, 0), cB, voffB); PG8_STAGE(PG8_SB(0, 1), cB + hstepB, voffB); PG8_STAGE(PG8_SA(0, 0), cA, voffA); PG8_STAGE(PG8_SA(0, 1), cA + hstep, voffA);
    if (wr == 1) PG8_BAR;
    PG8_WAIT_V(2); PG8_BAR;
    PG8_STAGE(PG8_SB(1, 0), cB + kstep, voffB); PG8_STAGE(PG8_SA(1, 0), cA + kstep, voffA); PG8_STAGE(PG8_SB(1, 1), cB + hstepB + kstep, voffB);
    PG8_WAIT_V(6); PG8_BAR;
    for (;;) {
        const bool has_next = S.next(ui + 1, nxt);
        const char* nA = has_next ? (const char*)g.A + (size_t)nxt.pm * tstep : cA; const char* nB = has_next ? (const char*)g.Bt + (size_t)nxt.pn * tstep : cB;
        for (int t = 0; t < nt; t += 2) {
            const bool last = (t == nt - 2);
            const char* a1 = cA + (size_t)(t + 1) * kstep;
            const char* a2 = last ? nA : cA + (size_t)(t + 2) * kstep; const char* b2 = last ? nB : cB + (size_t)(t + 2) * kstep;
            const char* a3 = a2 + kstep; const char* b3 = b2 + kstep;
            PG8_LDB(B0, 0, 0); PG8_LDB(B1, 0, 1); PG8_SCHED; PG8_LDA(At, 0, 0); PG8_STAGE(PG8_SA(1, 1), a1 + hstep, voffA);
            PG8_WAIT_V(8); PG8_WAIT_L(0); PG8_BAR; PG8_MMA(0, 0, At, B0); PG8_MMA(0, 1, At, B1); PG8_BAR; PG8_SCHED;
            PG8_LDA(At, 0, 1); PG8_STAGE(PG8_SB(0, 0), b2, voffB); PG8_STAGE(PG8_SB(0, 1), b2 + hstepB, voffB); PG8_STAGE(PG8_SA(0, 0), a2, voffA);
            PG8_WAIT_V(8); PG8_WAIT_L(0); PG8_BAR; PG8_MMA(1, 0, At, B0); PG8_MMA(1, 1, At, B1); PG8_BAR; PG8_SCHED;
            PG8_LDB(B0, 1, 0); PG8_LDB(B1, 1, 1); PG8_SCHED; PG8_LDA(At, 1, 0); PG8_STAGE(PG8_SA(0, 1), a2 + hstep, voffA);
            PG8_WAIT_V(8); PG8_WAIT_L(0); PG8_BAR; PG8_MMA(0, 0, At, B0); PG8_MMA(0, 1, At, B1); PG8_BAR; PG8_SCHED;
            PG8_LDA(At, 1, 1); PG8_STAGE(PG8_SB(1, 0), b3, voffB); PG8_STAGE(PG8_SB(1, 1), b3 + hstepB, voffB); PG8_STAGE(PG8_SA(1, 0), a3, voffA);
            PG8_WAIT_V(8); PG8_WAIT_L(0); PG8_BAR; PG8_MMA(1, 0, At, B0); PG8_MMA(1, 1, At, B1); PG8_BAR; PG8_SCHED;
        }
        if constexpr (ALIGN_EPI) { if (wr == 0) PG8_BAR; }
        if (war_cnt && ui == 0) { unsigned sp_ = 0; while (__hip_atomic_load(war_cnt, __ATOMIC_RELAXED, __HIP_MEMORY_SCOPE_AGENT) < war_need && ++sp_ < (1u << 22)) __builtin_amdgcn_s_sleep(2); }
        typename Epi::Side side_; E.side_issue(side_, ui, S.c, wid, lane);
        { const bool reuse_ = (cur.pm == prev_pm); prev_pm = cur.pm; E(acc, cur, wr, wc, fr, fq, reuse_, (PG8_LAS float*)(lds + 131072) + wid * 128); }
        E.side_finish(side_, lane);
        if (!has_next) break;
#pragma unroll
        for (int a = 0; a < 2; ++a)
#pragma unroll
            for (int b = 0; b < 2; ++b)
#pragma unroll
                for (int m = 0; m < 4; ++m)
#pragma unroll
                    for (int n = 0; n < 2; ++n) acc[a][b][m][n] = (f32x4){0.f, 0.f, 0.f, 0.f};
        cur = nxt; cA = nA; cB = nB; ++ui;
        if constexpr (ALIGN_EPI) { if (wr == 1) PG8_BAR; }
    }
    PG8_WAIT_V(0);
    if constexpr (!ALIGN_EPI) { if (wr == 0) PG8_BAR; }
    PG8_BAR;
#undef PG8_SA
#undef PG8_SB
#undef PG8_STAGE
#undef PG8_LDA
#undef PG8_LDB
#undef PG8_MMA
#undef PG8_WAIT_V
#undef PG8_WAIT_L
#undef PG8_BAR
#undef PG8_SCHED
}
}
constexpr int NWAVES = 8;
constexpr int BATCH = 8, SEQ = 4096, DM = 1024, NH = 16, HD = 64;
constexpr int MTOK = BATCH * SEQ;
#ifndef NCH_A
#define NCH_A 2
#endif
constexpr int NCH = NCH_A;
constexpr int MCH = MTOK / NCH, BCH = BATCH / NCH;
#ifndef NCH_B
#define NCH_B 1
#endif
constexpr int NCHB = NCH_B;
constexpr int MCHB = MTOK / NCHB, BCHB = BATCH / NCHB;
constexpr int NA_IN = 10240, NB_IN = 4096;
constexpr float LOG2E = 1.4426950408889634f;
constexpr float QSCALE = 0.125f * LOG2E;

constexpr size_t MiB = 1u << 20;
constexpr size_t WS_CTL = 0, CTL_ZERO_BYTES = 64 * 1024;
constexpr size_t WS_CSHIFT = 1 * MiB + 512 * 1024;
constexpr size_t WS_RSTD1 = 1 * MiB;
constexpr size_t WS_PART2 = 2 * MiB;
constexpr size_t WS_WAIN = 4 * MiB, WS_WAOUT = 24 * MiB, WS_WBIN = 26 * MiB, WS_WBOUT = 34 * MiB;
constexpr size_t WS_XB = 36 * MiB;
constexpr size_t WS_QKVA = 100 * MiB;
constexpr size_t SECA = (size_t)BCH * NH * SEQ * HD;
constexpr size_t WS_GATEA = WS_QKVA + 9 * SECA * 2;
constexpr size_t QKVA_BUF = 10 * SECA * 2;
constexpr int QKVA_NBUF = 1;
constexpr size_t WS_X1B = 100 * MiB;
constexpr size_t WS_QKVB = 164 * MiB;
constexpr size_t SECB = (size_t)BCHB * NH * SEQ * HD;
constexpr size_t WS_GATEB = WS_QKVB + 3 * SECB * 2;
constexpr size_t WS_END = 420 * MiB;
static_assert(WS_QKVA + (size_t)QKVA_NBUF * QKVA_BUF <= WS_END && WS_GATEB + (size_t)MCHB * DM * 2 <= WS_END && WS_X1B + 64 * MiB <= WS_QKVB, "ws map");
constexpr int CW_BAR = 4096;
constexpr int CW_WAR = 8192;

constexpr int RING_OFF = 0, RING_BYTES = 131072;
constexpr int PHASE_LDS = 155648;
constexpr int LDSCTL_OFF = PHASE_LDS, MISC_OFF = LDSCTL_OFF + 320;
constexpr int LDS_BYTES = 159744;

#define GAS __attribute__((address_space(1)))
#define LAS __attribute__((address_space(3)))
typedef unsigned short bf16;
typedef unsigned v4u __attribute__((ext_vector_type(4)));
typedef unsigned v2u __attribute__((ext_vector_type(2)));
typedef float f32x4 __attribute__((ext_vector_type(4)));
typedef short bf16x8 __attribute__((ext_vector_type(8)));
typedef GAS unsigned gu32;
#define RLX_AGENT __ATOMIC_RELAXED, __HIP_MEMORY_SCOPE_AGENT
#define LDS_WAIT() asm volatile("s_waitcnt lgkmcnt(0)" ::: "memory")
#define VM_WAIT() asm volatile("s_waitcnt vmcnt(0)" ::: "memory")
__device__ __forceinline__ unsigned f2bf(float f) { unsigned u = __builtin_bit_cast(unsigned, f); return (u + 0x7fffu + ((u >> 16) & 1u)) >> 16; }
__device__ __forceinline__ unsigned pk2(float lo, float hi) { return f2bf(lo) | (f2bf(hi) << 16); }
__device__ __forceinline__ float bf2f(unsigned short h) { return __builtin_bit_cast(float, (unsigned)h << 16); }

__device__ __forceinline__ int lane_id() { int l; asm volatile("v_mbcnt_lo_u32_b32 %0, -1, 0\n\tv_mbcnt_hi_u32_b32 %0, -1, %0" : "=v"(l)); return l; }
#define XB_TMO      128
#define XB_XCNT(j)  (256  + 64 * (j))
#define XB_XSUB(j)  (1280 + 64 * (j))
#define XB_XGEN(j)  (2304 + 64 * (j))
#define XB_TOP      3328
#define XB_TOPGEN   3392
#define XCD_BAR_WORDS 3456
#define XB_SPIN_CAP (1u << 18)
__device__ __forceinline__ unsigned xb_ld(unsigned* p)              { return __hip_atomic_load(p, __ATOMIC_RELAXED, __HIP_MEMORY_SCOPE_AGENT); }
__device__ __forceinline__ unsigned xb_add(unsigned* p, unsigned v) { return __hip_atomic_fetch_add(p, v, __ATOMIC_RELAXED, __HIP_MEMORY_SCOPE_AGENT); }
__device__ __forceinline__ unsigned xb_xcc_id() { return (unsigned)__builtin_amdgcn_s_getreg((3 << 11) | 20) & 0xFu; }
#define XB_SPIN(cond, bar) do { unsigned _sp = 0; while (cond) { __builtin_amdgcn_s_sleep(1); \
    if ((++_sp & 255u) == 0u) { if (xb_ld(&(bar)[XB_TMO])) break; if (_sp > XB_SPIN_CAP) { atomicAdd(&(bar)[XB_TMO], 1u); break; } } } } while (0)
struct XcdBarrier { unsigned* bar; unsigned x; volatile LAS unsigned* st; int wave; };
__device__ __forceinline__ XcdBarrier xcd_barrier_post(unsigned* bar, volatile LAS unsigned* st, int wave) {
    XcdBarrier b; b.bar = bar; b.x = xb_xcc_id(); b.st = st; b.wave = wave;
    if (wave == 0 && lane_id() == 0) (void)xb_add(&bar[XB_XCNT(b.x)], 1u);
    return b;
}
__device__ __forceinline__ void xcd_barrier_complete(unsigned* bar, unsigned x, unsigned& nloc, unsigned& nx) {
    const unsigned G = gridDim.x * gridDim.y * gridDim.z;
    unsigned sum, cnt, mine, sp = 0u;
    for (;;) {
        sum = 0u; cnt = 0u; mine = 0u;
#pragma unroll
        for (unsigned j = 0; j < 16; ++j) { const unsigned c = xb_ld(&bar[XB_XCNT(j)]); sum += c; cnt += (c > 0u) ? 1u : 0u; mine = (j == x) ? c : mine; }
        if (sum == G) break;
        __builtin_amdgcn_s_sleep(1);
        if ((++sp & 255u) == 0u) { if (xb_ld(&bar[XB_TMO])) break; if (sp > XB_SPIN_CAP) { atomicAdd(&bar[XB_TMO], 1u); break; } }
    }
    nloc = mine > 0u ? mine : 1u; nx = cnt > 0u ? cnt : 1u;
}
__device__ __forceinline__ void xcd_barrier(const XcdBarrier& b) {
    asm volatile("s_waitcnt vmcnt(0)" ::: "memory");
    __syncthreads();
    if (b.wave == 0 && lane_id() == 0) {
        unsigned* bar = b.bar; asm volatile("" : "+s"(bar));
        __builtin_amdgcn_s_waitcnt(0);
        unsigned nloc = b.st[0], nx = b.st[1];
        if (nloc == 0u) { xcd_barrier_complete(bar, b.x, nloc, nx); b.st[0] = nloc; b.st[1] = nx; }
        const unsigned old = xb_add(&bar[XB_XSUB(b.x)], 1u);
        const unsigned gen = old / nloc;
        if (old + 1u == (gen + 1u) * nloc) {
            __builtin_amdgcn_fence(__ATOMIC_RELEASE, "agent");
            asm volatile("s_waitcnt vmcnt(0)" ::: "memory");
            const unsigned og = xb_add(&bar[XB_TOP], 1u);
            const unsigned tg = og / nx;
            if (og + 1u == (tg + 1u) * nx) xb_add(&bar[XB_TOPGEN], 1u);
            else XB_SPIN(xb_ld(&bar[XB_TOPGEN]) == tg, bar);
            __builtin_amdgcn_fence(__ATOMIC_ACQUIRE, "agent");
            xb_add(&bar[XB_XGEN(b.x)], 1u);
            asm volatile("s_waitcnt vmcnt(0)" ::: "memory");
        } else {
            XB_SPIN(xb_ld(&bar[XB_XGEN(b.x)]) == gen, bar);
            __builtin_amdgcn_fence(__ATOMIC_ACQUIRE, "agent");
            asm volatile("s_waitcnt vmcnt(0)" ::: "memory");
        }
    }
    __syncthreads();
}

struct Frame {
    LAS unsigned char* lds;
    volatile LAS unsigned* MISC;
    gu32* ctl;
    int tid, lane, wave, vcu, G;
};

template <bool F16 = false>
__device__ __forceinline__ void p0_transpose_item(const float* W, int K, int N, bf16* WT, const float* gk, LAS float* scr, int item, int lane) {
    const int nblk = N / 32, kb = item / nblk, nb = item % nblk, k0 = 64 * kb, n0 = 32 * nb;
    float wv[32];
#pragma unroll
    for (int i = 0; i < 32; ++i) { const int kk = 2 * i + (lane >> 5); wv[i] = __builtin_nontemporal_load(W + (size_t)(k0 + kk) * N + n0 + (lane & 31)); }
#pragma unroll
    for (int i = 0; i < 32; ++i) { const int kk = 2 * i + (lane >> 5); const float gsc = gk ? gk[k0 + kk] : 1.0f; scr[kk * 33 + (lane & 31)] = wv[i] * gsc; }
    LDS_WAIT(); asm volatile("" ::: "memory");
    const int c = lane & 7;
#pragma unroll
    for (int j = 0; j < 4; ++j) { const int n = (lane >> 3) + 8 * j; const LAS float* s = scr + (8 * c) * 33 + n;
        v4u o;
        if (F16) { o.x = pg8::cvt_pk_f16(s[0 * 33], s[1 * 33]); o.y = pg8::cvt_pk_f16(s[2 * 33], s[3 * 33]); o.z = pg8::cvt_pk_f16(s[4 * 33], s[5 * 33]); o.w = pg8::cvt_pk_f16(s[6 * 33], s[7 * 33]); }
        else { o.x = pk2(s[0 * 33], s[1 * 33]); o.y = pk2(s[2 * 33], s[3 * 33]); o.z = pk2(s[4 * 33], s[5 * 33]); o.w = pk2(s[6 * 33], s[7 * 33]); }
        *(GAS v4u*)(WT + (size_t)(n0 + n) * K + k0 + 8 * c) = o; }
    LDS_WAIT(); asm volatile("" ::: "memory");
}
__device__ __forceinline__ int t5_bucket_dev(int rel) {
    const int n = rel < 0 ? -rel : rel;
    const int b = n < 8 ? n : 8 + (n >= 15) + (n >= 27) + (n >= 50) + (n >= 91) + (n >= 167) + (n >= 305) + (n >= 559);
    return b + (rel > 0 ? 16 : 0);
}
namespace att {
typedef float f32x16 __attribute__((ext_vector_type(16)));
typedef short s16x4 __attribute__((ext_vector_type(4)));
typedef short v4i16_t __attribute__((ext_vector_type(4)));
typedef float f32x2_t __attribute__((ext_vector_type(2)));
typedef __bf16 bf16x2_t __attribute__((ext_vector_type(2)));
constexpr float NEG = -1e30f;
constexpr int ACC_PITCH = 136;
constexpr int ACC_OFF = 0, LACC_OFF = 512 * ACC_PITCH, TBL_OFF = LACC_OFF + 2048, TBL_BYTES = 4096  , SCR_OFF = TBL_OFF + 2 * TBL_BYTES, VST_OFF = SCR_OFF + 256, STAGE_BYTES = 8192, LDS_END = VST_OFF + 8 * STAGE_BYTES;
static_assert(VST_OFF % 16 == 0 && LDS_END <= PHASE_LDS, "attention LDS map");
__device__ __forceinline__ int rho(int t) { return t ^ ((t >> 5) & 15); }
__device__ __forceinline__ unsigned cvtpk(float lo, float hi) { f32x2_t v = {lo, hi}; bf16x2_t b = __builtin_convertvector(v, bf16x2_t); return __builtin_bit_cast(unsigned, b); }
__device__ __forceinline__ s16x4 vtr(const LAS char* p) { return __builtin_bit_cast(s16x4, __builtin_amdgcn_ds_read_tr16_b64_v4i16((LAS v4i16_t*)p)); }

struct Seg {
    const bf16* qA; const bf16* qB;
    const bf16* kt; const bf16* vt;
    const LAS char* tbA; const LAS char* tbB; const LAS char* tneg;
    int tstride, nt, aHi, bLo, bHi;
    int raLo, rbLo;
    int tlocA, tlocB;
    int first, dual;
};
struct St { bf16x8 qA[4], qB[4]; };
struct Lay { unsigned kOffE, kOffO, vOff; int rdK[4]; int vrd; };
__device__ __forceinline__ void lay_init(Lay& L, int lane) {
    const int l3 = (lane >> 3) & 1, l4 = (lane >> 4) & 1, l5 = (lane >> 5) & 1, c7 = lane & 7;
    const unsigned rows = 1024u * l3 + 512u * l5 + 256u * l4;
    L.kOffE = rows + 16u * (unsigned)(c7 ^ (4 * l5 + 2 * l4));
    L.kOffO = rows + 128u + 16u * (unsigned)(c7 ^ (4 * l5 + 2 * l4 + 1));
    L.vOff = (unsigned)((lane >> 2) * 128 + (lane & 3) * 16);
    const int r32 = lane & 31, hi = lane >> 5, kp = (r32 & ~9) | ((r32 & 1) << 3) | ((r32 >> 3) & 1), m = r32 & 7;
#pragma unroll
    for (int d0 = 0; d0 < 4; ++d0) L.rdK[d0] = 128 * kp + 16 * ((2 * d0 + hi) ^ m);
    L.vrd = 4096 + ((lane >> 4) & 1) * 32 + (lane & 3) * 8 + (4 * hi + ((lane & 15) >> 2)) * 64;
}
#define ATT_GLDS(g, l) __builtin_amdgcn_global_load_lds((const unsigned*)(g), (LAS unsigned*)(l), 16, 0, 0)
__device__ __forceinline__ void dma_tile(const bf16* kt, const bf16* vt, LAS char* stage, const Lay& L) {
    const char* kb = (const char*)kt; const char* vb = (const char*)vt + L.vOff;
    ATT_GLDS(kb + L.kOffE, stage); ATT_GLDS(kb + L.kOffO, stage + 1024); ATT_GLDS(kb + L.kOffE + 2048, stage + 2048); ATT_GLDS(kb + L.kOffO + 2048, stage + 3072);
    ATT_GLDS(vb, stage + 4096); ATT_GLDS(vb + 2048, stage + 5120); ATT_GLDS(vb + 64, stage + 6144); ATT_GLDS(vb + 2048 + 64, stage + 7168);
}
__device__ __forceinline__ void seg_start(const Seg& s, St& st, int lane) {
    const int hi = lane >> 5;
#pragma unroll
    for (int d0 = 0; d0 < 4; ++d0) { st.qA[d0] = *(const bf16x8*)(s.qA + d0 * 16 + hi * 8); st.qB[d0] = *(const bf16x8*)(s.qB + d0 * 16 + hi * 8); }
}
template <bool CM>
__device__ __forceinline__ void cinit(f32x16& p, const LAS char* tb, const LAS char* tneg, int t, int rlo, const float (&cm)[16]) {
    const LAS char* ta = tb + 128 * t;
    if (CM) ta = ((unsigned)(t - rlo) < 8u) ? ta : tneg;
#pragma unroll
    for (int r = 0; r < 16; ++r) { p[r] = *(const LAS float*)(ta + 4 * ((r & 3) + 8 * (r >> 2))); if (CM) p[r] += cm[r]; }
}
__device__ __forceinline__ void softmax_pack(f32x16& p, float& lsum, bf16x8& pf0, bf16x8& pf1) {
#pragma unroll
    for (int r = 0; r < 16; ++r) { p[r] = __builtin_amdgcn_exp2f(p[r]); lsum += p[r]; }
    v4u pk0, pk1;
    pk0.x = cvtpk(p[0], p[1]); pk0.y = cvtpk(p[2], p[3]); pk0.z = cvtpk(p[4], p[5]); pk0.w = cvtpk(p[6], p[7]);
    pk1.x = cvtpk(p[8], p[9]); pk1.y = cvtpk(p[10], p[11]); pk1.z = cvtpk(p[12], p[13]); pk1.w = cvtpk(p[14], p[15]);
    pf0 = __builtin_bit_cast(bf16x8, pk0); pf1 = __builtin_bit_cast(bf16x8, pk1);
}
template <bool CM>
__device__ __forceinline__ void tile_step(int t, const bf16x8 (&kf)[4], const bf16x8 (&vf)[4], const bf16x8 (&q)[4], const LAS char* tb, const LAS char* tneg, int rlo,
                                          const float (&cm)[16], f32x16& o0, f32x16& o1, float& lsum) {
    f32x16 p; cinit<CM>(p, tb, tneg, t, rlo, cm);
#pragma unroll
    for (int d0 = 0; d0 < 4; ++d0) p = __builtin_amdgcn_mfma_f32_32x32x16_bf16(kf[d0], q[d0], p, 0, 0, 0);
    bf16x8 pf0, pf1; softmax_pack(p, lsum, pf0, pf1);
    o0 = __builtin_amdgcn_mfma_f32_32x32x16_bf16(vf[0], pf0, o0, 0, 0, 0);
    o0 = __builtin_amdgcn_mfma_f32_32x32x16_bf16(vf[1], pf1, o0, 0, 0, 0);
    o1 = __builtin_amdgcn_mfma_f32_32x32x16_bf16(vf[2], pf0, o1, 0, 0, 0);
    o1 = __builtin_amdgcn_mfma_f32_32x32x16_bf16(vf[3], pf1, o1, 0, 0, 0);
}
template <bool CM>
__device__ __forceinline__ void tile_step2(int t, const bf16x8 (&kf)[4], const bf16x8 (&vf)[4], const St& st, const Seg& s, const float (&cm)[16],
                                           f32x16& oA0, f32x16& oA1, float& lA, f32x16& oB0, f32x16& oB1, float& lB) {
    f32x16 pA, pB; cinit<CM>(pA, s.tbA, s.tneg, t, s.raLo, cm); cinit<CM>(pB, s.tbB, s.tneg, t, s.rbLo, cm);
#pragma unroll
    for (int d0 = 0; d0 < 4; ++d0) pA = __builtin_amdgcn_mfma_f32_32x32x16_bf16(kf[d0], st.qA[d0], pA, 0, 0, 0);
#pragma unroll
    for (int d0 = 0; d0 < 4; ++d0) pB = __builtin_amdgcn_mfma_f32_32x32x16_bf16(kf[d0], st.qB[d0], pB, 0, 0, 0);
    bf16x8 pf0, pf1; softmax_pack(pA, lA, pf0, pf1);
    oA0 = __builtin_amdgcn_mfma_f32_32x32x16_bf16(vf[0], pf0, oA0, 0, 0, 0);
    oA0 = __builtin_amdgcn_mfma_f32_32x32x16_bf16(vf[1], pf1, oA0, 0, 0, 0);
    oA1 = __builtin_amdgcn_mfma_f32_32x32x16_bf16(vf[2], pf0, oA1, 0, 0, 0);
    oA1 = __builtin_amdgcn_mfma_f32_32x32x16_bf16(vf[3], pf1, oA1, 0, 0, 0);
    bf16x8 pg0, pg1; softmax_pack(pB, lB, pg0, pg1);
    oB0 = __builtin_amdgcn_mfma_f32_32x32x16_bf16(vf[0], pg0, oB0, 0, 0, 0);
    oB0 = __builtin_amdgcn_mfma_f32_32x32x16_bf16(vf[1], pg1, oB0, 0, 0, 0);
    oB1 = __builtin_amdgcn_mfma_f32_32x32x16_bf16(vf[2], pg0, oB1, 0, 0, 0);
    oB1 = __builtin_amdgcn_mfma_f32_32x32x16_bf16(vf[3], pg1, oB1, 0, 0, 0);
}
template <bool CM>
__device__ __forceinline__ void seg_run(const Seg& s, const St& st, const Lay& L, const bf16* nkt, const bf16* nvt, const float (&cm)[16], LAS char* stage,
                                        f32x16& oA0, f32x16& oA1, float& lA, f32x16& oB0, f32x16& oB1, float& lB) {
    oA0 = f32x16{}; oA1 = f32x16{}; lA = 0.f; oB0 = f32x16{}; oB1 = f32x16{}; lB = 0.f;
    const int nt = s.nt, ntl = nt - 1;
    const int aHi = min(s.aHi, ntl), bLo = s.bLo, bHi = min(s.bHi, ntl);
#pragma unroll 1
    for (int t = 0; t < nt; ++t) {
        asm volatile("s_waitcnt vmcnt(0)" ::: "memory");
        bf16x8 kf[4], vf[4];
#pragma unroll
        for (int d0 = 0; d0 < 4; ++d0) kf[d0] = *(const LAS bf16x8*)(stage + L.rdK[d0]);
#pragma unroll
        for (int i_ = 0; i_ < 4; ++i_) { const s16x4 lo_ = vtr(stage + L.vrd + i_ * 1024), hh_ = vtr(stage + L.vrd + i_ * 1024 + 512); vf[i_] = (bf16x8){lo_[0], lo_[1], lo_[2], lo_[3], hh_[0], hh_[1], hh_[2], hh_[3]}; }
        asm volatile("s_waitcnt lgkmcnt(0)" ::: "memory");
        if (t < ntl) dma_tile(s.kt + (size_t)(t + 1) * s.tstride, s.vt + (size_t)(t + 1) * s.tstride, stage, L);
        else if (nkt) dma_tile(nkt, nvt, stage, L);
        const bool a_ = (t <= aHi), b_ = (t >= bLo && t <= bHi);
        if (a_) tile_step<CM>(t, kf, vf, st.qA, s.tbA, s.tneg, s.raLo, cm, oA0, oA1, lA);
        if (b_) tile_step<CM>(t, kf, vf, st.qB, s.tbB, s.tneg, s.rbLo, cm, oB0, oB1, lB);
    }
}
__device__ __forceinline__ void acc_block(const bool FIRST, const f32x16& o0, const f32x16& o1, float lsum, LAS char* lds, int tloc, int lane) {
    const int hi = lane >> 5;
    LAS char* row = lds + ACC_OFF + rho(tloc) * ACC_PITCH + 8 * hi;
#pragma unroll
    for (int dh = 0; dh < 2; ++dh)
#pragma unroll
        for (int c4 = 0; c4 < 4; ++c4) {
            float v0 = dh ? o1[4 * c4] : o0[4 * c4], v1 = dh ? o1[4 * c4 + 1] : o0[4 * c4 + 1], v2 = dh ? o1[4 * c4 + 2] : o0[4 * c4 + 2], v3 = dh ? o1[4 * c4 + 3] : o0[4 * c4 + 3];
            LAS v2u* a = (LAS v2u*)(row + 64 * dh + 16 * c4);
            if (!FIRST) { const v2u old = *a; v0 += __builtin_bit_cast(float, old.x << 16); v1 += __builtin_bit_cast(float, old.x & 0xffff0000u); v2 += __builtin_bit_cast(float, old.y << 16); v3 += __builtin_bit_cast(float, old.y & 0xffff0000u); }
            v2u w; w.x = cvtpk(v0, v1); w.y = cvtpk(v2, v3); *a = w;
        }
    float l = sum_x32(lsum);
    if (hi == 0) { LAS float* la = (LAS float*)(lds + LACC_OFF) + tloc; if (!FIRST) l += *la; *la = l; }
}
__device__ __forceinline__ void gate_load(v4u (&gw)[8], const bf16* grow, int tid) {
#pragma unroll
    for (int it = 0; it < 8; ++it) gw[it] = *(const v4u*)(grow + (size_t)((tid >> 3) + 64 * it) * 1024 + 8 * (tid & 7));
}
template <bool NT = false>
__device__ __forceinline__ void final_store(const v4u (&gw)[8], LAS char* lds, bf16* yrow, int tid) {
#pragma unroll
    for (int it = 0; it < 8; ++it) {
        const int tloc = (tid >> 3) + 64 * it, c = tid & 7;
        const LAS char* row = lds + ACC_OFF + rho(tloc) * ACC_PITCH + 16 * c;
        const v2u a0 = *(const LAS v2u*)row, a1 = *(const LAS v2u*)(row + 8);
        const float inv = __builtin_amdgcn_rcpf(*((const LAS float*)(lds + LACC_OFF) + tloc));
        v4u g = gw[it];
        float gs[8];
        { const unsigned gu[4] = {g.x, g.y, g.z, g.w};
#pragma unroll
          for (int k = 0; k < 4; ++k) { const float a = __builtin_bit_cast(float, gu[k] << 16), b = __builtin_bit_cast(float, gu[k] & 0xffff0000u);
              gs[2 * k] = a * __builtin_amdgcn_rcpf(1.0f + __builtin_amdgcn_exp2f(-LOG2E * a)); gs[2 * k + 1] = b * __builtin_amdgcn_rcpf(1.0f + __builtin_amdgcn_exp2f(-LOG2E * b)); } }
        v4u w;
        w.x = cvtpk(__builtin_bit_cast(float, a0.x << 16) * inv * gs[0], __builtin_bit_cast(float, a0.x & 0xffff0000u) * inv * gs[1]);
        w.y = cvtpk(__builtin_bit_cast(float, a0.y << 16) * inv * gs[2], __builtin_bit_cast(float, a0.y & 0xffff0000u) * inv * gs[3]);
        w.z = cvtpk(__builtin_bit_cast(float, a1.x << 16) * inv * gs[4], __builtin_bit_cast(float, a1.x & 0xffff0000u) * inv * gs[5]);
        w.w = cvtpk(__builtin_bit_cast(float, a1.y << 16) * inv * gs[6], __builtin_bit_cast(float, a1.y & 0xffff0000u) * inv * gs[7]);
        if (NT) __builtin_nontemporal_store(w, (v4u*)(yrow + (size_t)tloc * 1024 + 8 * c)); else *(v4u*)(yrow + (size_t)tloc * 1024 + 8 * c) = w;
    }
}
__device__ __forceinline__ float wg_absmax(const float* p, int n, LAS float* scr, int tid) {
    float m = 0.f;
    for (int i = tid; i < n; i += NWAVES * 64) m = fmaxf(m, fabsf(p[i]));
    m = wave_max(m);
    __syncthreads();
    if ((tid & 63) == 0) scr[tid >> 6] = m;
    __syncthreads();
    float r = scr[0];
#pragma unroll
    for (int i = 1; i < NWAVES; ++i) r = fmaxf(r, scr[i]);
    return r;
}

__device__ __forceinline__ void seg_a(Seg& sg, int u, int si, int tblbuf, const bf16* qkv, LAS char* lds, int lane, int wave) {
    const int s = u & 7, h = (u >> 3) & 15, bl = u >> 7;
    const int g = (si < 2) ? 2 : 3 - si, bb = (si < 2) ? si : 0;
    const bool dual = (g < 2);
    const int sh = 2 * g, L = SEQ >> sh;
    const int bi = 2 * wave + bb, res = bi >> (4 - sh), i = bi & ((16 >> sh) - 1);
    const int pos0 = ((512 * s) >> sh) + 32 * i;
    const int T0 = max(0, 2 - (pos0 >> 5)), T1 = min(dual ? 5 : 4, 2 + ((L - 32 - pos0) >> 5));
    const int q = lane & 31, hi = lane >> 5;
    const bf16* Qg = qkv + (size_t)(3 * g) * SECA + ((size_t)(bl * 16 + h) * 4096) * 64;
    sg.qA = Qg + (size_t)(res * L + pos0 + q) * 64; sg.qB = dual ? sg.qA + 32 * 64 : sg.qA;
    const size_t krow0 = (size_t)(res * L + pos0 + 32 * (T0 - 2)) * 64;
    sg.kt = Qg + SECA + krow0; sg.vt = Qg + 2 * SECA + krow0;
    sg.tbA = lds + TBL_OFF + tblbuf * TBL_BYTES + 4 * (g * 192 + 32 * T0 + 31 + 4 * hi - q); sg.tbB = sg.tbA - 128; sg.tneg = sg.tbA;
    sg.tstride = 2048; sg.nt = T1 - T0 + 1; sg.aHi = 4 - T0; sg.bLo = dual ? 1 - T0 : 1; sg.bHi = dual ? T1 - T0 : 0;
    sg.raLo = 0; sg.rbLo = 0;
    sg.tlocA = ((32 * i + q) << sh) + res; sg.tlocB = ((32 * i + 32 + q) << sh) + res;
    sg.first = (g == 2) ? 1 : 0; sg.dual = dual ? 1 : 0;
}
__device__ __forceinline__ void tbl_a(int u, int tblbuf, const float* t5, float cshift, LAS char* lds, int tid) {
    const int h = (u >> 3) & 15;
    for (int idx = tid; idx < 3 * 192; idx += NWAVES * 64) {
        const int g = idx / 192, rel = idx % 192 - 95; const int ar = rel < 0 ? -rel : rel;
        float v = NEG; if (ar <= 64) v = LOG2E * t5[(g * 16 + h) * 32 + t5_bucket_dev(rel << (2 * g))] - cshift;
        ((LAS float*)(lds + TBL_OFF + tblbuf * TBL_BYTES))[idx] = v;
    }
}
__device__ __forceinline__ void attn_a_phase(Frame& F, const float cshift, const bf16* qkv, const bf16* gate, bf16* y, const float* t5, const float* qg, const float* kg) {
    LAS char* lds = (LAS char*)F.lds;
    LAS float* scr = (LAS float*)(lds + SCR_OFF);
    int tid_ = F.wave * 64 + lane_id(); asm volatile("" : "+v"(tid_));
    const int tid = tid_, lane = tid & 63, wave = __builtin_amdgcn_readfirstlane(tid >> 6);
    const int NU = BCH * NH * 8, per = (NU + F.G - 1) / F.G, u0 = F.vcu * per, nu = min(per, NU - u0);
    if (nu <= 0) return;
    const float zero16[16] = {0.f, 0.f, 0.f, 0.f, 0.f, 0.f, 0.f, 0.f, 0.f, 0.f, 0.f, 0.f, 0.f, 0.f, 0.f, 0.f};
    LAS char* stage = lds + VST_OFF + wave * STAGE_BYTES;
    Lay L; lay_init(L, lane);
    Seg cur; St st;
    seg_a(cur, u0, 0, 0, qkv, lds, lane, wave); seg_start(cur, st, lane); dma_tile(cur.kt, cur.vt, stage, L);
    tbl_a(u0, 0, t5, cshift, lds, tid);
    __syncthreads();
#pragma unroll 1
    for (int ui = 0; ui < nu; ++ui) {
        const int u = u0 + ui;
#pragma unroll 1
        for (int si = 0; si < 4; ++si) {
            Seg nxt = cur;
            const bool more = (si < 3) || (ui + 1 < nu);
            if (more) { if (si < 3) seg_a(nxt, u, si + 1, ui & 1, qkv, lds, lane, wave); else seg_a(nxt, u + 1, 0, (ui + 1) & 1, qkv, lds, lane, wave); }
            f32x16 oA0, oA1, oB0, oB1; float lA, lB;
            seg_run<false>(cur, st, L, more ? nxt.kt : nullptr, nxt.vt, zero16, stage, oA0, oA1, lA, oB0, oB1, lB);
            if (more) seg_start(nxt, st, lane);
            if ((si == 0 && ui > 0) || si >= 2) __syncthreads();
            acc_block(cur.first != 0, oA0, oA1, lA, lds, cur.tlocA, lane);
            if (cur.dual) acc_block(false, oB0, oB1, lB, lds, cur.tlocB, lane);
            cur = nxt;
        }
        if (ui + 1 < nu) tbl_a(u + 1, (ui + 1) & 1, t5, cshift, lds, tid);
        const int s = u & 7, h = (u >> 3) & 15, bl = u >> 7;
        const size_t tok0 = (size_t)bl * 4096 + 512 * s;
        int tidf = tid; asm volatile("" : "+v"(tidf));
        v4u gw[8]; gate_load(gw, gate + tok0 * 1024 + h * 64, tidf);
        __syncthreads();
        final_store<true>(gw, lds, y + tok0 * 1024 + h * 64, tidf);
    }
    asm volatile("s_waitcnt vmcnt(0)" ::: "memory");
    __syncthreads();
}
__device__ __forceinline__ const bf16* uniform_ptr(const bf16* p) {
    const unsigned long long v = (unsigned long long)p;
    const unsigned lo = __builtin_amdgcn_readfirstlane((unsigned)v), hi = __builtin_amdgcn_readfirstlane((unsigned)(v >> 32));
    return (const bf16*)(((unsigned long long)hi << 32) | lo);
}
constexpr int RING_SLOT = 16384;
struct UnitB { const bf16* Kr; const bf16* Vr; int nrows, R, h, b; };
__device__ __forceinline__ void unit_b(UnitB& U, int u, const bf16* qkv) {
    U.R = u & 7; U.h = (u >> 3) & 15; U.b = u >> 7;
    const int kr0 = min(max(8 * U.R - 4, 0), 56), krl = min(max(8 * U.R + 7 - 4, 0), 56) + 7;
    U.nrows = krl - kr0 + 1;
    const bf16* Qb = qkv + ((size_t)(U.b * 16 + U.h) * 4096) * 64;
    U.Kr = uniform_ptr(Qb + SECB + (size_t)kr0 * 4096); U.Vr = uniform_ptr(Qb + 2 * SECB + (size_t)kr0 * 4096);
}
__device__ __forceinline__ void tbl_b(int u, int tblbuf, const float* rpb, float cshift, LAS char* lds, int tid) {
    const int h = (u >> 3) & 15;
    for (int idx = tid; idx < 640; idx += NWAVES * 64) {
        float v = NEG; const int e = idx - 16;
        if (e >= 0 && e < 480 && (e & 31) < 31) v = LOG2E * rpb[(h * 15 + (e >> 5)) * 31 + (e & 31)] - cshift;
        ((LAS float*)(lds + TBL_OFF + tblbuf * TBL_BYTES))[idx] = v;
    }
}
__device__ __forceinline__ void glds16_asm(const void* gsrc, unsigned lds_dst) { unsigned keep;
    asm volatile("s_mov_b32 %0, m0\n\ts_mov_b32 m0, %2\n\ts_nop 0\n\tglobal_load_lds_dwordx4 %1, off\n\ts_mov_b32 m0, %0" : "=&s"(keep) : "v"(gsrc), "s"(lds_dst) : "memory"); }
#define ATT_BAR() do { asm volatile("s_waitcnt lgkmcnt(0)" ::: "memory"); __builtin_amdgcn_s_barrier(); asm volatile("" ::: "memory"); } while (0)
__device__ __forceinline__ void attn_b_phase(Frame& F, const float cshift, const bf16* qkv, const bf16* gate, bf16* y, const float* rpb, const float* qg, const float* kg) {
    LAS char* lds = (LAS char*)F.lds;
    LAS float* scr = (LAS float*)(lds + SCR_OFF);
    int tid_ = F.wave * 64 + lane_id(); asm volatile("" : "+v"(tid_));
    const int tid = tid_, lane = tid & 63, wave = __builtin_amdgcn_readfirstlane(tid >> 6);
    const int NU = BCHB * NH * 8, per = (NU + F.G - 1) / F.G, u0 = F.vcu * per, nu = min(per, NU - u0);
    if (nu <= 0) return;
    const int wq = wave >> 2, cb = wave & 3, q = lane & 31, hi = lane >> 5;
    const int gcq = 16 * cb + (q & 15), slab0 = min(max(16 * cb - 8, 0), 32), csq = min(max(gcq - 8, 0), 48);
    float cm[16];
#pragma unroll
    for (int r = 0; r < 16; ++r) { const int kc = slab0 + (r & 3) + 8 * (r >> 2) + 4 * hi; cm[r] = ((unsigned)(kc - csq) < 16u) ? 0.f : NEG; }
    Lay L; lay_init(L, lane);
    const unsigned kSrc = ((wave & 1) ? L.kOffO : L.kOffE) + 2048u * (unsigned)(wave >> 1), vSrc = L.vOff + 2048u * (unsigned)(wave & 3) + 64u * (unsigned)(wave >> 2);
    const int kDst = wave * 1024, vDst = 8192 + (wave >> 2) * 4096 + (wave & 3) * 1024;
    int rdK[4];
    { const int kq = slab0 + q, kp = (kq & ~9) | ((kq & 1) << 3) | ((kq >> 3) & 1), m = kq & 7;
#pragma unroll
      for (int d0 = 0; d0 < 4; ++d0) rdK[d0] = 128 * kp + 16 * ((2 * d0 + hi) ^ m); }
    const int vrd = 8192 + (slab0 + 4 * hi + ((lane & 15) >> 2)) * 64 + ((lane >> 4) & 1) * 32 + (lane & 3) * 8;
    LAS char* ring = lds + VST_OFF;
    const unsigned ringb = (unsigned)(unsigned long long)ring;
#define ATT_ROWDMA(KR, VR, ROW, SLOT) do { const unsigned sl_ = (unsigned)__builtin_amdgcn_readfirstlane((int)(ringb + (unsigned)(SLOT) * RING_SLOT)); \
        glds16_asm((const char*)((KR) + (size_t)(ROW) * 4096) + kSrc, sl_ + kDst); glds16_asm((const char*)((VR) + (size_t)(ROW) * 4096) + vSrc, sl_ + vDst); } while (0)
    tbl_b(u0, 0, rpb, cshift, lds, tid);
    UnitB cur, nxt; unit_b(cur, u0, qkv); nxt = cur;
    if (nu > 1) unit_b(nxt, u0 + 1, qkv);
    ATT_ROWDMA(cur.Kr, cur.Vr, 0, 0); ATT_ROWDMA(cur.Kr, cur.Vr, 1, 1); ATT_ROWDMA(cur.Kr, cur.Vr, 2, 2);
    St st;
#define ATT_QLOADB(U) do { const bf16* qa_ = qkv + ((size_t)((U).b * 16 + (U).h) * 4096 + 512 * (U).R + (2 * wq + (q >> 4)) * 64 + gcq) * 64; \
        _Pragma("unroll") for (int d0 = 0; d0 < 4; ++d0) { st.qA[d0] = *(const bf16x8*)(qa_ + d0 * 16 + hi * 8); st.qB[d0] = *(const bf16x8*)(qa_ + 256 * 64 + d0 * 16 + hi * 8); } } while (0)
    ATT_QLOADB(cur);
    int rn = 0;
    ATT_BAR();
#pragma unroll 1
    for (int ui = 0; ui < nu; ++ui) {
        const int u = u0 + ui;
        const bool more = (ui + 1 < nu);
        const int R = cur.R, gr0 = 8 * R + 2 * wq, kr0 = min(max(8 * R - 4, 0), 56), nrows = cur.nrows;
        const int grA = gr0 + (q >> 4), grB = grA + 4;
        const int tlocA = (2 * wq + (q >> 4)) * 64 + gcq, tlocB = tlocA + 256;
        Seg sg;
        sg.raLo = min(max(grA - 4, 0), 56) - kr0; sg.rbLo = min(max(grB - 4, 0), 56) - kr0;
        sg.tbA = lds + TBL_OFF + (ui & 1) * TBL_BYTES + 4 * (16 + (kr0 - grA + 7) * 32 + (slab0 + 4 * hi - gcq + 15)); sg.tbB = sg.tbA - 4 * 128;
        sg.tneg = lds + TBL_OFF + (ui & 1) * TBL_BYTES + 4 * 576;
        const int aLo = min(max(gr0 - 4, 0), 56) - kr0, aHi = min(max(gr0 + 1 - 4, 0), 56) + 7 - kr0, bLo = min(max(gr0 + 4 - 4, 0), 56) - kr0, bHi = min(max(gr0 + 5 - 4, 0), 56) + 7 - kr0;
#pragma unroll
        for (int d0 = 0; d0 < 4; ++d0) asm volatile("" : "+v"(st.qA[d0]), "+v"(st.qB[d0]));
        f32x16 oA0 = f32x16{}, oA1 = f32x16{}, oB0 = f32x16{}, oB1 = f32x16{}; float lA = 0.f, lB = 0.f;
#pragma unroll 1
        for (int n = 0; n < nrows; ++n, ++rn) {
            asm volatile("s_waitcnt vmcnt(4)" ::: "memory");
            ATT_BAR();
            { const int j = n + 3;
              if (j < nrows) ATT_ROWDMA(cur.Kr, cur.Vr, j, (rn + 3) & 3);
              else if (more) ATT_ROWDMA(nxt.Kr, nxt.Vr, j - nrows, (rn + 3) & 3);
              else ATT_ROWDMA(cur.Kr, cur.Vr, nrows - 1, (rn + 3) & 3); }
            const bool a_ = (n >= aLo && n <= aHi), b_ = (n >= bLo && n <= bHi);
            if (a_ || b_) {
                const LAS char* sl = ring + (rn & 3) * RING_SLOT;
                bf16x8 kf[4], vf[4];
#pragma unroll
                for (int d0 = 0; d0 < 4; ++d0) kf[d0] = *(const LAS bf16x8*)(sl + rdK[d0]);
#pragma unroll
                for (int i_ = 0; i_ < 4; ++i_) { const s16x4 lo_ = vtr(sl + vrd + (i_ >> 1) * 4096 + (i_ & 1) * 1024), hh_ = vtr(sl + vrd + (i_ >> 1) * 4096 + (i_ & 1) * 1024 + 512);
                    vf[i_] = (bf16x8){lo_[0], lo_[1], lo_[2], lo_[3], hh_[0], hh_[1], hh_[2], hh_[3]}; }
                if (a_) tile_step<true>(n, kf, vf, st.qA, sg.tbA, sg.tneg, sg.raLo, cm, oA0, oA1, lA);
                if (b_) tile_step<true>(n, kf, vf, st.qB, sg.tbB, sg.tneg, sg.rbLo, cm, oB0, oB1, lB);
            }
        }
        if (more) ATT_QLOADB(nxt);
        acc_block(true, oA0, oA1, lA, lds, tlocA, lane);
        acc_block(true, oB0, oB1, lB, lds, tlocB, lane);
        if (more) tbl_b(u + 1, (ui + 1) & 1, rpb, cshift, lds, tid);
        const size_t tok0 = (size_t)cur.b * 4096 + 512 * R; const int h = cur.h;
        int tidf = tid; asm volatile("" : "+v"(tidf));
        v4u gw[8]; gate_load(gw, gate + tok0 * 1024 + h * 64, tidf);
        ATT_BAR();
        final_store(gw, lds, y + tok0 * 1024 + h * 64, tidf);
        cur = nxt;
        if (ui + 2 < nu) unit_b(nxt, u + 2, qkv);
    }
    asm volatile("s_waitcnt vmcnt(0)" ::: "memory");
    ATT_BAR();
#undef ATT_ROWDMA
#undef ATT_QLOADB
}
}
constexpr int PH_OUTA = 1 + 2 * NCH, PH_INB = PH_OUTA + 1  , PH_ATTB = PH_OUTA + 2  , PH_OUTB = PH_OUTA + 1 + 2 * NCHB, NPHASE = PH_OUTB + 1;
constexpr int P0_XROWS = ((MCH / 256) * (NA_IN / 256) * 8 >= MCH && ((MCH / 256) * (NA_IN / 256)) % 256 == 0) ? MCH : MTOK;
#ifndef STAG_IN
#define STAG_IN 0
#endif
#ifndef SPLIT_WAR
#define SPLIT_WAR 1
#endif
#ifndef STAGGER_US
#define STAGGER_US 0
#endif
struct Args { const float* in[12]; float* out; unsigned char* ws; int ph_lo, ph_hi; };
__global__ void __launch_bounds__(NWAVES * 64, 2) fwd_kernel(Args args) {
    extern __shared__ __attribute__((aligned(16))) unsigned char lds[];
    Frame F;
    F.lds = (LAS unsigned char*)lds;
    F.MISC = (volatile LAS unsigned*)(F.lds + MISC_OFF);
    F.wave = __builtin_amdgcn_readfirstlane(threadIdx.x >> 6); F.lane = lane_id(); F.tid = F.wave * 64 + F.lane;
    F.G = gridDim.x; { const int bx = blockIdx.x; F.vcu = (F.G % 8 == 0) ? (bx % 8) * (F.G / 8) + bx / 8 : bx; }
    unsigned char* ws = args.ws;
    F.ctl = (gu32*)(ws + WS_CTL);
    for (int u = F.tid; u < (LDS_BYTES - LDSCTL_OFF) / 4; u += NWAVES * 64) ((LAS unsigned*)(F.lds + LDSCTL_OFF))[u] = 0u;
    __syncthreads();
    XcdBarrier bar = xcd_barrier_post((unsigned*)(F.ctl + CW_BAR), F.MISC + 8, F.wave);
    const int lo = args.ph_lo, hi = args.ph_hi;
#ifndef PROBE_REP
#define PROBE_REP (-1)
#endif
#define NREP(k) (((k) == PROBE_REP) ? 2 : 1)
#define IN(k) (lo <= (k) && (k) < hi)
#define BOTH(k) (IN(k) && IN((k) + 1))
    const float* x = args.in[0]; const float* norm_gain = args.in[1];
    bf16* XB = (bf16*)(ws + WS_XB);
    float* rstd1 = (float*)(ws + WS_RSTD1); float* part2 = (float*)(ws + WS_PART2);

_Pragma("unroll 1") for (int rep_ = 0; rep_ < NREP(0); ++rep_) {
    if (IN(0)) {
        int tid0_ = F.wave * 64 + lane_id(); asm volatile("" : "+v"(tid0_)); F.tid = tid0_; F.lane = tid0_ & 63;
        LAS float* scr = (LAS float*)(F.lds + RING_OFF + F.wave * 16384);
        const int gw = F.vcu * NWAVES + F.wave, NGW = F.G * NWAVES;
        constexpr int I_AIN = (DM / 64) * (NA_IN / 32), I_O = (DM / 64) * (DM / 32), I_BIN = (DM / 64) * (NB_IN / 32);
        constexpr int NITEMS = I_AIN + I_O + I_BIN + I_O;
        for (int it = gw; it < NITEMS; it += NGW) {
            int r = it;
            if (r < I_AIN) { p0_transpose_item(args.in[2], DM, NA_IN, (bf16*)(ws + WS_WAIN), norm_gain, scr, r, F.lane); continue; } r -= I_AIN;
            if (r < I_O) { p0_transpose_item(args.in[3], DM, DM, (bf16*)(ws + WS_WAOUT), nullptr, scr, r, F.lane); continue; } r -= I_O;
            if (r < I_BIN) { p0_transpose_item<true>(args.in[7], DM, NB_IN, (bf16*)(ws + WS_WBIN), norm_gain + DM, scr, r, F.lane); continue; } r -= I_BIN;
            p0_transpose_item(args.in[8], DM, DM, (bf16*)(ws + WS_WBOUT), nullptr, scr, r, F.lane);
        }
        for (int m0 = 4 * gw; m0 < P0_XROWS; m0 += 4 * NGW) {
            f32x4 v[4][4];
#pragma unroll
            for (int rr = 0; rr < 4; ++rr) { const GAS f32x4* xr = (const GAS f32x4*)(x + (size_t)(m0 + rr) * DM) + F.lane;
#pragma unroll
                for (int j = 0; j < 4; ++j) v[rr][j] = __builtin_nontemporal_load(xr + 64 * j); }
#pragma unroll
            for (int rr = 0; rr < 4; ++rr) {
                float s = 0.f;
#pragma unroll
                for (int j = 0; j < 4; ++j) s += (v[rr][j].x * v[rr][j].x + v[rr][j].y * v[rr][j].y) + (v[rr][j].z * v[rr][j].z + v[rr][j].w * v[rr][j].w);
                s = wave_sum(s);
                const float rstd = __builtin_amdgcn_rsqf(s * (1.0f / DM) + pg8::RMS_EPS);
                GAS v2u* o8 = (GAS v2u*)(XB + (size_t)(m0 + rr) * DM) + F.lane;
#pragma unroll
                for (int j = 0; j < 4; ++j) { v2u w; w.x = pk2(v[rr][j].x * rstd, v[rr][j].y * rstd); w.y = pk2(v[rr][j].z * rstd, v[rr][j].w * rstd); o8[64 * j] = w; }
            }
        }
        if (blockIdx.x == 0) {
            LAS float* scr0 = (LAS float*)(F.lds + RING_OFF + 8 * 16384);
            const float ca = 64.0f * QSCALE * att::wg_absmax(args.in[4], 192, scr0, F.tid) * att::wg_absmax(args.in[5], 192, scr0, F.tid) + LOG2E * att::wg_absmax(args.in[6], 48 * 32, scr0, F.tid);
            const float cb = 64.0f * QSCALE * att::wg_absmax(args.in[9], 64, scr0, F.tid) * att::wg_absmax(args.in[10], 64, scr0, F.tid) + LOG2E * att::wg_absmax(args.in[11], NH * 15 * 31, scr0, F.tid);
            if (F.tid == 0) { float* cs = (float*)(ws + WS_CSHIFT); cs[0] = ca; cs[1] = cb; }
        }
        if (BOTH(0)) xcd_barrier(bar);
    }
}

    for (int hf = 0; hf < NCH; ++hf) {
_Pragma("unroll 1") for (int rep_ = 0; rep_ < NREP(1 + 2 * hf); ++rep_) {
        if (IN(1 + 2 * hf)) {
            if (STAG_IN > 0) { const unsigned long long t0_ = __builtin_amdgcn_s_memrealtime(), dl_ = (unsigned long long)((F.vcu % 5) * STAG_IN);
                while (__builtin_amdgcn_s_memrealtime() - t0_ < dl_) __builtin_amdgcn_s_sleep(4); }
            pg8::Gemm g{XB + (size_t)hf * MCH * DM, (const bf16*)(ws + WS_WAIN), MCH, NA_IN, DM};
            pg8::StaticOrder S; S.init(MCH, NA_IN, F.G, (int)blockIdx.x);
            pg8::EpiIn<0> E{(hf + 1 < NCH) ? x + (size_t)(hf + 1) * MCH * DM : nullptr, XB + (size_t)(hf + 1) * MCH * DM, (hf + 1 < NCH) ? MCH : 0, (MCH / 256) * (NA_IN / 256) / (int)F.G,
                            (bf16*)(ws + WS_QKVA + (size_t)(hf % QKVA_NBUF) * QKVA_BUF), SECA, (bf16*)(ws + WS_GATEA + (size_t)(hf % QKVA_NBUF) * QKVA_BUF), rstd1, args.in[4], args.in[5], hf * MCH, QSCALE};
            pg8::gemm_phase<pg8::EpiIn<0>, pg8::StaticOrder, true>(F.lds + RING_OFF, g, S, E, F.wave, (SPLIT_WAR && hf > 0) ? (const unsigned*)(F.ctl + CW_WAR + 64 * (hf - 1)) : nullptr, (unsigned)F.G);
            if (BOTH(1 + 2 * hf)) xcd_barrier(bar);
        }
}

_Pragma("unroll 1") for (int rep_ = 0; rep_ < NREP(2 + 2 * hf); ++rep_) {
        if (IN(2 + 2 * hf)) {
            att::attn_a_phase(F, ((const float*)(ws + WS_CSHIFT))[0], (const bf16*)(ws + WS_QKVA + (size_t)(hf % QKVA_NBUF) * QKVA_BUF), (const bf16*)(ws + WS_GATEA + (size_t)(hf % QKVA_NBUF) * QKVA_BUF), XB + (size_t)hf * MCH * DM, args.in[6], args.in[4], args.in[5]);
            if (BOTH(2 + 2 * hf)) {
                if (SPLIT_WAR && hf < NCH - 1) { if (F.wave == 0 && lane_id() == 0) __hip_atomic_fetch_add((unsigned*)(F.ctl + CW_WAR + 64 * hf), 1u, __ATOMIC_RELAXED, __HIP_MEMORY_SCOPE_AGENT); }
                else xcd_barrier(bar);
            }
        }
}

    }
_Pragma("unroll 1") for (int rep_ = 0; rep_ < NREP(PH_OUTA); ++rep_) {
    if (IN(PH_OUTA)) {
        if (STAGGER_US > 0 && (F.vcu & 1)) { const unsigned long long t0_ = __builtin_amdgcn_s_memrealtime(); while (__builtin_amdgcn_s_memrealtime() - t0_ < (unsigned long long)STAGGER_US * 100ull) __builtin_amdgcn_s_sleep(16); }
        pg8::Gemm g{XB, (const bf16*)(ws + WS_WAOUT), MTOK, DM, DM};
        pg8::StaticOrder S; S.init(MTOK, DM, F.G, (int)blockIdx.x);
        pg8::EpiOut<true> E{x, nullptr, (bf16*)(ws + WS_X1B), part2};
        pg8::gemm_phase<pg8::EpiOut<true>, pg8::StaticOrder, true>(F.lds + RING_OFF, g, S, E, F.wave);
        if (BOTH(PH_OUTA)) xcd_barrier(bar);
    }
}

    for (int cb = 0; cb < NCHB; ++cb) {
_Pragma("unroll 1") for (int rep_ = 0; rep_ < NREP(PH_INB + 2 * cb); ++rep_) {
        if (IN(PH_INB + 2 * cb)) {
            if (STAG_IN > 0) { const unsigned long long t0_ = __builtin_amdgcn_s_memrealtime(), dl_ = (unsigned long long)((F.vcu % 5) * STAG_IN);
                while (__builtin_amdgcn_s_memrealtime() - t0_ < dl_) __builtin_amdgcn_s_sleep(4); }
            pg8::Gemm g{(const bf16*)(ws + WS_X1B) + (size_t)cb * MCHB * DM, (const bf16*)(ws + WS_WBIN), MCHB, NB_IN, DM};
            pg8::StaticOrder S; S.init(MCHB, NB_IN, F.G, (int)blockIdx.x);
            pg8::EpiIn<1> E{nullptr, nullptr, 0, 1, (bf16*)(ws + WS_QKVB), SECB, (bf16*)(ws + WS_GATEB), part2, args.in[9], args.in[10], cb * MCHB, QSCALE};
            pg8::gemm_phase<pg8::EpiIn<1>, pg8::StaticOrder, true>(F.lds + RING_OFF, g, S, E, F.wave);
            if (BOTH(PH_INB + 2 * cb)) xcd_barrier(bar);
        }
}
_Pragma("unroll 1") for (int rep_ = 0; rep_ < NREP(PH_ATTB + 2 * cb); ++rep_) {
        if (IN(PH_ATTB + 2 * cb)) {
            att::attn_b_phase(F, ((const float*)(ws + WS_CSHIFT))[1], (const bf16*)(ws + WS_QKVB), (const bf16*)(ws + WS_GATEB), XB + (size_t)cb * MCHB * DM, args.in[11], args.in[9], args.in[10]);
            if (BOTH(PH_ATTB + 2 * cb)) xcd_barrier(bar);
        }
}
    }

    if (IN(PH_OUTB)) {
        if (STAGGER_US > 0 && (F.vcu & 1)) { const unsigned long long t0_ = __builtin_amdgcn_s_memrealtime(); while (__builtin_amdgcn_s_memrealtime() - t0_ < (unsigned long long)STAGGER_US * 100ull) __builtin_amdgcn_s_sleep(16); }
        pg8::Gemm g{XB, (const bf16*)(ws + WS_WBOUT), MTOK, DM, DM};
        pg8::StaticOrder S; S.init(MTOK, DM, F.G, (int)blockIdx.x);
        pg8::EpiOut<false> E{nullptr, args.out, (bf16*)(ws + WS_X1B), nullptr};
        pg8::gemm_phase<pg8::EpiOut<false>, pg8::StaticOrder, true>(F.lds + RING_OFF, g, S, E, F.wave);
    }
#undef IN
#undef BOTH
}

extern "C" void kernel_launch(void* const* d_in, const int* in_sizes, int n_in, void* d_out, int out_size, void* d_ws, size_t ws_size, hipStream_t stream) {
    static int grid = 0;
    if (grid == 0) {
        if (n_in != 12 || in_sizes[0] != MTOK * DM || out_size != MTOK * DM || ws_size < WS_END) { fprintf(stderr, "kernel_launch: unexpected shapes / workspace (%d inputs, ws %zu)\n", n_in, ws_size); grid = -1; return; }
        int dev = 0, cus = 0, per_cu = 0;
        if (hipGetDevice(&dev) != hipSuccess || hipDeviceGetAttribute(&cus, hipDeviceAttributeMultiprocessorCount, dev) != hipSuccess) { grid = -1; return; }
        if (hipFuncSetAttribute((const void*)fwd_kernel, hipFuncAttributeMaxDynamicSharedMemorySize, LDS_BYTES) != hipSuccess) { fprintf(stderr, "kernel_launch: hipFuncSetAttribute failed\n"); grid = -1; return; }
        if (hipOccupancyMaxActiveBlocksPerMultiprocessor(&per_cu, (const void*)fwd_kernel, NWAVES * 64, LDS_BYTES) != hipSuccess || per_cu < 1) { fprintf(stderr, "kernel_launch: occupancy query says %d blocks per CU\n", per_cu); per_cu = 1; }
        (void)hipGetLastError();
        grid = cus;
    }
    if (grid < 0) return;
    (void)hipMemsetAsync((char*)d_ws + WS_CTL, 0, CTL_ZERO_BYTES, stream);
    Args a{};
    for (int i = 0; i < 12; ++i) a.in[i] = (const float*)d_in[i];
    a.out = (float*)d_out; a.ws = (unsigned char*)d_ws;
    a.ph_lo = 0; a.ph_hi = NPHASE;
    void* kargs[] = {&a};
    hipError_t e = hipLaunchCooperativeKernel((const void*)fwd_kernel, dim3(grid), dim3(NWAVES * 64), kargs, LDS_BYTES, stream);
    if (e != hipSuccess) fprintf(stderr, "kernel_launch: cooperative launch failed: %s (grid %d)\n", hipGetErrorString(e), grid);
}
```

```cpp
#define NCH_A 4
#define NCH_B 1
#include <hip/hip_runtime.h>
#include <cstdio>
#include <cstdint>
template <int CTRL> __device__ __forceinline__ float dpp_mov(float v) { return __int_as_float(__builtin_amdgcn_update_dpp(0, __float_as_int(v), CTRL, 0xF, 0xF, true)); }
__device__ __forceinline__ void swap16(float v, float& a, float& b) { auto r = __builtin_amdgcn_permlane16_swap(__float_as_uint(v), __float_as_uint(v), false, false); const unsigned r0 = r[0], r1 = r[1]; a = __uint_as_float(r0); b = __uint_as_float(r1); }
__device__ __forceinline__ void swap32(float v, float& a, float& b) { auto r = __builtin_amdgcn_permlane32_swap(__float_as_uint(v), __float_as_uint(v), false, false); const unsigned r0 = r[0], r1 = r[1]; a = __uint_as_float(r0); b = __uint_as_float(r1); }
__device__ __forceinline__ float sum_x16(float v) { float a, b; swap16(v, a, b); return a + b; }
__device__ __forceinline__ float sum_x32(float v) { float a, b; swap32(v, a, b); return a + b; }
__device__ __forceinline__ float max_x16(float v) { float a, b; swap16(v, a, b); return fmaxf(a, b); }
__device__ __forceinline__ float max_x32(float v) { float a, b; swap32(v, a, b); return fmaxf(a, b); }
__device__ __forceinline__ float wave_sum(float v) { v += dpp_mov<0xB1>(v); v += dpp_mov<0x4E>(v); v += dpp_mov<0x141>(v); v += dpp_mov<0x140>(v); v = sum_x16(v); return sum_x32(v); }
__device__ __forceinline__ float wave_max(float v) { v = fmaxf(v, dpp_mov<0xB1>(v)); v = fmaxf(v, dpp_mov<0x4E>(v)); v = fmaxf(v, dpp_mov<0x141>(v)); v = fmaxf(v, dpp_mov<0x140>(v)); v = max_x16(v); return max_x32(v); }
namespace pg8 {
#define PG8_LAS __attribute__((address_space(3)))
typedef unsigned short bf16_t;
typedef short bf16x8 __attribute__((ext_vector_type(8)));
typedef float f32x4 __attribute__((ext_vector_type(4)));
typedef unsigned u32x4 __attribute__((ext_vector_type(4)));
typedef unsigned u32x2 __attribute__((ext_vector_type(2)));
constexpr int BM = 256, BK = 64, HALF = 128, HTB = HALF * BK * 2  , STAGE_BYTES = 8 * HTB, NXCD = 8, WGM = 8;

__host__ __device__ __forceinline__ int lds_byte(int r, int c) { const int st = (r >> 4) * 2 + (c >> 5), rr = r & 15, cc = c & 31, ob = rr * 64 + cc * 2; return st * 1024 + (ob ^ (((ob >> 9) & 1) << 5)); }
__host__ __device__ __forceinline__ void stage_rc(int b, int& R, int& C) { const int st = b / 1024, sb = b % 1024, swz = sb ^ (((sb >> 9) & 1) << 5); R = (st >> 1) * 16 + swz / 64; C = (st & 1) * 32 + (swz % 64) / 2; }
__host__ __device__ __forceinline__ int perm32(int rho) { const int n = rho >> 4, i = rho & 15; return 8 * (i >> 2) + 4 * n + (i & 3); }

struct Unit { int pm, pn; };
struct Gemm { const bf16_t* A; const bf16_t* Bt; int M, N, K; };

struct StaticOrder {
    int nM, nN, nwg, G, c;
    __host__ __device__ void init(int M, int N, int G_, int c_) { nM = M / BM; nN = N / BM; nwg = nM * nN; G = G_; c = c_; }
    __host__ __device__ bool next(int i, Unit& u) const {
        const long L = (long)i * G + c; if (L >= nwg) return false;
        int wgid = (int)L; { const int q = nwg / NXCD, r = nwg % NXCD, xcd = wgid % NXCD, off = wgid / NXCD; wgid = (xcd < r ? xcd * (q + 1) : r * (q + 1) + (xcd - r) * q) + off; }
        const int nig = WGM * nN, gid = wgid / nig, fm = gid * WGM, gsz = (nM - fm) < WGM ? (nM - fm) : WGM;
        u.pm = fm + ((wgid % nig) % gsz); u.pn = (wgid % nig) / gsz; return true;
    }
};

#ifndef WT_STORES
#define WT_STORES 0
#endif
__device__ __forceinline__ void st16_wt(void* p, u32x4 v) { if (WT_STORES) asm volatile("global_store_dwordx4 %0, %1, off sc1\n\ts_nop 1" :: "v"(p), "v"(v) : "memory"); else *(u32x4*)p = v; }
__device__ __forceinline__ void st8_wt(void* p, u32x2 v) { if (WT_STORES) asm volatile("global_store_dwordx2 %0, %1, off sc1\n\ts_nop 1" :: "v"(p), "v"(v) : "memory"); else *(u32x2*)p = v; }
typedef _Float16 f16x2_t __attribute__((ext_vector_type(2)));
typedef _Float16 f16x8_t __attribute__((ext_vector_type(8)));
typedef float f32x2_t __attribute__((ext_vector_type(2)));
__device__ __forceinline__ unsigned cvt_pk_f16(float lo, float hi) { const f32x2_t v = {lo, hi}; const f16x2_t h = __builtin_convertvector(v, f16x2_t); return __builtin_bit_cast(unsigned, h); }
__device__ __forceinline__ f32x4 f16x4_to_f32(u32x2 w) { const unsigned w0 = w.x, w1 = w.y;
    const f16x2_t a = __builtin_bit_cast(f16x2_t, w0), b = __builtin_bit_cast(f16x2_t, w1); return (f32x4){(float)a[0], (float)a[1], (float)b[0], (float)b[1]}; }
__device__ __forceinline__ unsigned cvt_pk_bf16(float lo, float hi) { unsigned r; asm volatile("v_cvt_pk_bf16_f32 %0, %1, %2" : "=v"(r) : "v"(lo), "v"(hi)); return r; }


constexpr float RMS_EPS = 1e-6f;
struct NoSide { };
template <int MODE> struct EpiIn {
    static constexpr bool HEADMAP = true;
    static constexpr bool F16 = (MODE == 1);
    const float* xs; bf16_t* xd; int xrows, upc;
    struct Side { f32x4 v[4]; int row; };
    __device__ __forceinline__ void side_issue(Side& s, int ui, int c, int wid, int lane) const {
        s.row = (c * upc + ui) * 8 + wid;
        if (MODE == 0 && s.row < xrows) { const f32x4* xr = (const f32x4*)(xs + (size_t)s.row * 1024) + lane;
#pragma unroll
            for (int j = 0; j < 4; ++j) s.v[j] = __builtin_nontemporal_load(xr + 64 * j); }
    }
    __device__ __forceinline__ void side_finish(const Side& s, int lane) const {
        if (MODE == 0 && s.row < xrows) {
            float q = 0.f;
#pragma unroll
            for (int j = 0; j < 4; ++j) q += (s.v[j][0] * s.v[j][0] + s.v[j][1] * s.v[j][1]) + (s.v[j][2] * s.v[j][2] + s.v[j][3] * s.v[j][3]);
            const float rstd = __builtin_amdgcn_rsqf(wave_sum(q) * (1.0f / 1024.0f) + 1e-6f);
            const bool odd = lane & 1;
            bf16_t* orow = xd + (size_t)s.row * 1024 + 4 * (lane & ~1);
#pragma unroll
            for (int jp = 0; jp < 2; ++jp) {
                const int ja = 2 * jp, jb = 2 * jp + 1;
                const unsigned pax = cvt_pk_bf16(s.v[ja][0] * rstd, s.v[ja][1] * rstd), pay = cvt_pk_bf16(s.v[ja][2] * rstd, s.v[ja][3] * rstd);
                const unsigned pbx = cvt_pk_bf16(s.v[jb][0] * rstd, s.v[jb][1] * rstd), pby = cvt_pk_bf16(s.v[jb][2] * rstd, s.v[jb][3] * rstd);
                const unsigned rx = (unsigned)__builtin_amdgcn_update_dpp(0, (int)(odd ? pax : pbx), 0xB1, 0xF, 0xF, true), ry = (unsigned)__builtin_amdgcn_update_dpp(0, (int)(odd ? pay : pby), 0xB1, 0xF, 0xF, true);
                u32x4 w; w.x = odd ? rx : pax; w.y = odd ? ry : pay; w.z = odd ? pbx : rx; w.w = odd ? pby : ry;
                *(u32x4*)(orow + (odd ? 256 * jb : 256 * ja)) = w;
            }
        }
    }
    bf16_t* qkv; size_t sec_stride; bf16_t* gate; const float* rs; const float* qg; const float* kg; int row_base; float qscale;
    static constexpr int NGQ = (MODE == 0) ? 192 : 64;
    __device__ __forceinline__ void stage_consts(PG8_LAS float* gl, int tid) const { if (tid < 2 * NGQ) gl[tid] = (tid < NGQ) ? qg[tid] * qscale : kg[tid - NGQ]; }
    __device__ __forceinline__ void operator()(const f32x4 (&acc)[2][2][4][2], const Unit& u, int wr, int wc, int fr, int fq, const bool reuse, PG8_LAS float* rscr, PG8_LAS const float* gains) const {
        const int sec = u.pn >> 2, hq = u.pn & 3, h = hq * 4 + wc;
        int type, g = 0;
        if (MODE == 0) { if (sec == 9) type = 3; else { g = sec / 3; type = sec - 3 * g; } } else type = sec;
        const int shift = (MODE == 0) ? 2 * g : 0;
        f32x4 gv[2][2];
#pragma unroll
        for (int bj = 0; bj < 2; ++bj)
#pragma unroll
            for (int n = 0; n < 2; ++n) gv[bj][n] = (f32x4){1.f, 1.f, 1.f, 1.f};
        if (type < 2) {
            PG8_LAS const float* gp = gains + (type == 0 ? 0 : NGQ) + (MODE == 0 ? g * 64 : 0) + 8 * fq;
#pragma unroll
            for (int bj = 0; bj < 2; ++bj)
#pragma unroll
                for (int n = 0; n < 2; ++n) gv[bj][n] = *(PG8_LAS const f32x4*)(gp + 32 * bj + 4 * n);
        }
        bf16_t* p0; size_t step16;
        { const int r0 = u.pm * BM + wr * 64 + fr;
          if (type < 3) { const int t = r0 & 4095, bl = r0 >> 12; const int pos = ((t & ((1 << shift) - 1)) << (12 - shift)) | (t >> shift);
              p0 = qkv + (size_t)sec * sec_stride + ((size_t)(bl * 16 + h) * 4096 + pos) * 64 + 8 * fq; step16 = (size_t)(16 >> shift) * 64; }
          else { p0 = gate + (size_t)r0 * 1024 + hq * 256 + wc * 64 + 8 * fq; step16 = (size_t)16 * 1024; } }
        float rsvv[2][4];
        if (MODE == 1) {
            PG8_LAS float* rsl = rscr + fr;
            if (reuse) {
#pragma unroll
                for (int ai = 0; ai < 2; ++ai)
#pragma unroll
                    for (int m = 0; m < 4; ++m) rsvv[ai][m] = rsl[(ai * 4 + m) * 16];
            } else {
                f32x4 rs4[2][4];
#pragma unroll
                for (int ai = 0; ai < 2; ++ai)
#pragma unroll
                    for (int m = 0; m < 4; ++m) { const int r = u.pm * BM + ai * HALF + wr * 64 + m * 16 + fr; rs4[ai][m] = *(const f32x4*)(rs + (size_t)(row_base + r) * 16 + 4 * fq); }
#pragma unroll
                for (int ai = 0; ai < 2; ++ai)
#pragma unroll
                    for (int m = 0; m < 4; ++m) { const f32x4 pp = rs4[ai][m]; float s = (pp[0] + pp[1]) + (pp[2] + pp[3]); s = sum_x16(s); s = sum_x32(s);
                        rsvv[ai][m] = __builtin_amdgcn_rsqf(s * (1.0f / 1024.0f) + RMS_EPS); if (fq == 0) rsl[(ai * 4 + m) * 16] = rsvv[ai][m]; }
            }
        }
#pragma unroll
        for (int ai = 0; ai < 2; ++ai)
#pragma unroll
            for (int m = 0; m < 4; ++m) {
                const int r = u.pm * BM + ai * HALF + wr * 64 + m * 16 + fr;
                const float rsv = (MODE == 0) ? 1.0f : rsvv[ai][m];
                f32x4 v[2][2];
#pragma unroll
                for (int bj = 0; bj < 2; ++bj)
#pragma unroll
                    for (int n = 0; n < 2; ++n) v[bj][n] = acc[ai][bj][m][n] * rsv;
                if (type < 2) {
                    float ss = 0.f;
#pragma unroll
                    for (int bj = 0; bj < 2; ++bj)
#pragma unroll
                        for (int n = 0; n < 2; ++n) { const f32x4 x = v[bj][n]; ss += (x[0] * x[0] + x[1] * x[1]) + (x[2] * x[2] + x[3] * x[3]); }
                    ss = sum_x16(ss); ss = sum_x32(ss);
                    const float inv = __builtin_amdgcn_rsqf(ss * (1.0f / 64.0f) + RMS_EPS);
#pragma unroll
                    for (int bj = 0; bj < 2; ++bj)
#pragma unroll
                        for (int n = 0; n < 2; ++n) v[bj][n] = v[bj][n] * gv[bj][n] * inv;
                }
                bf16_t* p = p0 + (size_t)(8 * ai + m) * step16;
#pragma unroll
                for (int bj = 0; bj < 2; ++bj) { u32x4 w; w.x = cvt_pk_bf16(v[bj][0][0], v[bj][0][1]); w.y = cvt_pk_bf16(v[bj][0][2], v[bj][0][3]); w.z = cvt_pk_bf16(v[bj][1][0], v[bj][1][1]); w.w = cvt_pk_bf16(v[bj][1][2], v[bj][1][3]);
                    st16_wt(p + 32 * bj, w); }
            }
    }
};

template <bool FIRST> struct EpiOut {
    static constexpr bool HEADMAP = false;
    static constexpr bool F16 = false;
    struct Side { };
    __device__ __forceinline__ void side_issue(Side&, int, int, int, int) const {}
    __device__ __forceinline__ void side_finish(const Side&, int) const {}
    const float* base; float* out; bf16_t* xh; float* part;
    static __device__ __forceinline__ void swap2(unsigned a, unsigned b, unsigned& ra, unsigned& rb) { auto r = __builtin_amdgcn_permlane16_swap(a, b, false, false); const unsigned r0 = r[0], r1 = r[1]; ra = r0; rb = r1; }
    __device__ __forceinline__ void stage_consts(PG8_LAS float*, int) const {}
    __device__ __forceinline__ void operator()(const f32x4 (&acc)[2][2][4][2], const Unit& u, int wr, int wc, int fr, int fq, bool, PG8_LAS float*, PG8_LAS const float*) const {
        f32x4 pre[FIRST ? 4 : 1][2][2]; u32x4 preh[FIRST ? 1 : 4][2]; float ssq[8];
        const size_t off0 = (size_t)(u.pm * BM + wr * 64 + fr) * 1024 + u.pn * BM + wc * 32 + 4 * fq;
        const size_t offw = off0 + ((fq & 1) ? 12 : 0);
#define EPO_ROW(rg) ((size_t)(((rg) >> 2) * HALF + ((rg) & 3) * 16) * 1024)
#define EPO_LOAD(rg) do { _Pragma("unroll") for (int bj = 0; bj < 2; ++bj) { \
            if (FIRST) { _Pragma("unroll") for (int n = 0; n < 2; ++n) pre[(rg) & 3][bj][n] = *(const f32x4*)(base + off0 + EPO_ROW(rg) + bj * HALF + n * 16); } \
            else preh[(rg) & 3][bj] = *(const u32x4*)(xh + offw + EPO_ROW(rg) + bj * HALF); } } while (0)
        EPO_LOAD(0); EPO_LOAD(1); EPO_LOAD(2); EPO_LOAD(3);
#pragma unroll
        for (int rg = 0; rg < 8; ++rg) {
            const int ai = rg >> 2, m = rg & 3;
            float ss = 0.f;
#pragma unroll
            for (int bj = 0; bj < 2; ++bj) {
                f32x4 p0, p1;
                if (FIRST) { p0 = pre[rg & 3][bj][0]; p1 = pre[rg & 3][bj][1]; }
                else { const u32x4 L = preh[rg & 3][bj]; const unsigned lx = L.x, ly = L.y, lz = L.z, lw = L.w; u32x2 X, Y; unsigned a0, b0, a1, b1; swap2(lx, lz, a0, b0); swap2(ly, lw, a1, b1);
                       X.x = a0; X.y = a1; Y.x = b0; Y.y = b1; p0 = f16x4_to_f32(X); p1 = f16x4_to_f32(Y); }
                const f32x4 o0 = p0 + acc[ai][bj][m][0], o1 = p1 + acc[ai][bj][m][1];
                if (FIRST) {
                    const unsigned x0 = cvt_pk_f16(o0[0], o0[1]), x1 = cvt_pk_f16(o0[2], o0[3]), y0 = cvt_pk_f16(o1[0], o1[1]), y1 = cvt_pk_f16(o1[2], o1[3]);
                    unsigned a0, b0, a1, b1; swap2(x0, y0, a0, b0); swap2(x1, y1, a1, b1);
                    u32x4 w; w.x = a0; w.y = a1; w.z = b0; w.w = b1;
                    st16_wt(xh + offw + EPO_ROW(rg) + bj * HALF, w);
                    ss += ((o0[0] * o0[0] + o0[1] * o0[1]) + (o0[2] * o0[2] + o0[3] * o0[3])) + ((o1[0] * o1[0] + o1[1] * o1[1]) + (o1[2] * o1[2] + o1[3] * o1[3]));
                } else {
                    st16_wt(out + off0 + EPO_ROW(rg) + bj * HALF, __builtin_bit_cast(u32x4, o0));
                    st16_wt(out + off0 + EPO_ROW(rg) + bj * HALF + 16, __builtin_bit_cast(u32x4, o1));
                }
            }
            if (rg + 4 < 8) EPO_LOAD(rg + 4);
            if (FIRST) { ss = sum_x16(ss); ss = sum_x32(ss); ssq[rg] = ss; }
        }
        if (FIRST) {
#pragma unroll
            for (int hh = 0; hh < 2; ++hh) {
                const float v = (fq == 0) ? ssq[4 * hh] : (fq == 1) ? ssq[4 * hh + 1] : (fq == 2) ? ssq[4 * hh + 2] : ssq[4 * hh + 3];
                const int r = u.pm * BM + hh * HALF + wr * 64 + fq * 16 + fr;
                part[(size_t)r * 16 + u.pn * 4 + wc] = v;
            }
        }
#undef EPO_ROW
#undef EPO_LOAD
    }
};

template <class Epi, class Sched, bool ALIGN_EPI>
__device__ __forceinline__ void gemm_phase(PG8_LAS unsigned char* lds, const Gemm g, const Sched& S, const Epi& E, const int wave_, const unsigned* war_cnt = nullptr, const unsigned war_need = 0u) {
    int lane_; asm volatile("v_mbcnt_lo_u32_b32 %0, -1, 0\n\tv_mbcnt_hi_u32_b32 %0, -1, %0" : "=v"(lane_)); const int tid_ = wave_ * 64 + lane_;
    const int tid = tid_, wid = __builtin_amdgcn_readfirstlane(tid >> 6), lane = tid & 63, wr = wid >> 2, wc = wid & 3, fr = lane & 15, fq = lane >> 4;
    const int K = g.K, nt = K / BK;
    unsigned voffA[2], voffB[2];
#pragma unroll
    for (int i = 0; i < 2; ++i) { int R, C; stage_rc(tid * 16 + i * 8192, R, C);
        const int Rb = Epi::HEADMAP ? (64 * (R >> 5) + perm32(R & 31)) : R;
        voffA[i] = (unsigned)(R * K + C) * 2u; voffB[i] = (unsigned)(Rb * K + C) * 2u; }
    const size_t kstep = (size_t)(BK * 2);
    const size_t hstep = (size_t)HALF * K * 2;
    const size_t hstepB = Epi::HEADMAP ? (size_t)32 * K * 2 : hstep;
    const size_t tstep = 2 * hstep;
    const unsigned ldsw = (unsigned)wid * 1024u;
    const int aoff = lds_byte(wr * 64 + fr, fq * 8), boff = lds_byte(wc * 32 + fr, fq * 8);
#define PG8_SA(b, h) (((b) * 2 + (h)) * HTB)
#define PG8_SB(b, h) ((4 + (b) * 2 + (h)) * HTB)
#define PG8_STAGE(bufoff, gbase, voff) do { _Pragma("unroll") for (int _i = 0; _i < 2; ++_i) \
        __builtin_amdgcn_global_load_lds((const unsigned*)((const char*)(gbase) + (voff)[_i]), (PG8_LAS unsigned*)(lds + (bufoff) + ldsw + _i * 8192), 16, 0, 0); } while (0)
#define PG8_LDA(dst, b, h) do { _Pragma("unroll") for (int m = 0; m < 4; ++m) _Pragma("unroll") for (int k = 0; k < 2; ++k) dst[m][k] = *(const PG8_LAS bf16x8*)(lds + PG8_SA(b, h) + aoff + m * 2048 + k * 1024); } while (0)
#define PG8_LDB(dst, b, h) do { _Pragma("unroll") for (int n = 0; n < 2; ++n) _Pragma("unroll") for (int k = 0; k < 2; ++k) dst[n][k] = *(const PG8_LAS bf16x8*)(lds + PG8_SB(b, h) + boff + n * 2048 + k * 1024); } while (0)
#define PG8_MMA(ai, bj, At, Bt) do { __builtin_amdgcn_s_setprio(1); _Pragma("unroll") for (int m = 0; m < 4; ++m) _Pragma("unroll") for (int n = 0; n < 2; ++n) _Pragma("unroll") for (int k = 0; k < 2; ++k) \
        acc[ai][bj][m][n] = Epi::F16 ? __builtin_amdgcn_mfma_f32_16x16x32_f16(__builtin_bit_cast(f16x8_t, Bt[n][k]), __builtin_bit_cast(f16x8_t, At[m][k]), acc[ai][bj][m][n], 0, 0, 0) \
                                     : __builtin_amdgcn_mfma_f32_16x16x32_bf16(Bt[n][k], At[m][k], acc[ai][bj][m][n], 0, 0, 0); __builtin_amdgcn_s_setprio(0); } while (0)
#define PG8_WAIT_V(n) asm volatile("s_waitcnt vmcnt(" #n ")" ::: "memory")
#define PG8_WAIT_L(n) asm volatile("s_waitcnt lgkmcnt(" #n ")" ::: "memory")
#define PG8_BAR __builtin_amdgcn_s_barrier()
#define PG8_SCHED __builtin_amdgcn_sched_barrier(0)
    Unit cur, nxt; int ui = 0; int prev_pm = -1;
    if (!S.next(0, cur)) return;
    f32x4 acc[2][2][4][2];
#pragma unroll
    for (int a = 0; a < 2; ++a)
#pragma unroll
        for (int b = 0; b < 2; ++b)
#pragma unroll
            for (int m = 0; m < 4; ++m)
#pragma unroll
                for (int n = 0; n < 2; ++n) acc[a][b][m][n] = (f32x4){0.f, 0.f, 0.f, 0.f};
    bf16x8 At[4][2], B0[2][2], B1[2][2];
    const char* cA = (const char*)g.A + (size_t)cur.pm * tstep; const char* cB = (const char*)g.Bt + (size_t)cur.pn * tstep;
    PG8_STAGE(PG8_SB(0, 0), cB, voffB); PG8_STAGE(PG8_SB(0, 1), cB + hstepB, voffB); PG8_STAGE(PG8_SA(0, 0), cA, voffA); PG8_STAGE(PG8_SA(0, 1), cA + hstep, voffA);
    E.stage_consts((PG8_LAS float*)(lds + 131072) + 1024, tid);
    if (wr == 1) PG8_BAR;
    PG8_WAIT_V(2); PG8_BAR;
    PG8_STAGE(PG8_SB(1, 0), cB + kstep, voffB); PG8_STAGE(PG8_SA(1, 0), cA + kstep, voffA); PG8_STAGE(PG8_SB(1, 1), cB + hstepB + kstep, voffB);
    PG8_WAIT_V(6); PG8_BAR;
    for (;;) {
        const bool has_next = S.next(ui + 1, nxt);
        const char* nA = has_next ? (const char*)g.A + (size_t)nxt.pm * tstep : cA; const char* nB = has_next ? (const char*)g.Bt + (size_t)nxt.pn * tstep : cB;
        for (int t = 0; t < nt; t += 2) {
            const bool last = (t == nt - 2);
            const char* a1 = cA + (size_t)(t + 1) * kstep;
            const char* a2 = last ? nA : cA + (size_t)(t + 2) * kstep; const char* b2 = last ? nB : cB + (size_t)(t + 2) * kstep;
            const char* a3 = a2 + kstep; const char* b3 = b2 + kstep;
            PG8_LDB(B0, 0, 0); PG8_LDB(B1, 0, 1); PG8_SCHED; PG8_LDA(At, 0, 0); PG8_STAGE(PG8_SA(1, 1), a1 + hstep, voffA);
            PG8_WAIT_V(8); PG8_WAIT_L(0); PG8_BAR; PG8_MMA(0, 0, At, B0); PG8_MMA(0, 1, At, B1); PG8_BAR; PG8_SCHED;
            PG8_LDA(At, 0, 1); PG8_STAGE(PG8_SB(0, 0), b2, voffB); PG8_STAGE(PG8_SB(0, 1), b2 + hstepB, voffB); PG8_STAGE(PG8_SA(0, 0), a2, voffA);
            PG8_WAIT_V(8); PG8_WAIT_L(0); PG8_BAR; PG8_MMA(1, 0, At, B0); PG8_MMA(1, 1, At, B1); PG8_BAR; PG8_SCHED;
            PG8_LDB(B0, 1, 0); PG8_LDB(B1, 1, 1); PG8_SCHED; PG8_LDA(At, 1, 0); PG8_STAGE(PG8_SA(0, 1), a2 + hstep, voffA);
            PG8_WAIT_V(8); PG8_WAIT_L(0); PG8_BAR; PG8_MMA(0, 0, At, B0); PG8_MMA(0, 1, At, B1); PG8_BAR; PG8_SCHED;
            PG8_LDA(At, 1, 1); PG8_STAGE(PG8_SB(1, 0), b3, voffB); PG8_STAGE(PG8_SB(1, 1), b3 + hstepB, voffB); PG8_STAGE(PG8_SA(1, 0), a3, voffA);
            PG8_WAIT_V(8); PG8_WAIT_L(0); PG8_BAR; PG8_MMA(1, 0, At, B0); PG8_MMA(1, 1, At, B1); PG8_BAR; PG8_SCHED;
        }
        if constexpr (ALIGN_EPI) { if (wr == 0) PG8_BAR; }
        if (war_cnt && ui == 0) { unsigned sp_ = 0; while (__hip_atomic_load(war_cnt, __ATOMIC_RELAXED, __HIP_MEMORY_SCOPE_AGENT) < war_need && ++sp_ < (1u << 22)) __builtin_amdgcn_s_sleep(2); }
        typename Epi::Side side_; E.side_issue(side_, ui, S.c, wid, lane);
        { const bool reuse_ = (cur.pm == prev_pm); prev_pm = cur.pm; E(acc, cur, wr, wc, fr, fq, reuse_, (PG8_LAS float*)(lds + 131072) + wid * 128, (PG8_LAS const float*)(lds + 131072) + 1024); }
        E.side_finish(side_, lane);
        if (!has_next) break;
#pragma unroll
        for (int a = 0; a < 2; ++a)
#pragma unroll
            for (int b = 0; b < 2; ++b)
#pragma unroll
                for (int m = 0; m < 4; ++m)
#pragma unroll
                    for (int n = 0; n < 2; ++n) acc[a][b][m][n] = (f32x4){0.f, 0.f, 0.f, 0.f};
        cur = nxt; cA = nA; cB = nB; ++ui;
        if constexpr (ALIGN_EPI) { if (wr == 1) PG8_BAR; }
    }
    PG8_WAIT_V(0);
    if constexpr (!ALIGN_EPI) { if (wr == 0) PG8_BAR; }
    PG8_BAR;
#undef PG8_SA
#undef PG8_SB
#undef PG8_STAGE
#undef PG8_LDA
#undef PG8_LDB
#undef PG8_MMA
#undef PG8_WAIT_V
#undef PG8_WAIT_L
#undef PG8_BAR
#undef PG8_SCHED
}
}
constexpr int NWAVES = 8;
constexpr int BATCH = 8, SEQ = 4096, DM = 1024, NH = 16, HD = 64;
constexpr int MTOK = BATCH * SEQ;
#ifndef NCH_A
#define NCH_A 2
#endif
constexpr int NCH = NCH_A;
constexpr int MCH = MTOK / NCH, BCH = BATCH / NCH;
#ifndef NCH_B
#define NCH_B 1
#endif
constexpr int NCHB = NCH_B;
constexpr int MCHB = MTOK / NCHB, BCHB = BATCH / NCHB;
constexpr int NA_IN = 10240, NB_IN = 4096;
constexpr float LOG2E = 1.4426950408889634f;
constexpr float QSCALE = 0.125f * LOG2E;

constexpr size_t MiB = 1u << 20;
constexpr size_t WS_CTL = 0, CTL_ZERO_BYTES = 64 * 1024;
constexpr size_t WS_CSHIFT = 1 * MiB + 512 * 1024;
constexpr size_t WS_RSTD1 = 1 * MiB;
constexpr size_t WS_PART2 = 2 * MiB;
constexpr size_t WS_WAIN = 4 * MiB, WS_WAOUT = 24 * MiB, WS_WBIN = 26 * MiB, WS_WBOUT = 34 * MiB;
constexpr size_t WS_XB = 36 * MiB;
constexpr size_t WS_QKVA = 100 * MiB;
constexpr size_t SECA = (size_t)BCH * NH * SEQ * HD;
constexpr size_t WS_GATEA = WS_QKVA + 9 * SECA * 2;
constexpr size_t QKVA_BUF = 10 * SECA * 2;
constexpr int QKVA_NBUF = 1;
constexpr size_t WS_X1B = 100 * MiB;
constexpr size_t WS_QKVB = 164 * MiB;
constexpr size_t SECB = (size_t)BCHB * NH * SEQ * HD;
constexpr size_t WS_GATEB = WS_QKVB + 3 * SECB * 2;
constexpr size_t WS_END = 420 * MiB;
static_assert(WS_QKVA + (size_t)QKVA_NBUF * QKVA_BUF <= WS_END && WS_GATEB + (size_t)MCHB * DM * 2 <= WS_END && WS_X1B + 64 * MiB <= WS_QKVB, "ws map");
constexpr int CW_BAR = 4096;
constexpr int CW_WAR = 8192;

constexpr int RING_OFF = 0, RING_BYTES = 131072;
constexpr int PHASE_LDS = 155648;
constexpr int LDSCTL_OFF = PHASE_LDS, MISC_OFF = LDSCTL_OFF + 320;
constexpr int LDS_BYTES = 159744;

#define GAS __attribute__((address_space(1)))
#define LAS __attribute__((address_space(3)))
typedef unsigned short bf16;
typedef unsigned v4u __attribute__((ext_vector_type(4)));
typedef unsigned v2u __attribute__((ext_vector_type(2)));
typedef float f32x4 __attribute__((ext_vector_type(4)));
typedef short bf16x8 __attribute__((ext_vector_type(8)));
typedef GAS unsigned gu32;
#define RLX_AGENT __ATOMIC_RELAXED, __HIP_MEMORY_SCOPE_AGENT
#define LDS_WAIT() asm volatile("s_waitcnt lgkmcnt(0)" ::: "memory")
#define VM_WAIT() asm volatile("s_waitcnt vmcnt(0)" ::: "memory")
__device__ __forceinline__ unsigned f2bf(float f) { unsigned u = __builtin_bit_cast(unsigned, f); return (u + 0x7fffu + ((u >> 16) & 1u)) >> 16; }
__device__ __forceinline__ unsigned pk2(float lo, float hi) { return f2bf(lo) | (f2bf(hi) << 16); }
__device__ __forceinline__ float bf2f(unsigned short h) { return __builtin_bit_cast(float, (unsigned)h << 16); }

__device__ __forceinline__ int lane_id() { int l; asm volatile("v_mbcnt_lo_u32_b32 %0, -1, 0\n\tv_mbcnt_hi_u32_b32 %0, -1, %0" : "=v"(l)); return l; }
#define XB_TMO      128
#define XB_XCNT(j)  (256  + 64 * (j))
#define XB_XSUB(j)  (1280 + 64 * (j))
#define XB_XGEN(j)  (2304 + 64 * (j))
#define XB_TOP      3328
#define XB_TOPGEN   3392
#define XCD_BAR_WORDS 3456
#define XB_SPIN_CAP (1u << 18)
__device__ __forceinline__ unsigned xb_ld(unsigned* p)              { return __hip_atomic_load(p, __ATOMIC_RELAXED, __HIP_MEMORY_SCOPE_AGENT); }
__device__ __forceinline__ unsigned xb_add(unsigned* p, unsigned v) { return __hip_atomic_fetch_add(p, v, __ATOMIC_RELAXED, __HIP_MEMORY_SCOPE_AGENT); }
__device__ __forceinline__ unsigned xb_xcc_id() { return (unsigned)__builtin_amdgcn_s_getreg((3 << 11) | 20) & 0xFu; }
#define XB_SPIN(cond, bar) do { unsigned _sp = 0; while (cond) { __builtin_amdgcn_s_sleep(1); \
    if ((++_sp & 255u) == 0u) { if (xb_ld(&(bar)[XB_TMO])) break; if (_sp > XB_SPIN_CAP) { atomicAdd(&(bar)[XB_TMO], 1u); break; } } } } while (0)
struct XcdBarrier { unsigned* bar; unsigned x; volatile LAS unsigned* st; int wave; };
__device__ __forceinline__ XcdBarrier xcd_barrier_post(unsigned* bar, volatile LAS unsigned* st, int wave) {
    XcdBarrier b; b.bar = bar; b.x = xb_xcc_id(); b.st = st; b.wave = wave;
    if (wave == 0 && lane_id() == 0) (void)xb_add(&bar[XB_XCNT(b.x)], 1u);
    return b;
}
__device__ __forceinline__ void xcd_barrier_complete(unsigned* bar, unsigned x, unsigned& nloc, unsigned& nx) {
    const unsigned G = gridDim.x * gridDim.y * gridDim.z;
    unsigned sum, cnt, mine, sp = 0u;
    for (;;) {
        sum = 0u; cnt = 0u; mine = 0u;
#pragma unroll
        for (unsigned j = 0; j < 16; ++j) { const unsigned c = xb_ld(&bar[XB_XCNT(j)]); sum += c; cnt += (c > 0u) ? 1u : 0u; mine = (j == x) ? c : mine; }
        if (sum == G) break;
        __builtin_amdgcn_s_sleep(1);
        if ((++sp & 255u) == 0u) { if (xb_ld(&bar[XB_TMO])) break; if (sp > XB_SPIN_CAP) { atomicAdd(&bar[XB_TMO], 1u); break; } }
    }
    nloc = mine > 0u ? mine : 1u; nx = cnt > 0u ? cnt : 1u;
}
__device__ __forceinline__ void xcd_barrier(const XcdBarrier& b) {
    asm volatile("s_waitcnt vmcnt(0)" ::: "memory");
    __syncthreads();
    if (b.wave == 0 && lane_id() == 0) {
        unsigned* bar = b.bar; asm volatile("" : "+s"(bar));
        __builtin_amdgcn_s_waitcnt(0);
        unsigned nloc = b.st[0], nx = b.st[1];
        if (nloc == 0u) { xcd_barrier_complete(bar, b.x, nloc, nx); b.st[0] = nloc; b.st[1] = nx; }
        const unsigned old = xb_add(&bar[XB_XSUB(b.x)], 1u);
        const unsigned gen = old / nloc;
        if (old + 1u == (gen + 1u) * nloc) {
            __builtin_amdgcn_fence(__ATOMIC_RELEASE, "agent");
            asm volatile("s_waitcnt vmcnt(0)" ::: "memory");
            const unsigned og = xb_add(&bar[XB_TOP], 1u);
            const unsigned tg = og / nx;
            if (og + 1u == (tg + 1u) * nx) xb_add(&bar[XB_TOPGEN], 1u);
            else XB_SPIN(xb_ld(&bar[XB_TOPGEN]) == tg, bar);
            __builtin_amdgcn_fence(__ATOMIC_ACQUIRE, "agent");
            xb_add(&bar[XB_XGEN(b.x)], 1u);
            asm volatile("s_waitcnt vmcnt(0)" ::: "memory");
        } else {
            XB_SPIN(xb_ld(&bar[XB_XGEN(b.x)]) == gen, bar);
            __builtin_amdgcn_fence(__ATOMIC_ACQUIRE, "agent");
            asm volatile("s_waitcnt vmcnt(0)" ::: "memory");
        }
    }
    __syncthreads();
}

struct Frame {
    LAS unsigned char* lds;
    volatile LAS unsigned* MISC;
    gu32* ctl;
    int tid, lane, wave, vcu, G;
};

template <bool F16 = false>
__device__ __forceinline__ void p0_transpose_item(const float* W, int K, int N, bf16* WT, const float* gk, LAS float* scr, int item, int lane) {
    const int nblk = N / 32, kb = item / nblk, nb = item % nblk, k0 = 64 * kb, n0 = 32 * nb;
    float wv[32];
#pragma unroll
    for (int i = 0; i < 32; ++i) { const int kk = 2 * i + (lane >> 5); wv[i] = __builtin_nontemporal_load(W + (size_t)(k0 + kk) * N + n0 + (lane & 31)); }
#pragma unroll
    for (int i = 0; i < 32; ++i) { const int kk = 2 * i + (lane >> 5); const float gsc = gk ? gk[k0 + kk] : 1.0f; scr[kk * 33 + (lane & 31)] = wv[i] * gsc; }
    LDS_WAIT(); asm volatile("" ::: "memory");
    const int c = lane & 7;
#pragma unroll
    for (int j = 0; j < 4; ++j) { const int n = (lane >> 3) + 8 * j; const LAS float* s = scr + (8 * c) * 33 + n;
        v4u o;
        if (F16) { o.x = pg8::cvt_pk_f16(s[0 * 33], s[1 * 33]); o.y = pg8::cvt_pk_f16(s[2 * 33], s[3 * 33]); o.z = pg8::cvt_pk_f16(s[4 * 33], s[5 * 33]); o.w = pg8::cvt_pk_f16(s[6 * 33], s[7 * 33]); }
        else { o.x = pk2(s[0 * 33], s[1 * 33]); o.y = pk2(s[2 * 33], s[3 * 33]); o.z = pk2(s[4 * 33], s[5 * 33]); o.w = pk2(s[6 * 33], s[7 * 33]); }
        *(GAS v4u*)(WT + (size_t)(n0 + n) * K + k0 + 8 * c) = o; }
    LDS_WAIT(); asm volatile("" ::: "memory");
}
__device__ __forceinline__ int t5_bucket_dev(int rel) {
    const int n = rel < 0 ? -rel : rel;
    const int b = n < 8 ? n : 8 + (n >= 15) + (n >= 27) + (n >= 50) + (n >= 91) + (n >= 167) + (n >= 305) + (n >= 559);
    return b + (rel > 0 ? 16 : 0);
}
namespace att {
typedef float f32x16 __attribute__((ext_vector_type(16)));
typedef short s16x4 __attribute__((ext_vector_type(4)));
typedef short v4i16_t __attribute__((ext_vector_type(4)));
typedef float f32x2_t __attribute__((ext_vector_type(2)));
typedef __bf16 bf16x2_t __attribute__((ext_vector_type(2)));
constexpr float NEG = -1e30f;
constexpr int ACC_PITCH = 136;
constexpr int ACC_OFF = 0, LACC_OFF = 512 * ACC_PITCH, TBL_OFF = LACC_OFF + 2048, TBL_BYTES = 4096  , SCR_OFF = TBL_OFF + 2 * TBL_BYTES, VST_OFF = SCR_OFF + 256, STAGE_BYTES = 8192, LDS_END = VST_OFF + 8 * STAGE_BYTES;
static_assert(VST_OFF % 16 == 0 && LDS_END <= PHASE_LDS, "attention LDS map");
__device__ __forceinline__ int rho(int t) { return t ^ ((t >> 5) & 15); }
__device__ __forceinline__ unsigned cvtpk(float lo, float hi) { f32x2_t v = {lo, hi}; bf16x2_t b = __builtin_convertvector(v, bf16x2_t); return __builtin_bit_cast(unsigned, b); }
__device__ __forceinline__ s16x4 vtr(const LAS char* p) { return __builtin_bit_cast(s16x4, __builtin_amdgcn_ds_read_tr16_b64_v4i16((LAS v4i16_t*)p)); }

struct Seg {
    const bf16* qA; const bf16* qB;
    const bf16* kt; const bf16* vt;
    const LAS char* tbA; const LAS char* tbB; const LAS char* tneg;
    int tstride, nt, aHi, bLo, bHi;
    int raLo, rbLo;
    int tlocA, tlocB;
    int first, dual;
};
struct St { bf16x8 qA[4], qB[4]; };
struct Lay { unsigned kOffE, kOffO, vOff; int rdK[4]; int vrd; };
__device__ __forceinline__ void lay_init(Lay& L, int lane) {
    const int l3 = (lane >> 3) & 1, l4 = (lane >> 4) & 1, l5 = (lane >> 5) & 1, c7 = lane & 7;
    const unsigned rows = 1024u * l3 + 512u * l5 + 256u * l4;
    L.kOffE = rows + 16u * (unsigned)(c7 ^ (4 * l5 + 2 * l4));
    L.kOffO = rows + 128u + 16u * (unsigned)(c7 ^ (4 * l5 + 2 * l4 + 1));
    L.vOff = (unsigned)((lane >> 2) * 128 + (lane & 3) * 16);
    const int r32 = lane & 31, hi = lane >> 5, kp = (r32 & ~9) | ((r32 & 1) << 3) | ((r32 >> 3) & 1), m = r32 & 7;
#pragma unroll
    for (int d0 = 0; d0 < 4; ++d0) L.rdK[d0] = 128 * kp + 16 * ((2 * d0 + hi) ^ m);
    L.vrd = 4096 + ((lane >> 4) & 1) * 32 + (lane & 3) * 8 + (4 * hi + ((lane & 15) >> 2)) * 64;
}
#define ATT_GLDS(g, l) __builtin_amdgcn_global_load_lds((const unsigned*)(g), (LAS unsigned*)(l), 16, 0, 0)
__device__ __forceinline__ void dma_tile(const bf16* kt, const bf16* vt, LAS char* stage, const Lay& L) {
    const char* kb = (const char*)kt; const char* vb = (const char*)vt + L.vOff;
    ATT_GLDS(kb + L.kOffE, stage); ATT_GLDS(kb + L.kOffO, stage + 1024); ATT_GLDS(kb + L.kOffE + 2048, stage + 2048); ATT_GLDS(kb + L.kOffO + 2048, stage + 3072);
    ATT_GLDS(vb, stage + 4096); ATT_GLDS(vb + 2048, stage + 5120); ATT_GLDS(vb + 64, stage + 6144); ATT_GLDS(vb + 2048 + 64, stage + 7168);
}
__device__ __forceinline__ void seg_start(const Seg& s, St& st, int lane) {
    const int hi = lane >> 5;
#pragma unroll
    for (int d0 = 0; d0 < 4; ++d0) { st.qA[d0] = *(const bf16x8*)(s.qA + d0 * 16 + hi * 8); st.qB[d0] = *(const bf16x8*)(s.qB + d0 * 16 + hi * 8); }
}
template <bool CM>
__device__ __forceinline__ void cinit(f32x16& p, const LAS char* tb, const LAS char* tneg, int t, int rlo, const float (&cm)[16]) {
    const LAS char* ta = tb + 128 * t;
    if (CM) ta = ((unsigned)(t - rlo) < 8u) ? ta : tneg;
#pragma unroll
    for (int r = 0; r < 16; ++r) { p[r] = *(const LAS float*)(ta + 4 * ((r & 3) + 8 * (r >> 2))); if (CM) p[r] += cm[r]; }
}
__device__ __forceinline__ void softmax_pack(f32x16& p, float& lsum, bf16x8& pf0, bf16x8& pf1) {
#pragma unroll
    for (int r = 0; r < 16; ++r) { p[r] = __builtin_amdgcn_exp2f(p[r]); lsum += p[r]; }
    v4u pk0, pk1;
    pk0.x = cvtpk(p[0], p[1]); pk0.y = cvtpk(p[2], p[3]); pk0.z = cvtpk(p[4], p[5]); pk0.w = cvtpk(p[6], p[7]);
    pk1.x = cvtpk(p[8], p[9]); pk1.y = cvtpk(p[10], p[11]); pk1.z = cvtpk(p[12], p[13]); pk1.w = cvtpk(p[14], p[15]);
    pf0 = __builtin_bit_cast(bf16x8, pk0); pf1 = __builtin_bit_cast(bf16x8, pk1);
}
template <bool CM>
__device__ __forceinline__ void tile_step(int t, const bf16x8 (&kf)[4], const bf16x8 (&vf)[4], const bf16x8 (&q)[4], const LAS char* tb, const LAS char* tneg, int rlo,
                                          const float (&cm)[16], f32x16& o0, f32x16& o1, float& lsum) {
    f32x16 p; cinit<CM>(p, tb, tneg, t, rlo, cm);
#pragma unroll
    for (int d0 = 0; d0 < 4; ++d0) p = __builtin_amdgcn_mfma_f32_32x32x16_bf16(kf[d0], q[d0], p, 0, 0, 0);
    bf16x8 pf0, pf1; softmax_pack(p, lsum, pf0, pf1);
    o0 = __builtin_amdgcn_mfma_f32_32x32x16_bf16(vf[0], pf0, o0, 0, 0, 0);
    o0 = __builtin_amdgcn_mfma_f32_32x32x16_bf16(vf[1], pf1, o0, 0, 0, 0);
    o1 = __builtin_amdgcn_mfma_f32_32x32x16_bf16(vf[2], pf0, o1, 0, 0, 0);
    o1 = __builtin_amdgcn_mfma_f32_32x32x16_bf16(vf[3], pf1, o1, 0, 0, 0);
}
template <bool CM>
__device__ __forceinline__ void tile_step2(int t, const bf16x8 (&kf)[4], const bf16x8 (&vf)[4], const St& st, const Seg& s, const float (&cm)[16],
                                           f32x16& oA0, f32x16& oA1, float& lA, f32x16& oB0, f32x16& oB1, float& lB) {
    f32x16 pA, pB; cinit<CM>(pA, s.tbA, s.tneg, t, s.raLo, cm); cinit<CM>(pB, s.tbB, s.tneg, t, s.rbLo, cm);
#pragma unroll
    for (int d0 = 0; d0 < 4; ++d0) pA = __builtin_amdgcn_mfma_f32_32x32x16_bf16(kf[d0], st.qA[d0], pA, 0, 0, 0);
#pragma unroll
    for (int d0 = 0; d0 < 4; ++d0) pB = __builtin_amdgcn_mfma_f32_32x32x16_bf16(kf[d0], st.qB[d0], pB, 0, 0, 0);
    bf16x8 pf0, pf1; softmax_pack(pA, lA, pf0, pf1);
    oA0 = __builtin_amdgcn_mfma_f32_32x32x16_bf16(vf[0], pf0, oA0, 0, 0, 0);
    oA0 = __builtin_amdgcn_mfma_f32_32x32x16_bf16(vf[1], pf1, oA0, 0, 0, 0);
    oA1 = __builtin_amdgcn_mfma_f32_32x32x16_bf16(vf[2], pf0, oA1, 0, 0, 0);
    oA1 = __builtin_amdgcn_mfma_f32_32x32x16_bf16(vf[3], pf1, oA1, 0, 0, 0);
    bf16x8 pg0, pg1; softmax_pack(pB, lB, pg0, pg1);
    oB0 = __builtin_amdgcn_mfma_f32_32x32x16_bf16(vf[0], pg0, oB0, 0, 0, 0);
    oB0 = __builtin_amdgcn_mfma_f32_32x32x16_bf16(vf[1], pg1, oB0, 0, 0, 0);
    oB1 = __builtin_amdgcn_mfma_f32_32x32x16_bf16(vf[2], pg0, oB1, 0, 0, 0);
    oB1 = __builtin_amdgcn_mfma_f32_32x32x16_bf16(vf[3], pg1, oB1, 0, 0, 0);
}
template <bool CM>
__device__ __forceinline__ void seg_run(const Seg& s, const St& st, const Lay& L, const bf16* nkt, const bf16* nvt, const float (&cm)[16], LAS char* stage,
                                        f32x16& oA0, f32x16& oA1, float& lA, f32x16& oB0, f32x16& oB1, float& lB) {
    oA0 = f32x16{}; oA1 = f32x16{}; lA = 0.f; oB0 = f32x16{}; oB1 = f32x16{}; lB = 0.f;
    const int nt = s.nt, ntl = nt - 1;
    const int aHi = min(s.aHi, ntl), bLo = s.bLo, bHi = min(s.bHi, ntl);
#pragma unroll 1
    for (int t = 0; t < nt; ++t) {
        asm volatile("s_waitcnt vmcnt(0)" ::: "memory");
        bf16x8 kf[4], vf[4];
#pragma unroll
        for (int d0 = 0; d0 < 4; ++d0) kf[d0] = *(const LAS bf16x8*)(stage + L.rdK[d0]);
#pragma unroll
        for (int i_ = 0; i_ < 4; ++i_) { const s16x4 lo_ = vtr(stage + L.vrd + i_ * 1024), hh_ = vtr(stage + L.vrd + i_ * 1024 + 512); vf[i_] = (bf16x8){lo_[0], lo_[1], lo_[2], lo_[3], hh_[0], hh_[1], hh_[2], hh_[3]}; }
        asm volatile("s_waitcnt lgkmcnt(0)" ::: "memory");
        if (t < ntl) dma_tile(s.kt + (size_t)(t + 1) * s.tstride, s.vt + (size_t)(t + 1) * s.tstride, stage, L);
        else if (nkt) dma_tile(nkt, nvt, stage, L);
        const bool a_ = (t <= aHi), b_ = (t >= bLo && t <= bHi);
        if (a_) tile_step<CM>(t, kf, vf, st.qA, s.tbA, s.tneg, s.raLo, cm, oA0, oA1, lA);
        if (b_) tile_step<CM>(t, kf, vf, st.qB, s.tbB, s.tneg, s.rbLo, cm, oB0, oB1, lB);
    }
}
__device__ __forceinline__ void acc_block(const bool FIRST, const f32x16& o0, const f32x16& o1, float lsum, LAS char* lds, int tloc, int lane) {
    const int hi = lane >> 5;
    LAS char* row = lds + ACC_OFF + rho(tloc) * ACC_PITCH + 8 * hi;
#pragma unroll
    for (int dh = 0; dh < 2; ++dh)
#pragma unroll
        for (int c4 = 0; c4 < 4; ++c4) {
            float v0 = dh ? o1[4 * c4] : o0[4 * c4], v1 = dh ? o1[4 * c4 + 1] : o0[4 * c4 + 1], v2 = dh ? o1[4 * c4 + 2] : o0[4 * c4 + 2], v3 = dh ? o1[4 * c4 + 3] : o0[4 * c4 + 3];
            LAS v2u* a = (LAS v2u*)(row + 64 * dh + 16 * c4);
            if (!FIRST) { const v2u old = *a; v0 += __builtin_bit_cast(float, old.x << 16); v1 += __builtin_bit_cast(float, old.x & 0xffff0000u); v2 += __builtin_bit_cast(float, old.y << 16); v3 += __builtin_bit_cast(float, old.y & 0xffff0000u); }
            v2u w; w.x = cvtpk(v0, v1); w.y = cvtpk(v2, v3); *a = w;
        }
    float l = sum_x32(lsum);
    if (hi == 0) { LAS float* la = (LAS float*)(lds + LACC_OFF) + tloc; if (!FIRST) l += *la; *la = l; }
}
__device__ __forceinline__ void gate_load(v4u (&gw)[8], const bf16* grow, int tid) {
#pragma unroll
    for (int it = 0; it < 8; ++it) gw[it] = *(const v4u*)(grow + (size_t)((tid >> 3) + 64 * it) * 1024 + 8 * (tid & 7));
}
template <bool NT = false>
__device__ __forceinline__ void final_store(const v4u (&gw)[8], LAS char* lds, bf16* yrow, int tid) {
#pragma unroll
    for (int it = 0; it < 8; ++it) {
        const int tloc = (tid >> 3) + 64 * it, c = tid & 7;
        const LAS char* row = lds + ACC_OFF + rho(tloc) * ACC_PITCH + 16 * c;
        const v2u a0 = *(const LAS v2u*)row, a1 = *(const LAS v2u*)(row + 8);
        const float inv = __builtin_amdgcn_rcpf(*((const LAS float*)(lds + LACC_OFF) + tloc));
        v4u g = gw[it];
        float gs[8];
        { const unsigned gu[4] = {g.x, g.y, g.z, g.w};
#pragma unroll
          for (int k = 0; k < 4; ++k) { const float a = __builtin_bit_cast(float, gu[k] << 16), b = __builtin_bit_cast(float, gu[k] & 0xffff0000u);
              gs[2 * k] = a * __builtin_amdgcn_rcpf(1.0f + __builtin_amdgcn_exp2f(-LOG2E * a)); gs[2 * k + 1] = b * __builtin_amdgcn_rcpf(1.0f + __builtin_amdgcn_exp2f(-LOG2E * b)); } }
        v4u w;
        w.x = cvtpk(__builtin_bit_cast(float, a0.x << 16) * inv * gs[0], __builtin_bit_cast(float, a0.x & 0xffff0000u) * inv * gs[1]);
        w.y = cvtpk(__builtin_bit_cast(float, a0.y << 16) * inv * gs[2], __builtin_bit_cast(float, a0.y & 0xffff0000u) * inv * gs[3]);
        w.z = cvtpk(__builtin_bit_cast(float, a1.x << 16) * inv * gs[4], __builtin_bit_cast(float, a1.x & 0xffff0000u) * inv * gs[5]);
        w.w = cvtpk(__builtin_bit_cast(float, a1.y << 16) * inv * gs[6], __builtin_bit_cast(float, a1.y & 0xffff0000u) * inv * gs[7]);
        if (NT) __builtin_nontemporal_store(w, (v4u*)(yrow + (size_t)tloc * 1024 + 8 * c)); else *(v4u*)(yrow + (size_t)tloc * 1024 + 8 * c) = w;
    }
}
__device__ __forceinline__ float wg_absmax(const float* p, int n, LAS float* scr, int tid) {
    float m = 0.f;
    for (int i = tid; i < n; i += NWAVES * 64) m = fmaxf(m, fabsf(p[i]));
    m = wave_max(m);
    __syncthreads();
    if ((tid & 63) == 0) scr[tid >> 6] = m;
    __syncthreads();
    float r = scr[0];
#pragma unroll
    for (int i = 1; i < NWAVES; ++i) r = fmaxf(r, scr[i]);
    return r;
}

__device__ __forceinline__ void seg_a(Seg& sg, int u, int si, int tblbuf, const bf16* qkv, LAS char* lds, int lane, int wave) {
    const int s = u & 7, h = (u >> 3) & 15, bl = u >> 7;
    const int g = (si < 2) ? 2 : 3 - si, bb = (si < 2) ? si : 0;
    const bool dual = (g < 2);
    const int sh = 2 * g, L = SEQ >> sh;
    const int bi = 2 * wave + bb, res = bi >> (4 - sh), i = bi & ((16 >> sh) - 1);
    const int pos0 = ((512 * s) >> sh) + 32 * i;
    const int T0 = max(0, 2 - (pos0 >> 5)), T1 = min(dual ? 5 : 4, 2 + ((L - 32 - pos0) >> 5));
    const int q = lane & 31, hi = lane >> 5;
    const bf16* Qg = qkv + (size_t)(3 * g) * SECA + ((size_t)(bl * 16 + h) * 4096) * 64;
    sg.qA = Qg + (size_t)(res * L + pos0 + q) * 64; sg.qB = dual ? sg.qA + 32 * 64 : sg.qA;
    const size_t krow0 = (size_t)(res * L + pos0 + 32 * (T0 - 2)) * 64;
    sg.kt = Qg + SECA + krow0; sg.vt = Qg + 2 * SECA + krow0;
    sg.tbA = lds + TBL_OFF + tblbuf * TBL_BYTES + 4 * (g * 192 + 32 * T0 + 31 + 4 * hi - q); sg.tbB = sg.tbA - 128; sg.tneg = sg.tbA;
    sg.tstride = 2048; sg.nt = T1 - T0 + 1; sg.aHi = 4 - T0; sg.bLo = dual ? 1 - T0 : 1; sg.bHi = dual ? T1 - T0 : 0;
    sg.raLo = 0; sg.rbLo = 0;
    sg.tlocA = ((32 * i + q) << sh) + res; sg.tlocB = ((32 * i + 32 + q) << sh) + res;
    sg.first = (g == 2) ? 1 : 0; sg.dual = dual ? 1 : 0;
}
__device__ __forceinline__ void tbl_a(int u, int tblbuf, const float* t5, float cshift, LAS char* lds, int tid) {
    const int h = (u >> 3) & 15;
    for (int idx = tid; idx < 3 * 192; idx += NWAVES * 64) {
        const int g = idx / 192, rel = idx % 192 - 95; const int ar = rel < 0 ? -rel : rel;
        float v = NEG; if (ar <= 64) v = LOG2E * t5[(g * 16 + h) * 32 + t5_bucket_dev(rel << (2 * g))] - cshift;
        ((LAS float*)(lds + TBL_OFF + tblbuf * TBL_BYTES))[idx] = v;
    }
}
__device__ __forceinline__ void attn_a_phase(Frame& F, const float cshift, const bf16* qkv, const bf16* gate, bf16* y, const float* t5, const float* qg, const float* kg) {
    LAS char* lds = (LAS char*)F.lds;
    LAS float* scr = (LAS float*)(lds + SCR_OFF);
    int tid_ = F.wave * 64 + lane_id(); asm volatile("" : "+v"(tid_));
    const int tid = tid_, lane = tid & 63, wave = __builtin_amdgcn_readfirstlane(tid >> 6);
    const int NU = BCH * NH * 8, per = (NU + F.G - 1) / F.G, u0 = F.vcu * per, nu = min(per, NU - u0);
    if (nu <= 0) return;
    const float zero16[16] = {0.f, 0.f, 0.f, 0.f, 0.f, 0.f, 0.f, 0.f, 0.f, 0.f, 0.f, 0.f, 0.f, 0.f, 0.f, 0.f};
    LAS char* stage = lds + VST_OFF + wave * STAGE_BYTES;
    Lay L; lay_init(L, lane);
    Seg cur; St st;
    seg_a(cur, u0, 0, 0, qkv, lds, lane, wave); seg_start(cur, st, lane); dma_tile(cur.kt, cur.vt, stage, L);
    tbl_a(u0, 0, t5, cshift, lds, tid);
    __syncthreads();
#pragma unroll 1
    for (int ui = 0; ui < nu; ++ui) {
        const int u = u0 + ui;
#pragma unroll 1
        for (int si = 0; si < 4; ++si) {
            Seg nxt = cur;
            const bool more = (si < 3) || (ui + 1 < nu);
            if (more) { if (si < 3) seg_a(nxt, u, si + 1, ui & 1, qkv, lds, lane, wave); else seg_a(nxt, u + 1, 0, (ui + 1) & 1, qkv, lds, lane, wave); }
            f32x16 oA0, oA1, oB0, oB1; float lA, lB;
            seg_run<false>(cur, st, L, more ? nxt.kt : nullptr, nxt.vt, zero16, stage, oA0, oA1, lA, oB0, oB1, lB);
            if (more) seg_start(nxt, st, lane);
            if ((si == 0 && ui > 0) || si >= 2) __syncthreads();
            acc_block(cur.first != 0, oA0, oA1, lA, lds, cur.tlocA, lane);
            if (cur.dual) acc_block(false, oB0, oB1, lB, lds, cur.tlocB, lane);
            cur = nxt;
        }
        if (ui + 1 < nu) tbl_a(u + 1, (ui + 1) & 1, t5, cshift, lds, tid);
        const int s = u & 7, h = (u >> 3) & 15, bl = u >> 7;
        const size_t tok0 = (size_t)bl * 4096 + 512 * s;
        int tidf = tid; asm volatile("" : "+v"(tidf));
        v4u gw[8]; gate_load(gw, gate + tok0 * 1024 + h * 64, tidf);
        __syncthreads();
        final_store<true>(gw, lds, y + tok0 * 1024 + h * 64, tidf);
    }
    asm volatile("s_waitcnt vmcnt(0)" ::: "memory");
    __syncthreads();
}
__device__ __forceinline__ const bf16* uniform_ptr(const bf16* p) {
    const unsigned long long v = (unsigned long long)p;
    const unsigned lo = __builtin_amdgcn_readfirstlane((unsigned)v), hi = __builtin_amdgcn_readfirstlane((unsigned)(v >> 32));
    return (const bf16*)(((unsigned long long)hi << 32) | lo);
}
constexpr int RING_SLOT = 16384;
struct UnitB { const bf16* Kr; const bf16* Vr; int nrows, R, h, b; };
__device__ __forceinline__ void unit_b(UnitB& U, int u, const bf16* qkv) {
    U.R = u & 7; U.h = (u >> 3) & 15; U.b = u >> 7;
    const int kr0 = min(max(8 * U.R - 4, 0), 56), krl = min(max(8 * U.R + 7 - 4, 0), 56) + 7;
    U.nrows = krl - kr0 + 1;
    const bf16* Qb = qkv + ((size_t)(U.b * 16 + U.h) * 4096) * 64;
    U.Kr = uniform_ptr(Qb + SECB + (size_t)kr0 * 4096); U.Vr = uniform_ptr(Qb + 2 * SECB + (size_t)kr0 * 4096);
}
__device__ __forceinline__ void tbl_b(int u, int tblbuf, const float* rpb, float cshift, LAS char* lds, int tid) {
    const int h = (u >> 3) & 15;
    for (int idx = tid; idx < 640; idx += NWAVES * 64) {
        float v = NEG; const int e = idx - 16;
        if (e >= 0 && e < 480 && (e & 31) < 31) v = LOG2E * rpb[(h * 15 + (e >> 5)) * 31 + (e & 31)] - cshift;
        ((LAS float*)(lds + TBL_OFF + tblbuf * TBL_BYTES))[idx] = v;
    }
}
__device__ __forceinline__ void glds16_asm(const void* gsrc, unsigned lds_dst) { unsigned keep;
    asm volatile("s_mov_b32 %0, m0\n\ts_mov_b32 m0, %2\n\ts_nop 0\n\tglobal_load_lds_dwordx4 %1, off\n\ts_mov_b32 m0, %0" : "=&s"(keep) : "v"(gsrc), "s"(lds_dst) : "memory"); }
#define ATT_BAR() do { asm volatile("s_waitcnt lgkmcnt(0)" ::: "memory"); __builtin_amdgcn_s_barrier(); asm volatile("" ::: "memory"); } while (0)
__device__ __forceinline__ void attn_b_phase(Frame& F, const float cshift, const bf16* qkv, const bf16* gate, bf16* y, const float* rpb, const float* qg, const float* kg) {
    LAS char* lds = (LAS char*)F.lds;
    LAS float* scr = (LAS float*)(lds + SCR_OFF);
    int tid_ = F.wave * 64 + lane_id(); asm volatile("" : "+v"(tid_));
    const int tid = tid_, lane = tid & 63, wave = __builtin_amdgcn_readfirstlane(tid >> 6);
    const int NU = BCHB * NH * 8, per = (NU + F.G - 1) / F.G, u0 = F.vcu * per, nu = min(per, NU - u0);
    if (nu <= 0) return;
    const int wq = wave >> 2, cb = wave & 3, q = lane & 31, hi = lane >> 5;
    const int gcq = 16 * cb + (q & 15), slab0 = min(max(16 * cb - 8, 0), 32), csq = min(max(gcq - 8, 0), 48);
    float cm[16];
#pragma unroll
    for (int r = 0; r < 16; ++r) { const int kc = slab0 + (r & 3) + 8 * (r >> 2) + 4 * hi; cm[r] = ((unsigned)(kc - csq) < 16u) ? 0.f : NEG; }
    Lay L; lay_init(L, lane);
    const unsigned kSrc = ((wave & 1) ? L.kOffO : L.kOffE) + 2048u * (unsigned)(wave >> 1), vSrc = L.vOff + 2048u * (unsigned)(wave & 3) + 64u * (unsigned)(wave >> 2);
    const int kDst = wave * 1024, vDst = 8192 + (wave >> 2) * 4096 + (wave & 3) * 1024;
    int rdK[4];
    { const int kq = slab0 + q, kp = (kq & ~9) | ((kq & 1) << 3) | ((kq >> 3) & 1), m = kq & 7;
#pragma unroll
      for (int d0 = 0; d0 < 4; ++d0) rdK[d0] = 128 * kp + 16 * ((2 * d0 + hi) ^ m); }
    const int vrd = 8192 + (slab0 + 4 * hi + ((lane & 15) >> 2)) * 64 + ((lane >> 4) & 1) * 32 + (lane & 3) * 8;
    LAS char* ring = lds + VST_OFF;
    const unsigned ringb = (unsigned)(unsigned long long)ring;
#define ATT_ROWDMA(KR, VR, ROW, SLOT) do { const unsigned sl_ = (unsigned)__builtin_amdgcn_readfirstlane((int)(ringb + (unsigned)(SLOT) * RING_SLOT)); \
        glds16_asm((const char*)((KR) + (size_t)(ROW) * 4096) + kSrc, sl_ + kDst); glds16_asm((const char*)((VR) + (size_t)(ROW) * 4096) + vSrc, sl_ + vDst); } while (0)
    tbl_b(u0, 0, rpb, cshift, lds, tid);
    UnitB cur, nxt; unit_b(cur, u0, qkv); nxt = cur;
    if (nu > 1) unit_b(nxt, u0 + 1, qkv);
    ATT_ROWDMA(cur.Kr, cur.Vr, 0, 0); ATT_ROWDMA(cur.Kr, cur.Vr, 1, 1); ATT_ROWDMA(cur.Kr, cur.Vr, 2, 2);
    St st;
#define ATT_QLOADB(U) do { const bf16* qa_ = qkv + ((size_t)((U).b * 16 + (U).h) * 4096 + 512 * (U).R + (2 * wq + (q >> 4)) * 64 + gcq) * 64; \
        _Pragma("unroll") for (int d0 = 0; d0 < 4; ++d0) { st.qA[d0] = *(const bf16x8*)(qa_ + d0 * 16 + hi * 8); st.qB[d0] = *(const bf16x8*)(qa_ + 256 * 64 + d0 * 16 + hi * 8); } } while (0)
    ATT_QLOADB(cur);
    int rn = 0;
    ATT_BAR();
#pragma unroll 1
    for (int ui = 0; ui < nu; ++ui) {
        const int u = u0 + ui;
        const bool more = (ui + 1 < nu);
        const int R = cur.R, gr0 = 8 * R + 2 * wq, kr0 = min(max(8 * R - 4, 0), 56), nrows = cur.nrows;
        const int grA = gr0 + (q >> 4), grB = grA + 4;
        const int tlocA = (2 * wq + (q >> 4)) * 64 + gcq, tlocB = tlocA + 256;
        Seg sg;
        sg.raLo = min(max(grA - 4, 0), 56) - kr0; sg.rbLo = min(max(grB - 4, 0), 56) - kr0;
        sg.tbA = lds + TBL_OFF + (ui & 1) * TBL_BYTES + 4 * (16 + (kr0 - grA + 7) * 32 + (slab0 + 4 * hi - gcq + 15)); sg.tbB = sg.tbA - 4 * 128;
        sg.tneg = lds + TBL_OFF + (ui & 1) * TBL_BYTES + 4 * 576;
        const int aLo = min(max(gr0 - 4, 0), 56) - kr0, aHi = min(max(gr0 + 1 - 4, 0), 56) + 7 - kr0, bLo = min(max(gr0 + 4 - 4, 0), 56) - kr0, bHi = min(max(gr0 + 5 - 4, 0), 56) + 7 - kr0;
#pragma unroll
        for (int d0 = 0; d0 < 4; ++d0) asm volatile("" : "+v"(st.qA[d0]), "+v"(st.qB[d0]));
        f32x16 oA0 = f32x16{}, oA1 = f32x16{}, oB0 = f32x16{}, oB1 = f32x16{}; float lA = 0.f, lB = 0.f;
#pragma unroll 1
        for (int n = 0; n < nrows; ++n, ++rn) {
            asm volatile("s_waitcnt vmcnt(4)" ::: "memory");
            ATT_BAR();
            { const int j = n + 3;
              if (j < nrows) ATT_ROWDMA(cur.Kr, cur.Vr, j, (rn + 3) & 3);
              else if (more) ATT_ROWDMA(nxt.Kr, nxt.Vr, j - nrows, (rn + 3) & 3);
              else ATT_ROWDMA(cur.Kr, cur.Vr, nrows - 1, (rn + 3) & 3); }
            const bool a_ = (n >= aLo && n <= aHi), b_ = (n >= bLo && n <= bHi);
            if (a_ || b_) {
                const LAS char* sl = ring + (rn & 3) * RING_SLOT;
                bf16x8 kf[4], vf[4];
#pragma unroll
                for (int d0 = 0; d0 < 4; ++d0) kf[d0] = *(const LAS bf16x8*)(sl + rdK[d0]);
#pragma unroll
                for (int i_ = 0; i_ < 4; ++i_) { const s16x4 lo_ = vtr(sl + vrd + (i_ >> 1) * 4096 + (i_ & 1) * 1024), hh_ = vtr(sl + vrd + (i_ >> 1) * 4096 + (i_ & 1) * 1024 + 512);
                    vf[i_] = (bf16x8){lo_[0], lo_[1], lo_[2], lo_[3], hh_[0], hh_[1], hh_[2], hh_[3]}; }
                if (a_) tile_step<true>(n, kf, vf, st.qA, sg.tbA, sg.tneg, sg.raLo, cm, oA0, oA1, lA);
                if (b_) tile_step<true>(n, kf, vf, st.qB, sg.tbB, sg.tneg, sg.rbLo, cm, oB0, oB1, lB);
            }
        }
        if (more) ATT_QLOADB(nxt);
        acc_block(true, oA0, oA1, lA, lds, tlocA, lane);
        acc_block(true, oB0, oB1, lB, lds, tlocB, lane);
        if (more) tbl_b(u + 1, (ui + 1) & 1, rpb, cshift, lds, tid);
        const size_t tok0 = (size_t)cur.b * 4096 + 512 * R; const int h = cur.h;
        int tidf = tid; asm volatile("" : "+v"(tidf));
        v4u gw[8]; gate_load(gw, gate + tok0 * 1024 + h * 64, tidf);
        ATT_BAR();
        final_store(gw, lds, y + tok0 * 1024 + h * 64, tidf);
        cur = nxt;
        if (ui + 2 < nu) unit_b(nxt, u + 2, qkv);
    }
    asm volatile("s_waitcnt vmcnt(0)" ::: "memory");
    ATT_BAR();
#undef ATT_ROWDMA
#undef ATT_QLOADB
}
}
constexpr int PH_OUTA = 1 + 2 * NCH, PH_INB = PH_OUTA + 1  , PH_ATTB = PH_OUTA + 2  , PH_OUTB = PH_OUTA + 1 + 2 * NCHB, NPHASE = PH_OUTB + 1;
constexpr int P0_XROWS = ((MCH / 256) * (NA_IN / 256) * 8 >= MCH && ((MCH / 256) * (NA_IN / 256)) % 256 == 0) ? MCH : MTOK;
#ifndef STAG_IN
#define STAG_IN 0
#endif
#ifndef SPLIT_WAR
#define SPLIT_WAR 1
#endif
#ifndef STAGGER_US
#define STAGGER_US 0
#endif
struct Args { const float* in[12]; float* out; unsigned char* ws; int ph_lo, ph_hi; };
__global__ void __launch_bounds__(NWAVES * 64, 2) fwd_kernel(Args args) {
    extern __shared__ __attribute__((aligned(16))) unsigned char lds[];
    Frame F;
    F.lds = (LAS unsigned char*)lds;
    F.MISC = (volatile LAS unsigned*)(F.lds + MISC_OFF);
    F.wave = __builtin_amdgcn_readfirstlane(threadIdx.x >> 6); F.lane = lane_id(); F.tid = F.wave * 64 + F.lane;
    F.G = gridDim.x; { const int bx = blockIdx.x; F.vcu = (F.G % 8 == 0) ? (bx % 8) * (F.G / 8) + bx / 8 : bx; }
    unsigned char* ws = args.ws;
    F.ctl = (gu32*)(ws + WS_CTL);
    for (int u = F.tid; u < (LDS_BYTES - LDSCTL_OFF) / 4; u += NWAVES * 64) ((LAS unsigned*)(F.lds + LDSCTL_OFF))[u] = 0u;
    __syncthreads();
    XcdBarrier bar = xcd_barrier_post((unsigned*)(F.ctl + CW_BAR), F.MISC + 8, F.wave);
    const int lo = args.ph_lo, hi = args.ph_hi;
#ifndef PROBE_REP
#define PROBE_REP (-1)
#endif
#define NREP(k) (((k) == PROBE_REP) ? 2 : 1)
#define IN(k) (lo <= (k) && (k) < hi)
#define BOTH(k) (IN(k) && IN((k) + 1))
    const float* x = args.in[0]; const float* norm_gain = args.in[1];
    bf16* XB = (bf16*)(ws + WS_XB);
    float* rstd1 = (float*)(ws + WS_RSTD1); float* part2 = (float*)(ws + WS_PART2);

_Pragma("unroll 1") for (int rep_ = 0; rep_ < NREP(0); ++rep_) {
    if (IN(0)) {
        int tid0_ = F.wave * 64 + lane_id(); asm volatile("" : "+v"(tid0_)); F.tid = tid0_; F.lane = tid0_ & 63;
        LAS float* scr = (LAS float*)(F.lds + RING_OFF + F.wave * 16384);
        const int gw = F.vcu * NWAVES + F.wave, NGW = F.G * NWAVES;
        constexpr int I_AIN = (DM / 64) * (NA_IN / 32), I_O = (DM / 64) * (DM / 32), I_BIN = (DM / 64) * (NB_IN / 32);
        constexpr int NITEMS = I_AIN + I_O + I_BIN + I_O;
        for (int it = gw; it < NITEMS; it += NGW) {
            int r = it;
            if (r < I_AIN) { p0_transpose_item(args.in[2], DM, NA_IN, (bf16*)(ws + WS_WAIN), norm_gain, scr, r, F.lane); continue; } r -= I_AIN;
            if (r < I_O) { p0_transpose_item(args.in[3], DM, DM, (bf16*)(ws + WS_WAOUT), nullptr, scr, r, F.lane); continue; } r -= I_O;
            if (r < I_BIN) { p0_transpose_item<true>(args.in[7], DM, NB_IN, (bf16*)(ws + WS_WBIN), norm_gain + DM, scr, r, F.lane); continue; } r -= I_BIN;
            p0_transpose_item(args.in[8], DM, DM, (bf16*)(ws + WS_WBOUT), nullptr, scr, r, F.lane);
        }
        for (int m0 = 4 * gw; m0 < P0_XROWS; m0 += 4 * NGW) {
            f32x4 v[4][4];
#pragma unroll
            for (int rr = 0; rr < 4; ++rr) { const GAS f32x4* xr = (const GAS f32x4*)(x + (size_t)(m0 + rr) * DM) + F.lane;
#pragma unroll
                for (int j = 0; j < 4; ++j) v[rr][j] = __builtin_nontemporal_load(xr + 64 * j); }
#pragma unroll
            for (int rr = 0; rr < 4; ++rr) {
                float s = 0.f;
#pragma unroll
                for (int j = 0; j < 4; ++j) s += (v[rr][j].x * v[rr][j].x + v[rr][j].y * v[rr][j].y) + (v[rr][j].z * v[rr][j].z + v[rr][j].w * v[rr][j].w);
                s = wave_sum(s);
                const float rstd = __builtin_amdgcn_rsqf(s * (1.0f / DM) + pg8::RMS_EPS);
                GAS v2u* o8 = (GAS v2u*)(XB + (size_t)(m0 + rr) * DM) + F.lane;
#pragma unroll
                for (int j = 0; j < 4; ++j) { v2u w; w.x = pk2(v[rr][j].x * rstd, v[rr][j].y * rstd); w.y = pk2(v[rr][j].z * rstd, v[rr][j].w * rstd); o8[64 * j] = w; }
            }
        }
        if (blockIdx.x == 0) {
            LAS float* scr0 = (LAS float*)(F.lds + RING_OFF + 8 * 16384);
            const float ca = 64.0f * QSCALE * att::wg_absmax(args.in[4], 192, scr0, F.tid) * att::wg_absmax(args.in[5], 192, scr0, F.tid) + LOG2E * att::wg_absmax(args.in[6], 48 * 32, scr0, F.tid);
            const float cb = 64.0f * QSCALE * att::wg_absmax(args.in[9], 64, scr0, F.tid) * att::wg_absmax(args.in[10], 64, scr0, F.tid) + LOG2E * att::wg_absmax(args.in[11], NH * 15 * 31, scr0, F.tid);
            if (F.tid == 0) { float* cs = (float*)(ws + WS_CSHIFT); cs[0] = ca; cs[1] = cb; }
        }
        if (BOTH(0)) xcd_barrier(bar);
    }
}

    for (int hf = 0; hf < NCH; ++hf) {
_Pragma("unroll 1") for (int rep_ = 0; rep_ < NREP(1 + 2 * hf); ++rep_) {
        if (IN(1 + 2 * hf)) {
            if (STAG_IN > 0) { const unsigned long long t0_ = __builtin_amdgcn_s_memrealtime(), dl_ = (unsigned long long)((F.vcu % 5) * STAG_IN);
                while (__builtin_amdgcn_s_memrealtime() - t0_ < dl_) __builtin_amdgcn_s_sleep(4); }
            pg8::Gemm g{XB + (size_t)hf * MCH * DM, (const bf16*)(ws + WS_WAIN), MCH, NA_IN, DM};
            pg8::StaticOrder S; S.init(MCH, NA_IN, F.G, (int)blockIdx.x);
            pg8::EpiIn<0> E{(hf + 1 < NCH) ? x + (size_t)(hf + 1) * MCH * DM : nullptr, XB + (size_t)(hf + 1) * MCH * DM, (hf + 1 < NCH) ? MCH : 0, (MCH / 256) * (NA_IN / 256) / (int)F.G,
                            (bf16*)(ws + WS_QKVA + (size_t)(hf % QKVA_NBUF) * QKVA_BUF), SECA, (bf16*)(ws + WS_GATEA + (size_t)(hf % QKVA_NBUF) * QKVA_BUF), rstd1, args.in[4], args.in[5], hf * MCH, QSCALE};
            pg8::gemm_phase<pg8::EpiIn<0>, pg8::StaticOrder, true>(F.lds + RING_OFF, g, S, E, F.wave, (SPLIT_WAR && hf > 0) ? (const unsigned*)(F.ctl + CW_WAR + 64 * (hf - 1)) : nullptr, (unsigned)F.G);
            if (BOTH(1 + 2 * hf)) xcd_barrier(bar);
        }
}

_Pragma("unroll 1") for (int rep_ = 0; rep_ < NREP(2 + 2 * hf); ++rep_) {
        if (IN(2 + 2 * hf)) {
            att::attn_a_phase(F, ((const float*)(ws + WS_CSHIFT))[0], (const bf16*)(ws + WS_QKVA + (size_t)(hf % QKVA_NBUF) * QKVA_BUF), (const bf16*)(ws + WS_GATEA + (size_t)(hf % QKVA_NBUF) * QKVA_BUF), XB + (size_t)hf * MCH * DM, args.in[6], args.in[4], args.in[5]);
            if (BOTH(2 + 2 * hf)) {
                if (SPLIT_WAR && hf < NCH - 1) { if (F.wave == 0 && lane_id() == 0) __hip_atomic_fetch_add((unsigned*)(F.ctl + CW_WAR + 64 * hf), 1u, __ATOMIC_RELAXED, __HIP_MEMORY_SCOPE_AGENT); }
                else xcd_barrier(bar);
            }
        }
}

    }
_Pragma("unroll 1") for (int rep_ = 0; rep_ < NREP(PH_OUTA); ++rep_) {
    if (IN(PH_OUTA)) {
        if (STAGGER_US > 0 && (F.vcu & 1)) { const unsigned long long t0_ = __builtin_amdgcn_s_memrealtime(); while (__builtin_amdgcn_s_memrealtime() - t0_ < (unsigned long long)STAGGER_US * 100ull) __builtin_amdgcn_s_sleep(16); }
        pg8::Gemm g{XB, (const bf16*)(ws + WS_WAOUT), MTOK, DM, DM};
        pg8::StaticOrder S; S.init(MTOK, DM, F.G, (int)blockIdx.x);
        pg8::EpiOut<true> E{x, nullptr, (bf16*)(ws + WS_X1B), part2};
        pg8::gemm_phase<pg8::EpiOut<true>, pg8::StaticOrder, true>(F.lds + RING_OFF, g, S, E, F.wave);
        if (BOTH(PH_OUTA)) xcd_barrier(bar);
    }
}

    for (int cb = 0; cb < NCHB; ++cb) {
_Pragma("unroll 1") for (int rep_ = 0; rep_ < NREP(PH_INB + 2 * cb); ++rep_) {
        if (IN(PH_INB + 2 * cb)) {
            if (STAG_IN > 0) { const unsigned long long t0_ = __builtin_amdgcn_s_memrealtime(), dl_ = (unsigned long long)((F.vcu % 5) * STAG_IN);
                while (__builtin_amdgcn_s_memrealtime() - t0_ < dl_) __builtin_amdgcn_s_sleep(4); }
            pg8::Gemm g{(const bf16*)(ws + WS_X1B) + (size_t)cb * MCHB * DM, (const bf16*)(ws + WS_WBIN), MCHB, NB_IN, DM};
            pg8::StaticOrder S; S.init(MCHB, NB_IN, F.G, (int)blockIdx.x);
            pg8::EpiIn<1> E{nullptr, nullptr, 0, 1, (bf16*)(ws + WS_QKVB), SECB, (bf16*)(ws + WS_GATEB), part2, args.in[9], args.in[10], cb * MCHB, QSCALE};
            pg8::gemm_phase<pg8::EpiIn<1>, pg8::StaticOrder, true>(F.lds + RING_OFF, g, S, E, F.wave);
            if (BOTH(PH_INB + 2 * cb)) xcd_barrier(bar);
        }
}
_Pragma("unroll 1") for (int rep_ = 0; rep_ < NREP(PH_ATTB + 2 * cb); ++rep_) {
        if (IN(PH_ATTB + 2 * cb)) {
            att::attn_b_phase(F, ((const float*)(ws + WS_CSHIFT))[1], (const bf16*)(ws + WS_QKVB), (const bf16*)(ws + WS_GATEB), XB + (size_t)cb * MCHB * DM, args.in[11], args.in[9], args.in[10]);
            if (BOTH(PH_ATTB + 2 * cb)) xcd_barrier(bar);
        }
}
    }

    if (IN(PH_OUTB)) {
        if (STAGGER_US > 0 && (F.vcu & 1)) { const unsigned long long t0_ = __builtin_amdgcn_s_memrealtime(); while (__builtin_amdgcn_s_memrealtime() - t0_ < (unsigned long long)STAGGER_US * 100ull) __builtin_amdgcn_s_sleep(16); }
        pg8::Gemm g{XB, (const bf16*)(ws + WS_WBOUT), MTOK, DM, DM};
        pg8::StaticOrder S; S.init(MTOK, DM, F.G, (int)blockIdx.x);
        pg8::EpiOut<false> E{nullptr, args.out, (bf16*)(ws + WS_X1B), nullptr};
        pg8::gemm_phase<pg8::EpiOut<false>, pg8::StaticOrder, true>(F.lds + RING_OFF, g, S, E, F.wave);
    }
#undef IN
#undef BOTH
}

extern "C" void kernel_launch(void* const* d_in, const int* in_sizes, int n_in, void* d_out, int out_size, void* d_ws, size_t ws_size, hipStream_t stream) {
    static int grid = 0;
    if (grid == 0) {
        if (n_in != 12 || in_sizes[0] != MTOK * DM || out_size != MTOK * DM || ws_size < WS_END) { fprintf(stderr, "kernel_launch: unexpected shapes / workspace (%d inputs, ws %zu)\n", n_in, ws_size); grid = -1; return; }
        int dev = 0, cus = 0, per_cu = 0;
        if (hipGetDevice(&dev) != hipSuccess || hipDeviceGetAttribute(&cus, hipDeviceAttributeMultiprocessorCount, dev) != hipSuccess) { grid = -1; return; }
        if (hipFuncSetAttribute((const void*)fwd_kernel, hipFuncAttributeMaxDynamicSharedMemorySize, LDS_BYTES) != hipSuccess) { fprintf(stderr, "kernel_launch: hipFuncSetAttribute failed\n"); grid = -1; return; }
        if (hipOccupancyMaxActiveBlocksPerMultiprocessor(&per_cu, (const void*)fwd_kernel, NWAVES * 64, LDS_BYTES) != hipSuccess || per_cu < 1) { fprintf(stderr, "kernel_launch: occupancy query says %d blocks per CU\n", per_cu); per_cu = 1; }
        (void)hipGetLastError();
        grid = cus;
    }
    if (grid < 0) return;
    (void)hipMemsetAsync((char*)d_ws + WS_CTL, 0, CTL_ZERO_BYTES, stream);
    Args a{};
    for (int i = 0; i < 12; ++i) a.in[i] = (const float*)d_in[i];
    a.out = (float*)d_out; a.ws = (unsigned char*)d_ws;
    a.ph_lo = 0; a.ph_hi = NPHASE;
    void* kargs[] = {&a};
    hipError_t e = hipLaunchCooperativeKernel((const void*)fwd_kernel, dim3(grid), dim3(NWAVES * 64), kargs, LDS_BYTES, stream);
    if (e != hipSuccess) fprintf(stderr, "kernel_launch: cooperative launch failed: %s (grid %d)\n", hipGetErrorString(e), grid);
}
```
